# Optimizing an MI355X kernel written in HIP

```python
import jax, jax.numpy as jnp
from jax import lax
import numpy as np

D_MODEL = 1024
BATCH = 2
SEQ = 8192
DEPTH = 1

N_META = 16
ATTN_HEADS = 8
ATTN_HEAD_DIM = 64
ATTN_WIDTH = ATTN_HEADS * ATTN_HEAD_DIM
IDX_HEADS = 8
IDX_HEAD_DIM = 64
IDX_SCALE = (IDX_HEADS ** -0.5) * (IDX_HEAD_DIM ** -0.5)
ATTN_SCALE = ATTN_HEAD_DIM ** -0.5
TOPK_MAX = 256
Q_BLOCK = 128
HGRN_HEADS = 4
HGRN_KEY_DIM = 128
HGRN_VAL_DIM = 128
HGRN_WIDTH = HGRN_HEADS * HGRN_VAL_DIM
CHUNK = 64
MIX_WIDTH = ATTN_WIDTH + HGRN_WIDTH
IN_WIDTH = 4 * ATTN_WIDTH + IDX_HEADS * IDX_HEAD_DIM + IDX_HEAD_DIM + IDX_HEADS + 4 * HGRN_WIDTH
ROPE_THETA = 500000.0
ROPE_FRACTION = 4
EPS = 1e-6

kernel_name = "hymba_dsa_hgrn2_hybrid"


def rms_norm(x, g):
    xf = x.astype(jnp.float32)
    y = xf * lax.rsqrt(jnp.mean(xf * xf, axis=-1, keepdims=True) + EPS)
    return (y * g.astype(jnp.float32)).astype(x.dtype)


def layer_norm(x, g, b):
    xf = x.astype(jnp.float32)
    mu = jnp.mean(xf, axis=-1, keepdims=True)
    var = jnp.mean((xf - mu) ** 2, axis=-1, keepdims=True)
    y = (xf - mu) * lax.rsqrt(var + EPS)
    return (y * g.astype(jnp.float32) + b.astype(jnp.float32)).astype(x.dtype)


def rope_tables(T, head_dim):
    r = head_dim // ROPE_FRACTION
    half = r // 2
    inv = ROPE_THETA ** (-jnp.arange(half, dtype=jnp.float32) * 2.0 / r)
    ang = jnp.arange(T, dtype=jnp.float32)[:, None] * inv[None, :]
    return jnp.cos(ang)[:, None, :], jnp.sin(ang)[:, None, :]


def partial_rope(x, cos, sin):
    d = x.shape[-1]
    r = d // ROPE_FRACTION
    half = r // 2
    x1 = x[..., :half].astype(jnp.float32)
    x2 = x[..., half:r].astype(jnp.float32)
    rot = jnp.concatenate([x1 * cos - x2 * sin, x2 * cos + x1 * sin], axis=-1)
    return jnp.concatenate([rot.astype(x.dtype), x[..., r:]], axis=-1)


def split_columns(proj):
    sizes = [ATTN_WIDTH] * 4 + [IDX_HEADS * IDX_HEAD_DIM, IDX_HEAD_DIM, IDX_HEADS] + [HGRN_WIDTH] * 4
    points = np.cumsum(sizes)[:-1].tolist()
    return jnp.split(proj, points, axis=-1)


def sparse_attention(aq, ak, av, iq, ik, iw, idx_k_g, idx_k_b):
    B, T, _ = aq.shape
    S = T - N_META
    cos, sin = rope_tables(T, ATTN_HEAD_DIM)
    q = partial_rope(aq.reshape(B, T, ATTN_HEADS, ATTN_HEAD_DIM), cos, sin)
    k = partial_rope(ak.reshape(B, T, ATTN_HEADS, ATTN_HEAD_DIM), cos, sin)
    v = av.reshape(B, T, ATTN_HEADS, ATTN_HEAD_DIM)
    icos, isin = rope_tables(T, IDX_HEAD_DIM)
    qi = partial_rope(iq.reshape(B, T, IDX_HEADS, IDX_HEAD_DIM), icos, isin)
    ki = partial_rope(layer_norm(ik, idx_k_g, idx_k_b)[:, :, None, :], icos, isin)[:, :, 0, :]

    q_m, k_m, v_m = q[:, :N_META], k[:, :N_META], v[:, :N_META]
    s_m = jnp.einsum('bqhd,bkhd->bhqk', q_m, k_m).astype(jnp.float32) * ATTN_SCALE
    meta_causal = jnp.tril(jnp.ones((N_META, N_META), dtype=bool))
    s_m = jnp.where(meta_causal[None, None], s_m, -jnp.inf)
    p_m = jax.nn.softmax(s_m, axis=-1).astype(v.dtype)
    o_m = jnp.einsum('bhqk,bkhd->bqhd', p_m, v_m)

    q_r, k_r, v_r = q[:, N_META:], k[:, N_META:], v[:, N_META:]
    qi_r, ki_r, iw_r = qi[:, N_META:], ki[:, N_META:], iw[:, N_META:]
    n_blocks = S // Q_BLOCK
    topk = min(TOPK_MAX, S // 4)
    key_pos = jnp.arange(S)

    def to_blocks(a):
        return jnp.moveaxis(a.reshape((B, n_blocks, Q_BLOCK) + a.shape[2:]), 1, 0)

    def block_fn(args):
        blk, qb, qib, wb = args
        r = blk * Q_BLOCK + jnp.arange(Q_BLOCK)
        rel = jax.nn.relu(jnp.einsum('bqhd,bsd->bqhs', qib, ki_r))
        score = jnp.einsum('bqhs,bqh->bqs', rel, wb).astype(jnp.float32) * IDX_SCALE
        admissible = key_pos[None, :] <= r[:, None]
        score = jnp.where(admissible[None], score, -jnp.inf)
        _, sel = lax.top_k(score, topk)
        valid = sel <= r[None, :, None]
        k_sel = jax.vmap(lambda kb, ib: kb[ib])(k_r, sel)
        v_sel = jax.vmap(lambda vb, ib: vb[ib])(v_r, sel)
        s_sel = jnp.einsum('bqhd,bqkhd->bhqk', qb, k_sel).astype(jnp.float32) * ATTN_SCALE
        s_sel = jnp.where(valid[:, None], s_sel, -jnp.inf)
        s_meta = jnp.einsum('bqhd,bmhd->bhqm', qb, k_m).astype(jnp.float32) * ATTN_SCALE
        p = jax.nn.softmax(jnp.concatenate([s_meta, s_sel], axis=-1), axis=-1).astype(v.dtype)
        return (jnp.einsum('bhqm,bmhd->bqhd', p[..., :N_META], v_m)
                + jnp.einsum('bhqk,bqkhd->bqhd', p[..., N_META:], v_sel))

    o_r = lax.map(block_fn, (jnp.arange(n_blocks), to_blocks(q_r), to_blocks(qi_r), to_blocks(iw_r)))
    o_r = jnp.moveaxis(o_r, 0, 1).reshape(B, S, ATTN_HEADS, ATTN_HEAD_DIM)
    return jnp.concatenate([o_m, o_r], axis=1).reshape(B, T, ATTN_WIDTH)


def hgrn2(hq, hf, hi, lower_bound):
    B, T, _ = hq.shape
    f32 = jnp.float32
    q = jax.nn.silu(hq.astype(f32)).reshape(B, T, HGRN_HEADS, HGRN_KEY_DIM)
    f = lower_bound + (1.0 - lower_bound) * jax.nn.sigmoid(hf.astype(f32))
    log_f = jnp.log(f).reshape(B, T, HGRN_HEADS, HGRN_KEY_DIM)
    k = (1.0 - f).reshape(B, T, HGRN_HEADS, HGRN_KEY_DIM)
    v = hi.astype(f32).reshape(B, T, HGRN_HEADS, HGRN_VAL_DIM)
    pad = (-N_META) % CHUNK
    padw = ((0, 0), (pad, 0), (0, 0), (0, 0))
    q, log_f, k, v = [jnp.pad(a, padw) for a in (q, log_f, k, v)]
    Tp = T + pad
    n_chunks = Tp // CHUNK

    def chunks(a):
        return a.reshape(B, n_chunks, CHUNK, HGRN_HEADS, a.shape[-1]).transpose(1, 0, 3, 2, 4)

    causal = jnp.tril(jnp.ones((CHUNK, CHUNK), dtype=bool))[None, None, :, :, None]

    def step(state, xs):
        qc, kc, vc, gc = xs
        b = jnp.cumsum(gc, axis=2)
        diff = b[:, :, :, None, :] - b[:, :, None, :, :]
        decay = jnp.exp(jnp.where(causal, diff, -jnp.inf))
        a = jnp.einsum('bhtd,bhsd,bhtsd->bhts', qc, kc, decay)
        o = jnp.einsum('bhts,bhsv->bhtv', a, vc) + jnp.einsum('bhtd,bhdv->bhtv', qc * jnp.exp(b), state)
        b_last = b[:, :, -1]
        state = (jnp.exp(b_last)[..., None] * state
                 + jnp.einsum('bhsd,bhsv->bhdv', kc * jnp.exp(b_last[:, :, None, :] - b), vc))
        return state, o

    s0 = jnp.zeros((B, HGRN_HEADS, HGRN_KEY_DIM, HGRN_VAL_DIM), f32)
    _, o = lax.scan(step, s0, (chunks(q), chunks(k), chunks(v), chunks(log_f)))
    o = o.transpose(1, 0, 3, 2, 4).reshape(B, Tp, HGRN_HEADS, HGRN_VAL_DIM)
    return o[:, pad:].astype(hq.dtype)


def hybrid_mixer(h, w_in, idx_k_g, idx_k_b, attn_norm_g, lower_bound, hgrn_norm_g, w_out):
    B, T, _ = h.shape
    proj = jnp.einsum('btd,de->bte', h, w_in)
    aq, ak, av, ag, iq, ik, iw, hq, hf, hi, hg = split_columns(proj)
    o_attn = sparse_attention(aq, ak, av, iq, ik, iw, idx_k_g, idx_k_b)
    o_attn = rms_norm(o_attn, attn_norm_g) * jax.nn.silu(ag)
    o_hgrn = rms_norm(hgrn2(hq, hf, hi, lower_bound), hgrn_norm_g).reshape(B, T, HGRN_WIDTH)
    o_hgrn = o_hgrn * jax.nn.silu(hg)
    mixed = jnp.concatenate([o_attn, o_hgrn], axis=-1)
    return jnp.einsum('bte,ed->btd', mixed, w_out)


def setup_inputs(seed: int = 0) -> dict:
    key = jax.random.key(seed)
    ks = jax.random.split(key, 12)
    f32 = jnp.float32
    return {
        "x": jax.random.normal(ks[0], (BATCH, SEQ, D_MODEL), f32),
        "meta_tokens": jax.random.normal(ks[1], (N_META, D_MODEL), f32),
        "mix_norm": 1.0 + 0.05 * jax.random.normal(ks[2], (DEPTH, D_MODEL), f32),
        "w_in": jax.random.normal(ks[3], (DEPTH, D_MODEL, IN_WIDTH), f32) * D_MODEL ** -0.5,
        "idx_k_norm_g": 1.0 + 0.05 * jax.random.normal(ks[4], (DEPTH, IDX_HEAD_DIM), f32),
        "idx_k_norm_b": 0.02 * jax.random.normal(ks[5], (DEPTH, IDX_HEAD_DIM), f32),
        "attn_out_norm": 1.0 + 0.05 * jax.random.normal(ks[6], (DEPTH, ATTN_WIDTH), f32),
        "hgrn_lb_logits": 0.5 * jax.random.normal(ks[7], (DEPTH + 1, HGRN_WIDTH), f32),
        "hgrn_out_norm": 1.0 + 0.05 * jax.random.normal(ks[8], (DEPTH, HGRN_VAL_DIM), f32),
        "w_out": jax.random.normal(ks[9], (DEPTH, MIX_WIDTH, D_MODEL), f32) * MIX_WIDTH ** -0.5,
        "final_norm": 1.0 + 0.05 * jax.random.normal(ks[10], (D_MODEL,), f32),
    }


def reference(x, meta_tokens, mix_norm, w_in, idx_k_norm_g, idx_k_norm_b, attn_out_norm,
              hgrn_lb_logits, hgrn_out_norm, w_out, final_norm):
    B = x.shape[0]
    meta = jnp.broadcast_to(meta_tokens.astype(x.dtype)[None], (B, N_META, D_MODEL))
    h = jnp.concatenate([meta, x], axis=1)
    lower_bounds = jnp.cumsum(jax.nn.softmax(hgrn_lb_logits.astype(jnp.float32), axis=0), axis=0)
    for l in range(DEPTH):
        h = h + hybrid_mixer(rms_norm(h, mix_norm[l]), w_in[l], idx_k_norm_g[l], idx_k_norm_b[l],
                             attn_out_norm[l], lower_bounds[l], hgrn_out_norm[l], w_out[l])
    y = rms_norm(h, final_norm)
    return y[:, N_META:]
```

```cpp
#include <hip/hip_runtime.h>
#include <hip/hip_cooperative_groups.h>
#include <cstdint>
#include <cstdio>
namespace cg = cooperative_groups;

typedef _Float16 h16;
typedef _Float16 h16x8 __attribute__((ext_vector_type(8)));
typedef _Float16 h16x4 __attribute__((ext_vector_type(4)));
typedef float f32x4 __attribute__((ext_vector_type(4)));

#ifndef N_LAUNCH_MODE
#define N_LAUNCH_MODE 0
#endif

constexpr int NB = 2, S = 8192, NMETA = 16, D = 1024;
constexpr int MREAL = NB * S;
constexpr int MROWS = MREAL + NMETA;
constexpr int MPAD = 16640;
constexpr int NCOL = 4680, NPAD = 4864;
constexpr int C_AQ = 0, C_AK = 512, C_AV = 1024, C_AG = 1536, C_IQ = 2048, C_HQ = 2560, C_HF = 3072, C_HI = 3584, C_HG = 4096, C_IK = 4608, C_IW = 4672;
constexpr int NCH = 129;
constexpr int NT = 512;

constexpr size_t MiB = 1u << 20;
constexpr size_t WS_WTIN = 1 * MiB, WS_WTOUT = 11 * MiB, WS_ROPE = 13 * MiB, WS_E = 14 * MiB, WS_KI = 23 * MiB, WS_G = 26 * MiB, WS_P = 27 * MiB, WS_X = 182 * MiB, WS_END = 256 * MiB;
static_assert(WS_P + (size_t)MPAD * NPAD * 2 <= WS_X, "P");
static_assert(WS_X + (size_t)NB * 4 * NCH * 16384 * 4 <= WS_END, "ST");

constexpr int LDS_BYTES = 140 * 1024;

struct Params {
    const float *x, *meta, *mix_norm, *w_in, *idx_g, *idx_b, *attn_norm, *lb_logits, *hgrn_norm, *w_out, *final_norm;
    float* out; unsigned char* ws;
};

__device__ __forceinline__ float wave_sum(float v) {
#pragma unroll
    for (int o = 1; o < 64; o <<= 1) v += __shfl_xor(v, o);
    return v;
}
__device__ __forceinline__ float wave_max(float v) {
#pragma unroll
    for (int o = 1; o < 64; o <<= 1) v = fmaxf(v, __shfl_xor(v, o));
    return v;
}
__device__ __forceinline__ float sigmoidf_(float x) { return 1.f / (1.f + __expf(-x)); }
__device__ __forceinline__ float siluf_(float x) { return x * sigmoidf_(x); }
__device__ __forceinline__ int oldcol(int n) { return n < 2560 ? n : (n < 4608 ? n + 72 : (n < 4672 ? 2560 + (n - 4608) : 2624 + (n - 4672))); }
__device__ __forceinline__ unsigned skey(float x) { if (x == 0.f) x = 0.f; unsigned u = __float_as_uint(x); return (u & 0x80000000u) ? ~u : (u | 0x80000000u); }

__device__ void transpose_item(const float* __restrict__ W, int ldw, int nvalid, bool remap, h16* __restrict__ WT, int K, int item, float* tile) {
    const int nkt = K / 64, nb = item / nkt, kb = item % nkt, n0 = nb * 64, k0 = kb * 64, tid = threadIdx.x;
    {
        const int nl = tid & 63, kl = tid >> 6, n = n0 + nl;
        int src = -1; if (n < nvalid) src = remap ? oldcol(n) : n;
        for (int kk = kl; kk < 64; kk += 8) tile[kk * 65 + nl] = (src >= 0) ? W[(size_t)(k0 + kk) * ldw + src] : 0.f;
    }
    __syncthreads();
    {
        const int kl = tid & 63, nl = tid >> 6;
        for (int nn = nl; nn < 64; nn += 8) WT[(size_t)(n0 + nn) * K + k0 + kl] = (h16)tile[kl * 65 + nn];
    }
    __syncthreads();
}

__device__ void phase_prep(const Params& p, char* lds) {
    float* tile = (float*)lds;
    h16* WTin = (h16*)(p.ws + WS_WTIN); h16* WTout = (h16*)(p.ws + WS_WTOUT);
    constexpr int I_IN = (NPAD / 64) * (D / 64), I_OUT = (D / 64) * (D / 64);
    for (int it = blockIdx.x; it < I_IN + I_OUT; it += gridDim.x) {
        if (it < I_IN) transpose_item(p.w_in, NCOL, NCOL, true, WTin, D, it, tile);
        else transpose_item(p.w_out, D, D, false, WTout, D, it - I_IN, tile);
    }
    h16* HN = (h16*)(p.ws + WS_X);
    const int lane = threadIdx.x & 63, wave = threadIdx.x >> 6;
    for (int row = blockIdx.x * 8 + wave; row < MPAD; row += gridDim.x * 8) {
        h16* o = HN + (size_t)row * D;
        if (row >= MROWS) {
            for (int j = 0; j < 4; ++j) { h16x4 z = {(h16)0.f, (h16)0.f, (h16)0.f, (h16)0.f}; *(h16x4*)(o + (lane + 64 * j) * 4) = z; }
            continue;
        }
        const float* src = row < MREAL ? p.x + (size_t)row * D : p.meta + (size_t)(row - MREAL) * D;
        f32x4 v[4]; float ss = 0.f;
        for (int j = 0; j < 4; ++j) { v[j] = *(const f32x4*)(src + (lane + 64 * j) * 4); ss += v[j].x * v[j].x + v[j].y * v[j].y + v[j].z * v[j].z + v[j].w * v[j].w; }
        const float rs = rsqrtf(wave_sum(ss) * (1.f / D) + 1e-6f);
        for (int j = 0; j < 4; ++j) {
            const f32x4 g = *(const f32x4*)(p.mix_norm + (lane + 64 * j) * 4);
            h16x4 hv = {(h16)(v[j].x * rs * g.x), (h16)(v[j].y * rs * g.y), (h16)(v[j].z * rs * g.z), (h16)(v[j].w * rs * g.w)};
            *(h16x4*)(o + (lane + 64 * j) * 4) = hv;
        }
    }
    float* ROPE = (float*)(p.ws + WS_ROPE);
    const double inv[8] = {1.0, 0.1939227432012558, 0.03760603070259094, 0.007292664609849453, 0.0014142135623842478, 0.00027424818836152554, 5.3182957344688475e-05, 1.0313385246263351e-05};
    for (int idx = blockIdx.x * NT + threadIdx.x; idx < (S + NMETA) * 8; idx += gridDim.x * NT) {
        const int t = idx >> 3, i = idx & 7;
        double iv = inv[0];
        if (i == 1) iv = inv[1]; else if (i == 2) iv = inv[2]; else if (i == 3) iv = inv[3]; else if (i == 4) iv = inv[4]; else if (i == 5) iv = inv[5]; else if (i == 6) iv = inv[6]; else if (i == 7) iv = inv[7];
        const double rev = (double)t * iv * 0.15915494309189535;
        const float fr = (float)(rev - __builtin_rint(rev));
        ROPE[idx * 2] = __builtin_amdgcn_cosf(fr); ROPE[idx * 2 + 1] = __builtin_amdgcn_sinf(fr);
    }
}

template <int EPI>
__device__ void gemm_tile(const Params& p, const h16* __restrict__ A, int lda, const h16* __restrict__ Bt, int ldb, int K, int pm, int pn, char* lds) {
    h16* As = (h16*)lds;
    h16* Bs = As + 128 * 40;
    const int tid = threadIdx.x, lane = tid & 63, wave = tid >> 6, wr = wave >> 2, wc = wave & 3;
    const int arow = tid >> 2, apart = tid & 3;
    const h16* ag = A + (size_t)(pm * 128 + arow) * lda + apart * 8;
    const h16* bg0 = Bt + (size_t)(pn * 256 + (tid >> 2)) * ldb + apart * 8;
    const h16* bg1 = Bt + (size_t)(pn * 256 + 128 + (tid >> 2)) * ldb + apart * 8;
    f32x4 acc[4][4];
#pragma unroll
    for (int m = 0; m < 4; ++m)
#pragma unroll
        for (int n = 0; n < 4; ++n) acc[m][n] = (f32x4){0.f, 0.f, 0.f, 0.f};
    h16x8 ra = *(const h16x8*)ag, rb0 = *(const h16x8*)bg0, rb1 = *(const h16x8*)bg1;
    const int nk = K / 32;
    for (int kt = 0; kt < nk; ++kt) {
        *(h16x8*)(As + arow * 40 + apart * 8) = ra;
        *(h16x8*)(Bs + (tid >> 2) * 40 + apart * 8) = rb0;
        *(h16x8*)(Bs + (128 + (tid >> 2)) * 40 + apart * 8) = rb1;
        __syncthreads();
        if (kt + 1 < nk) { ra = *(const h16x8*)(ag + (kt + 1) * 32); rb0 = *(const h16x8*)(bg0 + (kt + 1) * 32); rb1 = *(const h16x8*)(bg1 + (kt + 1) * 32); }
        h16x8 af[4], bf[4];
#pragma unroll
        for (int m = 0; m < 4; ++m) af[m] = *(const h16x8*)(As + (wr * 64 + m * 16 + (lane & 15)) * 40 + (lane >> 4) * 8);
#pragma unroll
        for (int n = 0; n < 4; ++n) bf[n] = *(const h16x8*)(Bs + (wc * 64 + n * 16 + (lane & 15)) * 40 + (lane >> 4) * 8);
#pragma unroll
        for (int m = 0; m < 4; ++m)
#pragma unroll
            for (int n = 0; n < 4; ++n) acc[m][n] = __builtin_amdgcn_mfma_f32_16x16x32_f16(af[m], bf[n], acc[m][n], 0, 0, 0);
        __syncthreads();
    }
#pragma unroll
    for (int m = 0; m < 4; ++m)
#pragma unroll
        for (int n = 0; n < 4; ++n)
#pragma unroll
            for (int r = 0; r < 4; ++r) {
                const int grow = pm * 128 + wr * 64 + m * 16 + (lane >> 4) * 4 + r, gcol = pn * 256 + wc * 64 + n * 16 + (lane & 15);
                const float v = acc[m][n][r];
                if (EPI == 0) {
                    ((h16*)(p.ws + WS_P))[(size_t)grow * NPAD + gcol] = (h16)v;
                    if (gcol >= C_IK && gcol < C_IK + 128) ((float*)(p.ws + WS_E))[(size_t)grow * 128 + (gcol - C_IK)] = v;
                } else {
                    p.out[(size_t)grow * D + gcol] = p.x[(size_t)grow * D + gcol] + v;
                }
            }
}

__device__ void phase_gemm_in(const Params& p, char* lds) {
    constexpr int NM = MPAD / 128, NN = NPAD / 256;
    for (int t = blockIdx.x; t < NM * NN; t += gridDim.x)
        gemm_tile<0>(p, (const h16*)(p.ws + WS_X), D, (const h16*)(p.ws + WS_WTIN), D, D, t / NN, t % NN, lds);
}
__device__ void phase_gemm_out(const Params& p, char* lds) {
    constexpr int NM = MREAL / 128, NN = D / 256;
    for (int t = blockIdx.x; t < NM * NN; t += gridDim.x)
        gemm_tile<1>(p, (const h16*)(p.ws + WS_X), D, (const h16*)(p.ws + WS_WTOUT), D, D, t / NN, t % NN, lds);
}

__device__ void phase_post(const Params& p) {
    h16* P = (h16*)(p.ws + WS_P); const float* E = (const float*)(p.ws + WS_E); h16* KI = (h16*)(p.ws + WS_KI); const float* ROPE = (const float*)(p.ws + WS_ROPE);
    const int lane = threadIdx.x & 63, wave = threadIdx.x >> 6;
    for (int row = blockIdx.x * 8 + wave; row < MROWS; row += gridDim.x * 8) {
        const int t = row < MREAL ? NMETA + (row & (S - 1)) : row - MREAL;
        h16* pr = P + (size_t)row * NPAD;
        for (int pi = lane; pi < 192; pi += 64) {
            const int tensor = pi >> 6, head = (pi >> 3) & 7, i = pi & 7;
            const int base = (tensor == 0 ? C_AQ : (tensor == 1 ? C_AK : C_IQ)) + head * 64;
            const float c = ROPE[(t * 8 + i) * 2], s = ROPE[(t * 8 + i) * 2 + 1];
            const float x1 = (float)pr[base + i], x2 = (float)pr[base + i + 8];
            pr[base + i] = (h16)(x1 * c - x2 * s); pr[base + i + 8] = (h16)(x2 * c + x1 * s);
        }
        const float v = E[(size_t)row * 128 + lane];
        const float mean = wave_sum(v) * (1.f / 64.f); const float d = v - mean;
        const float var = wave_sum(d * d) * (1.f / 64.f);
        float y = d * rsqrtf(var + 1e-6f) * p.idx_g[lane] + p.idx_b[lane];
        const float other = __shfl_xor(y, 8);
        if (lane < 16) {
            const int i = lane & 7; const float c = ROPE[(t * 8 + i) * 2], s = ROPE[(t * 8 + i) * 2 + 1];
            y = lane < 8 ? (y * c - other * s) : (y * c + other * s);
        }
        KI[(size_t)row * 64 + lane] = (h16)y;
    }
}

__device__ void attn_item_naive(const Params& p, int q, char* lds) {
    float* sc = (float*)lds;
    float* qi = sc + 8192;
    float* wq = qi + 512;
    unsigned* hist = (unsigned*)(wq + 16);
    int* sel = (int*)(hist + 256);
    int* misc = sel + 272;
    float* aq = (float*)(misc + 16);
    float* ps = aq + 512;
    h16* P = (h16*)(p.ws + WS_P); const float* E = (const float*)(p.ws + WS_E); const h16* KI = (const h16*)(p.ws + WS_KI);
    const int tid = threadIdx.x, lane = tid & 63, wave = tid >> 6;
    const int b = q >> 13, r = q & (S - 1), n = r + 1;
    const size_t qrow = (size_t)q;
    qi[tid] = (float)P[qrow * NPAD + C_IQ + tid];
    aq[tid] = (float)P[qrow * NPAD + C_AQ + tid];
    if (tid < 8) wq[tid] = E[qrow * 128 + 64 + tid];
    __syncthreads();
    int cnt;
    if (n > 256) {
        for (int s = tid; s < n; s += NT) {
            const h16* kp = KI + (size_t)(b * S + s) * 64;
            float dot[8];
#pragma unroll
            for (int h = 0; h < 8; ++h) dot[h] = 0.f;
#pragma unroll 1
            for (int c = 0; c < 8; ++c) { const h16x8 hv = *(const h16x8*)(kp + c * 8);
#pragma unroll
                for (int h = 0; h < 8; ++h)
#pragma unroll
                    for (int j = 0; j < 8; ++j) dot[h] += qi[h * 64 + c * 8 + j] * (float)hv[j]; }
            float score = 0.f;
#pragma unroll
            for (int h = 0; h < 8; ++h) score += wq[h] * fmaxf(dot[h], 0.f);
            sc[s] = score;
        }
        __syncthreads();
        unsigned prefix = 0; int need = 256, cnt_eq = 0;
        for (int pass = 0; pass < 4; ++pass) {
            const int shift = 24 - 8 * pass;
            if (tid < 256) hist[tid] = 0;
            __syncthreads();
            const unsigned himask = pass == 0 ? 0u : (0xFFFFFFFFu << (shift + 8));
            for (int s = tid; s < n; s += NT) { const unsigned k = skey(sc[s]); if ((k & himask) == (prefix & himask)) atomicAdd(&hist[(k >> shift) & 255], 1u); }
            __syncthreads();
            if (tid == 0) { int cum = 0, bsel = 0; for (int bb = 255; bb >= 0; --bb) { const int c = (int)hist[bb]; if (cum + c >= need) { bsel = bb; break; } cum += c; } misc[0] = bsel; misc[1] = need - cum; misc[2] = (int)hist[bsel]; }
            __syncthreads();
            prefix |= (unsigned)misc[0] << shift; need = misc[1]; cnt_eq = misc[2];
            __syncthreads();
        }
        if (tid == 0) misc[3] = 0;
        __syncthreads();
        for (int s = tid; s < n; s += NT) { const unsigned k = skey(sc[s]); if (k > prefix || (k == prefix && cnt_eq == need)) { const int pos = atomicAdd(&misc[3], 1); if (pos < 256) sel[16 + pos] = s; } }
        __syncthreads();
        if (cnt_eq != need && tid == 0) { int c = 0; int base = misc[3]; for (int s = 0; s < n && c < need; ++s) if (skey(sc[s]) == prefix) { if (base + c < 256) sel[16 + base + c] = s; ++c; } misc[3] = base + c; }
        __syncthreads();
        cnt = misc[3]; if (cnt > 256) cnt = 256;
    } else {
        for (int s = tid; s < n; s += NT) sel[16 + s] = s;
        cnt = n;
        __syncthreads();
    }
    const int nk = 16 + cnt;
    const int h = wave;
    float mx = -INFINITY;
    for (int j = lane; j < nk; j += 64) {
        const size_t krow = j < 16 ? (size_t)(MREAL + j) : (size_t)(b * S + sel[j]);
        const h16* kp = P + krow * NPAD + C_AK + h * 64;
        float dot = 0.f;
#pragma unroll
        for (int c = 0; c < 8; ++c) { const h16x8 hv = *(const h16x8*)(kp + c * 8);
#pragma unroll
            for (int jj = 0; jj < 8; ++jj) dot += aq[h * 64 + c * 8 + jj] * (float)hv[jj]; }
        dot *= 0.125f; ps[h * 272 + j] = dot; mx = fmaxf(mx, dot);
    }
    mx = wave_max(mx);
    float sum = 0.f;
    for (int j = lane; j < nk; j += 64) { const float e = __expf(ps[h * 272 + j] - mx); ps[h * 272 + j] = e; sum += e; }
    sum = wave_sum(sum);
    __syncthreads();
    float acc = 0.f;
    for (int j = 0; j < nk; ++j) {
        const size_t krow = j < 16 ? (size_t)(MREAL + j) : (size_t)(b * S + sel[j]);
        acc += ps[h * 272 + j] * (float)P[krow * NPAD + C_AV + h * 64 + lane];
    }
    P[qrow * NPAD + C_AQ + h * 64 + lane] = (h16)(acc / sum);
    __syncthreads();
}

__device__ __forceinline__ float hgrn_lb(const Params& p, int idx) { const float l0 = p.lb_logits[idx], l1 = p.lb_logits[512 + idx]; return 1.f / (1.f + __expf(l1 - l0)); }

__device__ void hgrn_stepA(const Params& p, int item, char* lds) {
    float* kd = (float*)lds;
    float* kk = kd + 64 * 128;
    float* vv = kk + 64 * 128;
    const h16* P = (const h16*)(p.ws + WS_P); float* ST = (float*)(p.ws + WS_X); float* G = (float*)(p.ws + WS_G);
    const int tid = threadIdx.x;
    const int c = item % NCH, bh = item / NCH, h = bh & 3, b = bh >> 2;
    const int L = c == 0 ? 16 : 64; const size_t rowbase = c == 0 ? (size_t)MREAL : (size_t)(b * S + (c - 1) * 64);
    for (int i = tid; i < L * 128; i += NT) { const int t = i >> 7, v = i & 127; vv[t * 128 + v] = (float)P[(rowbase + t) * NPAD + C_HI + h * 128 + v]; }
    if (tid < 128) {
        const int d = tid; const float lb = hgrn_lb(p, h * 128 + d);
        float bc = 0.f;
        for (int t = 0; t < L; ++t) {
            const float hf = (float)P[(rowbase + t) * NPAD + C_HF + h * 128 + d];
            const float f = lb + (1.f - lb) * sigmoidf_(hf);
            bc += logf(f); kd[t * 128 + d] = bc; kk[t * 128 + d] = 1.f - f;
        }
        for (int t = 0; t < L; ++t) kd[t * 128 + d] = kk[t * 128 + d] * __expf(bc - kd[t * 128 + d]);
        G[(size_t)item * 128 + d] = __expf(bc);
    }
    __syncthreads();
    const int d = tid & 127, vg = tid >> 7;
    float acc[32];
#pragma unroll
    for (int j = 0; j < 32; ++j) acc[j] = 0.f;
    for (int s = 0; s < L; ++s) {
        const float kv = kd[s * 128 + d];
#pragma unroll
        for (int j = 0; j < 32; j += 4) { const f32x4 v4 = *(const f32x4*)(vv + s * 128 + vg * 32 + j); acc[j] += kv * v4.x; acc[j + 1] += kv * v4.y; acc[j + 2] += kv * v4.z; acc[j + 3] += kv * v4.w; }
    }
    float* o = ST + (size_t)item * 16384 + d * 128 + vg * 32;
#pragma unroll
    for (int j = 0; j < 32; j += 4) *(f32x4*)(o + j) = (f32x4){acc[j], acc[j + 1], acc[j + 2], acc[j + 3]};
    __syncthreads();
}

__device__ void hgrn_scan(const Params& p) {
    float* ST = (float*)(p.ws + WS_X); const float* G = (const float*)(p.ws + WS_G);
    for (int idx = blockIdx.x * NT + threadIdx.x; idx < NB * 4 * 16384; idx += gridDim.x * NT) {
        const int bh = idx >> 14, e = idx & 16383, d = e >> 7;
        float Sv = 0.f;
        for (int c = 0; c < NCH; ++c) {
            const size_t off = (size_t)(bh * NCH + c) * 16384 + e;
            const float u = ST[off]; const float g = G[(size_t)(bh * NCH + c) * 128 + d];
            ST[off] = Sv; Sv = g * Sv + u;
        }
    }
}

__device__ void hgrn_stepC(const Params& p, int item, char* lds) {
    float* bq = (float*)lds;
    float* qq = bq + 64 * 65;
    float* kk = qq + 64 * 65;
    float* Am = kk + 64 * 65;
    float* qe = Am + 64 * 65;
    float* vv = qe + 64 * 128;
    h16* P = (h16*)(p.ws + WS_P); const float* ST = (const float*)(p.ws + WS_X);
    const int tid = threadIdx.x;
    const int c = 1 + item % 128, bh = item / 128, h = bh & 3, b = bh >> 2;
    const size_t rowbase = (size_t)(b * S + (c - 1) * 64);
    for (int i = tid; i < 64 * 128; i += NT) { const int t = i >> 7, v = i & 127; vv[t * 128 + v] = (float)P[(rowbase + t) * NPAD + C_HI + h * 128 + v]; }
    float aacc[8];
#pragma unroll
    for (int i = 0; i < 8; ++i) aacc[i] = 0.f;
    for (int half = 0; half < 2; ++half) {
        if (tid < 64) {
            const int d = half * 64 + tid; const float lb = hgrn_lb(p, h * 128 + d);
            float bc = 0.f;
            for (int t = 0; t < 64; ++t) {
                const float hf = (float)P[(rowbase + t) * NPAD + C_HF + h * 128 + d];
                const float f = lb + (1.f - lb) * sigmoidf_(hf);
                bc += logf(f); bq[t * 65 + tid] = bc; kk[t * 65 + tid] = 1.f - f;
            }
        }
        for (int i = tid; i < 64 * 64; i += NT) { const int t = i >> 6, dl = i & 63; qq[t * 65 + dl] = siluf_((float)P[(rowbase + t) * NPAD + C_HQ + h * 128 + half * 64 + dl]); }
        __syncthreads();
#pragma unroll
        for (int i = 0; i < 8; ++i) {
            const int pr = tid + NT * i, t = pr >> 6, s = pr & 63;
            if (s <= t) { float sum = 0.f;
                for (int dl = 0; dl < 64; ++dl) sum += qq[t * 65 + dl] * kk[s * 65 + dl] * __expf(bq[t * 65 + dl] - bq[s * 65 + dl]);
                aacc[i] += sum; }
        }
        for (int i = tid; i < 64 * 64; i += NT) { const int t = i >> 6, dl = i & 63; qe[t * 128 + half * 64 + dl] = qq[t * 65 + dl] * __expf(bq[t * 65 + dl]); }
        __syncthreads();
    }
#pragma unroll
    for (int i = 0; i < 8; ++i) { const int pr = tid + NT * i, t = pr >> 6, s = pr & 63; Am[t * 65 + s] = aacc[i]; }
    __syncthreads();
    const int v = tid & 127, tg = tid >> 7;
    float acc[16];
#pragma unroll
    for (int i = 0; i < 16; ++i) acc[i] = 0.f;
    for (int s = 0; s < 64; ++s) { const float vval = vv[s * 128 + v];
#pragma unroll
        for (int i = 0; i < 16; ++i) acc[i] += Am[(tg * 16 + i) * 65 + s] * vval; }
    const float* sp = ST + (size_t)(bh * NCH + c) * 16384 + v;
    for (int d = 0; d < 128; ++d) { const float sv = sp[d * 128];
#pragma unroll
        for (int i = 0; i < 16; ++i) acc[i] += qe[(tg * 16 + i) * 128 + d] * sv; }
#pragma unroll
    for (int i = 0; i < 16; ++i) P[(rowbase + tg * 16 + i) * NPAD + C_HQ + h * 128 + v] = (h16)acc[i];
    __syncthreads();
}

__device__ void phase_mix(const Params& p) {
    const h16* P = (const h16*)(p.ws + WS_P); h16* MIX = (h16*)(p.ws + WS_X);
    const int lane = threadIdx.x & 63, wave = threadIdx.x >> 6;
    for (int row = blockIdx.x * 8 + wave; row < MREAL; row += gridDim.x * 8) {
        const h16* pr = P + (size_t)row * NPAD; h16* o = MIX + (size_t)row * D;
        { const h16x8 a = *(const h16x8*)(pr + C_AQ + lane * 8); const h16x8 g = *(const h16x8*)(pr + C_AG + lane * 8);
          float ss = 0.f;
#pragma unroll
          for (int j = 0; j < 8; ++j) ss += (float)a[j] * (float)a[j];
          const float rs = rsqrtf(wave_sum(ss) * (1.f / 512.f) + 1e-6f);
          h16x8 ov;
#pragma unroll
          for (int j = 0; j < 8; ++j) ov[j] = (h16)((float)a[j] * rs * p.attn_norm[lane * 8 + j] * siluf_((float)g[j]));
          *(h16x8*)(o + lane * 8) = ov; }
        { const h16x8 a = *(const h16x8*)(pr + C_HQ + lane * 8); const h16x8 g = *(const h16x8*)(pr + C_HG + lane * 8);
          float ss = 0.f;
#pragma unroll
          for (int j = 0; j < 8; ++j) ss += (float)a[j] * (float)a[j];
#pragma unroll
          for (int o2 = 1; o2 < 16; o2 <<= 1) ss += __shfl_xor(ss, o2);
          const float rs = rsqrtf(ss * (1.f / 128.f) + 1e-6f);
          h16x8 ov;
#pragma unroll
          for (int j = 0; j < 8; ++j) ov[j] = (h16)((float)a[j] * rs * p.hgrn_norm[(lane & 15) * 8 + j] * siluf_((float)g[j]));
          *(h16x8*)(o + 512 + lane * 8) = ov; }
    }
}

__device__ void phase_final(const Params& p) {
    const int lane = threadIdx.x & 63, wave = threadIdx.x >> 6;
    for (int row = blockIdx.x * 8 + wave; row < MREAL; row += gridDim.x * 8) {
        float* o = p.out + (size_t)row * D;
        f32x4 v[4]; float ss = 0.f;
        for (int j = 0; j < 4; ++j) { v[j] = *(const f32x4*)(o + (lane + 64 * j) * 4); ss += v[j].x * v[j].x + v[j].y * v[j].y + v[j].z * v[j].z + v[j].w * v[j].w; }
        const float rs = rsqrtf(wave_sum(ss) * (1.f / D) + 1e-6f);
        for (int j = 0; j < 4; ++j) { const f32x4 g = *(const f32x4*)(p.final_norm + (lane + 64 * j) * 4);
            *(f32x4*)(o + (lane + 64 * j) * 4) = (f32x4){v[j].x * rs * g.x, v[j].y * rs * g.y, v[j].z * rs * g.z, v[j].w * rs * g.w}; }
    }
}

constexpr int NPHASE = 9;
__global__ void __launch_bounds__(NT, 2) mega(Params p, int ph_lo, int ph_hi) {
    extern __shared__ __attribute__((aligned(16))) char lds[];
    cg::grid_group grid = cg::this_grid();
    for (int ph = ph_lo; ph < ph_hi; ++ph) {
        switch (ph) {
        case 0: phase_prep(p, lds); break;
        case 1: phase_gemm_in(p, lds); break;
        case 2: phase_post(p); break;
        case 3: {
            constexpr int NA = NB * 4 * NCH;
            for (int it = blockIdx.x; it < NA + MREAL; it += gridDim.x) { if (it < NA) hgrn_stepA(p, it, lds); else attn_item_naive(p, it - NA, lds); }
        } break;
        case 4: hgrn_scan(p); break;
        case 5: for (int it = blockIdx.x; it < NB * 4 * 128; it += gridDim.x) hgrn_stepC(p, it, lds); break;
        case 6: phase_mix(p); break;
        case 7: phase_gemm_out(p, lds); break;
        case 8: phase_final(p); break;
        }
        if (ph + 1 < ph_hi) grid.sync();
    }
}

extern "C" void kernel_launch(void* const* d_in, const int* in_sizes, int n_in, void* d_out, int out_size, void* d_ws, size_t ws_size, hipStream_t stream) {
    static int grid = 0;
    if (grid == 0) {
        if (n_in != 11 || ws_size < WS_END || out_size != MREAL * D) { fprintf(stderr, "kernel_launch: unexpected shapes n_in %d ws %zu out %d\n", n_in, ws_size, out_size); grid = -1; return; }
        int dev = 0, cus = 0, per_cu = 0;
        hipGetDevice(&dev); hipDeviceGetAttribute(&cus, hipDeviceAttributeMultiprocessorCount, dev);
        hipFuncSetAttribute((const void*)mega, hipFuncAttributeMaxDynamicSharedMemorySize, LDS_BYTES);
        hipOccupancyMaxActiveBlocksPerMultiprocessor(&per_cu, (const void*)mega, NT, LDS_BYTES);
        if (per_cu < 1) { fprintf(stderr, "kernel_launch: occupancy query says %d\n", per_cu); per_cu = 1; }
        grid = cus * 1;
        (void)hipGetLastError();
    }
    if (grid < 0) return;
    Params p{};
    p.x = (const float*)d_in[0]; p.meta = (const float*)d_in[1]; p.mix_norm = (const float*)d_in[2]; p.w_in = (const float*)d_in[3];
    p.idx_g = (const float*)d_in[4]; p.idx_b = (const float*)d_in[5]; p.attn_norm = (const float*)d_in[6]; p.lb_logits = (const float*)d_in[7];
    p.hgrn_norm = (const float*)d_in[8]; p.w_out = (const float*)d_in[9]; p.final_norm = (const float*)d_in[10];
    p.out = (float*)d_out; p.ws = (unsigned char*)d_ws;
#if N_LAUNCH_MODE == 1
    int lo = 0, hi = NPHASE; void* args[] = {&p, &lo, &hi};
    hipError_t e = hipLaunchCooperativeKernel((const void*)mega, dim3(grid), dim3(NT), args, LDS_BYTES, stream);
    if (e != hipSuccess) fprintf(stderr, "cooperative launch failed: %s (grid %d)\n", hipGetErrorString(e), grid);
#else
    for (int ph = 0; ph < NPHASE; ++ph) hipLaunchKernelGGL(mega, dim3(grid), dim3(NT), LDS_BYTES, stream, p, ph, ph + 1);
#endif
}
```

```cpp
#include <hip/hip_runtime.h>
#include <hip/hip_cooperative_groups.h>
#include <cstdint>
#include <cstdio>
namespace cg = cooperative_groups;

typedef _Float16 h16;
typedef _Float16 h16x8 __attribute__((ext_vector_type(8)));
typedef _Float16 h16x4 __attribute__((ext_vector_type(4)));
typedef float f32x4 __attribute__((ext_vector_type(4)));

#ifndef N_LAUNCH_MODE
#define N_LAUNCH_MODE 1
#endif

constexpr int NB = 2, S = 8192, NMETA = 16, D = 1024;
constexpr int MREAL = NB * S;
constexpr int MROWS = MREAL + NMETA;
constexpr int MPAD = 16640;
constexpr int NCOL = 4680, NPAD = 4864;
constexpr int C_AQ = 0, C_AK = 512, C_AV = 1024, C_AG = 1536, C_IQ = 2048, C_HQ = 2560, C_HF = 3072, C_HI = 3584, C_HG = 4096, C_IK = 4608, C_IW = 4672;
constexpr int NCH = 129;
constexpr int NT = 512;

constexpr size_t MiB = 1u << 20;
constexpr size_t WS_WTIN = 1 * MiB, WS_WTOUT = 11 * MiB, WS_ROPE = 13 * MiB, WS_E = 14 * MiB, WS_KI = 23 * MiB, WS_G = 26 * MiB, WS_P = 27 * MiB, WS_X = 182 * MiB, WS_END = 256 * MiB;
static_assert(WS_P + (size_t)MPAD * NPAD * 2 <= WS_X, "P");
static_assert(WS_X + (size_t)NB * 4 * NCH * 16384 * 4 <= WS_END, "ST");

constexpr int LDS_BYTES = 140 * 1024;

struct Params {
    const float *x, *meta, *mix_norm, *w_in, *idx_g, *idx_b, *attn_norm, *lb_logits, *hgrn_norm, *w_out, *final_norm;
    float* out; unsigned char* ws;
};

__device__ __forceinline__ float wave_sum(float v) {
#pragma unroll
    for (int o = 1; o < 64; o <<= 1) v += __shfl_xor(v, o);
    return v;
}
__device__ __forceinline__ float wave_max(float v) {
#pragma unroll
    for (int o = 1; o < 64; o <<= 1) v = fmaxf(v, __shfl_xor(v, o));
    return v;
}
__device__ __forceinline__ float sigmoidf_(float x) { return 1.f / (1.f + __expf(-x)); }
__device__ __forceinline__ float siluf_(float x) { return x * sigmoidf_(x); }
__device__ __forceinline__ int oldcol(int n) { return n < 2560 ? n : (n < 4608 ? n + 72 : (n < 4672 ? 2560 + (n - 4608) : 2624 + (n - 4672))); }
__device__ __forceinline__ unsigned skey(float x) { if (x == 0.f) x = 0.f; unsigned u = __float_as_uint(x); return (u & 0x80000000u) ? ~u : (u | 0x80000000u); }

__device__ void transpose_item(const float* __restrict__ W, int ldw, int nvalid, bool remap, h16* __restrict__ WT, int K, int item, float* tile) {
    const int nkt = K / 64, nb = item / nkt, kb = item % nkt, n0 = nb * 64, k0 = kb * 64, tid = threadIdx.x;
    {
        const int nl = tid & 63, kl = tid >> 6, n = n0 + nl;
        int src = -1; if (n < nvalid) src = remap ? oldcol(n) : n;
        for (int kk = kl; kk < 64; kk += 8) tile[kk * 65 + nl] = (src >= 0) ? W[(size_t)(k0 + kk) * ldw + src] : 0.f;
    }
    __syncthreads();
    {
        const int kl = tid & 63, nl = tid >> 6;
        for (int nn = nl; nn < 64; nn += 8) WT[(size_t)(n0 + nn) * K + k0 + kl] = (h16)tile[kl * 65 + nn];
    }
    __syncthreads();
}

__device__ void phase_prep(const Params& p, char* lds) {
    float* tile = (float*)lds;
    h16* WTin = (h16*)(p.ws + WS_WTIN); h16* WTout = (h16*)(p.ws + WS_WTOUT);
    constexpr int I_IN = (NPAD / 64) * (D / 64), I_OUT = (D / 64) * (D / 64);
    for (int it = blockIdx.x; it < I_IN + I_OUT; it += gridDim.x) {
        if (it < I_IN) transpose_item(p.w_in, NCOL, NCOL, true, WTin, D, it, tile);
        else transpose_item(p.w_out, D, D, false, WTout, D, it - I_IN, tile);
    }
    h16* HN = (h16*)(p.ws + WS_X);
    const int lane = threadIdx.x & 63, wave = threadIdx.x >> 6;
    for (int row = blockIdx.x * 8 + wave; row < MPAD; row += gridDim.x * 8) {
        h16* o = HN + (size_t)row * D;
        if (row >= MROWS) {
            for (int j = 0; j < 4; ++j) { h16x4 z = {(h16)0.f, (h16)0.f, (h16)0.f, (h16)0.f}; *(h16x4*)(o + (lane + 64 * j) * 4) = z; }
            continue;
        }
        const float* src = row < MREAL ? p.x + (size_t)row * D : p.meta + (size_t)(row - MREAL) * D;
        f32x4 v[4]; float ss = 0.f;
        for (int j = 0; j < 4; ++j) { v[j] = *(const f32x4*)(src + (lane + 64 * j) * 4); ss += v[j].x * v[j].x + v[j].y * v[j].y + v[j].z * v[j].z + v[j].w * v[j].w; }
        const float rs = rsqrtf(wave_sum(ss) * (1.f / D) + 1e-6f);
        for (int j = 0; j < 4; ++j) {
            const f32x4 g = *(const f32x4*)(p.mix_norm + (lane + 64 * j) * 4);
            h16x4 hv = {(h16)(v[j].x * rs * g.x), (h16)(v[j].y * rs * g.y), (h16)(v[j].z * rs * g.z), (h16)(v[j].w * rs * g.w)};
            *(h16x4*)(o + (lane + 64 * j) * 4) = hv;
        }
    }
    float* ROPE = (float*)(p.ws + WS_ROPE);
    const double inv[8] = {1.0, 0.1939227432012558, 0.03760603070259094, 0.007292664609849453, 0.0014142135623842478, 0.00027424818836152554, 5.3182957344688475e-05, 1.0313385246263351e-05};
    for (int idx = blockIdx.x * NT + threadIdx.x; idx < (S + NMETA) * 8; idx += gridDim.x * NT) {
        const int t = idx >> 3, i = idx & 7;
        double iv = inv[0];
        if (i == 1) iv = inv[1]; else if (i == 2) iv = inv[2]; else if (i == 3) iv = inv[3]; else if (i == 4) iv = inv[4]; else if (i == 5) iv = inv[5]; else if (i == 6) iv = inv[6]; else if (i == 7) iv = inv[7];
        const double rev = (double)t * iv * 0.15915494309189535;
        const float fr = (float)(rev - __builtin_rint(rev));
        ROPE[idx * 2] = __builtin_amdgcn_cosf(fr); ROPE[idx * 2 + 1] = __builtin_amdgcn_sinf(fr);
    }
}

template <int EPI>
__device__ void gemm_tile(const Params& p, const h16* __restrict__ A, int lda, const h16* __restrict__ Bt, int ldb, int K, int pm, int pn, char* lds) {
    h16* As = (h16*)lds;
    h16* Bs = As + 128 * 40;
    const int tid = threadIdx.x, lane = tid & 63, wave = tid >> 6, wr = wave >> 2, wc = wave & 3;
    const int arow = tid >> 2, apart = tid & 3;
    const h16* ag = A + (size_t)(pm * 128 + arow) * lda + apart * 8;
    const h16* bg0 = Bt + (size_t)(pn * 256 + (tid >> 2)) * ldb + apart * 8;
    const h16* bg1 = Bt + (size_t)(pn * 256 + 128 + (tid >> 2)) * ldb + apart * 8;
    f32x4 acc[4][4];
#pragma unroll
    for (int m = 0; m < 4; ++m)
#pragma unroll
        for (int n = 0; n < 4; ++n) acc[m][n] = (f32x4){0.f, 0.f, 0.f, 0.f};
    h16x8 ra = *(const h16x8*)ag, rb0 = *(const h16x8*)bg0, rb1 = *(const h16x8*)bg1;
    const int nk = K / 32;
    for (int kt = 0; kt < nk; ++kt) {
        *(h16x8*)(As + arow * 40 + apart * 8) = ra;
        *(h16x8*)(Bs + (tid >> 2) * 40 + apart * 8) = rb0;
        *(h16x8*)(Bs + (128 + (tid >> 2)) * 40 + apart * 8) = rb1;
        __syncthreads();
        if (kt + 1 < nk) { ra = *(const h16x8*)(ag + (kt + 1) * 32); rb0 = *(const h16x8*)(bg0 + (kt + 1) * 32); rb1 = *(const h16x8*)(bg1 + (kt + 1) * 32); }
        h16x8 af[4], bf[4];
#pragma unroll
        for (int m = 0; m < 4; ++m) af[m] = *(const h16x8*)(As + (wr * 64 + m * 16 + (lane & 15)) * 40 + (lane >> 4) * 8);
#pragma unroll
        for (int n = 0; n < 4; ++n) bf[n] = *(const h16x8*)(Bs + (wc * 64 + n * 16 + (lane & 15)) * 40 + (lane >> 4) * 8);
#pragma unroll
        for (int m = 0; m < 4; ++m)
#pragma unroll
            for (int n = 0; n < 4; ++n) acc[m][n] = __builtin_amdgcn_mfma_f32_16x16x32_f16(af[m], bf[n], acc[m][n], 0, 0, 0);
        __syncthreads();
    }
#pragma unroll
    for (int m = 0; m < 4; ++m)
#pragma unroll
        for (int n = 0; n < 4; ++n)
#pragma unroll
            for (int r = 0; r < 4; ++r) {
                const int grow = pm * 128 + wr * 64 + m * 16 + (lane >> 4) * 4 + r, gcol = pn * 256 + wc * 64 + n * 16 + (lane & 15);
                const float v = acc[m][n][r];
                if (EPI == 0) {
                    ((h16*)(p.ws + WS_P))[(size_t)grow * NPAD + gcol] = (h16)v;
                    if (gcol >= C_IK && gcol < C_IK + 128) ((float*)(p.ws + WS_E))[(size_t)grow * 128 + (gcol - C_IK)] = v;
                } else {
                    p.out[(size_t)grow * D + gcol] = p.x[(size_t)grow * D + gcol] + v;
                }
            }
}

__device__ void phase_gemm_in(const Params& p, char* lds) {
    constexpr int NM = MPAD / 128, NN = NPAD / 256;
    for (int t = blockIdx.x; t < NM * NN; t += gridDim.x)
        gemm_tile<0>(p, (const h16*)(p.ws + WS_X), D, (const h16*)(p.ws + WS_WTIN), D, D, t / NN, t % NN, lds);
}
__device__ void phase_gemm_out(const Params& p, char* lds) {
    constexpr int NM = MREAL / 128, NN = D / 256;
    for (int t = blockIdx.x; t < NM * NN; t += gridDim.x)
        gemm_tile<1>(p, (const h16*)(p.ws + WS_X), D, (const h16*)(p.ws + WS_WTOUT), D, D, t / NN, t % NN, lds);
}

__device__ void phase_post(const Params& p) {
    h16* P = (h16*)(p.ws + WS_P); const float* E = (const float*)(p.ws + WS_E); h16* KI = (h16*)(p.ws + WS_KI); const float* ROPE = (const float*)(p.ws + WS_ROPE);
    const int lane = threadIdx.x & 63, wave = threadIdx.x >> 6;
    for (int row = blockIdx.x * 8 + wave; row < MROWS; row += gridDim.x * 8) {
        const int t = row < MREAL ? NMETA + (row & (S - 1)) : row - MREAL;
        h16* pr = P + (size_t)row * NPAD;
        for (int pi = lane; pi < 192; pi += 64) {
            const int tensor = pi >> 6, head = (pi >> 3) & 7, i = pi & 7;
            const int base = (tensor == 0 ? C_AQ : (tensor == 1 ? C_AK : C_IQ)) + head * 64;
            const float c = ROPE[(t * 8 + i) * 2], s = ROPE[(t * 8 + i) * 2 + 1];
            const float x1 = (float)pr[base + i], x2 = (float)pr[base + i + 8];
            pr[base + i] = (h16)(x1 * c - x2 * s); pr[base + i + 8] = (h16)(x2 * c + x1 * s);
        }
        const float v = E[(size_t)row * 128 + lane];
        const float mean = wave_sum(v) * (1.f / 64.f); const float d = v - mean;
        const float var = wave_sum(d * d) * (1.f / 64.f);
        float y = d * rsqrtf(var + 1e-6f) * p.idx_g[lane] + p.idx_b[lane];
        const float other = __shfl_xor(y, 8);
        if (lane < 16) {
            const int i = lane & 7; const float c = ROPE[(t * 8 + i) * 2], s = ROPE[(t * 8 + i) * 2 + 1];
            y = lane < 8 ? (y * c - other * s) : (y * c + other * s);
        }
        KI[(size_t)row * 64 + lane] = (h16)y;
    }
}

constexpr int NMI = 130;
constexpr int QB = 32, CAP = 128;
constexpr int IX_KB = 0, IX_HIST = 16384, IX_MASK = 49152, IX_CAND = 82432, IX_ST = 98816, IX_FLAG = 99840;
typedef float f32x16 __attribute__((ext_vector_type(16)));
#define ST_LO 0
#define ST_HI 1
#define ST_NEED 2
#define ST_CNT 3
#define ST_FLAGS 4
#define ST_NCAND 5
#define ST_SH 6
#define ST_RUN 7
#define FL_ACTIVE 1u
#define FL_TIE 2u

__device__ __forceinline__ unsigned skey_c(float x) { x = x + 0.f; const unsigned u = __float_as_uint(x); return u ^ (((unsigned)((int)u >> 31)) | 0x80000000u); }
__device__ __forceinline__ int custom_bin(unsigned key) {
    const int k14 = (int)(key >> 18); const int a = k14 - 12000, bb = k14 - 3873;
    const int lowpart = min(max(bb, 0), 255);
    return max(min(a, 511), lowpart);
}

template <int MODE>
__device__ __forceinline__ void idx_pass(const Params& p, int b, int u, char* lds, const h16x8 (&afrag)[4], const float (&wreg)[16]) {
    const h16* KI = (const h16*)(p.ws + WS_KI) + (size_t)b * S * 64;
    unsigned* HIST = (unsigned*)(lds + IX_HIST); unsigned* MASK = (unsigned*)(lds + IX_MASK); unsigned* CAND = (unsigned*)(lds + IX_CAND); unsigned* ST = (unsigned*)(lds + IX_ST);
    const int tid = threadIdx.x, lane = tid & 63, w = tid >> 6, hl = lane >> 5, cc = lane & 31;
    const int tq = u >> 1;
    const int qA = 4 * w + hl, qB = 4 * w + 2 + hl;
    const int rA = 32 * u + qA, rB = 32 * u + qB;
    unsigned loA = 0, hiA = 0, loB = 0, hiB = 0, flA = 0, flB = 0, shA = 0, shB = 0, needA = 0, needB = 0, runA = 0, runB = 0;
    if (MODE != 0) { loA = ST[qA * 8 + ST_LO]; hiA = ST[qA * 8 + ST_HI]; flA = ST[qA * 8 + ST_FLAGS]; shA = ST[qA * 8 + ST_SH]; needA = ST[qA * 8 + ST_NEED];
                     loB = ST[qB * 8 + ST_LO]; hiB = ST[qB * 8 + ST_HI]; flB = ST[qB * 8 + ST_FLAGS]; shB = ST[qB * 8 + ST_SH]; needB = ST[qB * 8 + ST_NEED]; }
    const bool anyTie = (MODE == 2) && (__ballot((flA | flB) & FL_TIE) != 0ull);
    const int si = tid >> 3, sc_ = tid & 7;
    const int sdst = si * 128 + ((sc_ ^ ((si >> 1) & 7)) << 4);
    h16x8 reg = *(const h16x8*)(KI + (size_t)si * 64 + sc_ * 8);
    *(h16x8*)(lds + IX_KB + sdst) = reg;
    __syncthreads();
    for (int t = 0; t <= tq; ++t) {
        if (t < tq) reg = *(const h16x8*)(KI + (size_t)(64 * (t + 1) + si) * 64 + sc_ * 8);
        const char* kb = lds + IX_KB + (t & 1) * 8192;
#pragma unroll
        for (int kh = 0; kh < 2; ++kh) {
            f32x16 acc = {0.f, 0.f, 0.f, 0.f, 0.f, 0.f, 0.f, 0.f, 0.f, 0.f, 0.f, 0.f, 0.f, 0.f, 0.f, 0.f};
            const int ki = 32 * kh + cc;
#pragma unroll
            for (int ks = 0; ks < 4; ++ks) {
                const h16x8 bfrag = *(const h16x8*)(kb + ki * 128 + (((2 * ks + hl) ^ ((ki >> 1) & 7)) << 4));
                acc = __builtin_amdgcn_mfma_f32_32x32x16_f16(afrag[ks], bfrag, acc, 0, 0, 0);
            }
            float pq[4];
#pragma unroll
            for (int q4 = 0; q4 < 4; ++q4)
                pq[q4] = __builtin_fmaf(wreg[4 * q4 + 3], fmaxf(acc[4 * q4 + 3], 0.f), __builtin_fmaf(wreg[4 * q4 + 2], fmaxf(acc[4 * q4 + 2], 0.f), __builtin_fmaf(wreg[4 * q4 + 1], fmaxf(acc[4 * q4 + 1], 0.f), wreg[4 * q4] * fmaxf(acc[4 * q4], 0.f))));
            const auto r01 = __builtin_amdgcn_permlane32_swap(__float_as_uint(pq[0]), __float_as_uint(pq[1]), false, false);
            const auto r23 = __builtin_amdgcn_permlane32_swap(__float_as_uint(pq[2]), __float_as_uint(pq[3]), false, false);
            const float sA = __uint_as_float(r01[0]) + __uint_as_float(r01[1]);
            const float sB = __uint_as_float(r23[0]) + __uint_as_float(r23[1]);
            const int sidx = 64 * t + 32 * kh + cc;
            const bool vA = sidx <= rA, vB = sidx <= rB;
            const unsigned kA = skey_c(sA), kB = skey_c(sB);
            if (MODE == 0) {
                const int bA = custom_bin(kA), bB = custom_bin(kB);
                if (vA) atomicAdd(&HIST[qA * 256 + (bA >> 1)], 1u << (16 * (bA & 1)));
                if (vB) atomicAdd(&HIST[qB * 256 + (bB >> 1)], 1u << (16 * (bB & 1)));
            } else if (MODE == 1) {
                if (vA && (flA & FL_ACTIVE) && (kA - loA) <= (hiA - loA)) { const unsigned sb = (kA - loA) >> shA; atomicAdd(&HIST[qA * 256 + (sb >> 1)], 1u << (16 * (sb & 1))); }
                if (vB && (flB & FL_ACTIVE) && (kB - loB) <= (hiB - loB)) { const unsigned sb = (kB - loB) >> shB; atomicAdd(&HIST[qB * 256 + (sb >> 1)], 1u << (16 * (sb & 1))); }
            } else {
                bool selA = vA && kA > hiA, selB = vB && kB > hiB;
                const bool inA = vA && (kA - loA) <= (hiA - loA), inB = vB && (kB - loB) <= (hiB - loB);
                if (anyTie) {
                    const unsigned long long eA = __ballot(inA && (flA & FL_TIE)), eB = __ballot(inB && (flB & FL_TIE));
                    const unsigned pA = hl ? (unsigned)(eA >> 32) : (unsigned)eA, pB = hl ? (unsigned)(eB >> 32) : (unsigned)eB;
                    const unsigned below = (1u << cc) - 1u;
                    if (inA && (flA & FL_TIE) && runA + __popc(pA & below) < needA) selA = true;
                    if (inB && (flB & FL_TIE) && runB + __popc(pB & below) < needB) selB = true;
                    runA += __popc(pA); runB += __popc(pB);
                }
                if (inA && !(flA & FL_TIE)) { const unsigned pos = atomicAdd(&ST[qA * 8 + ST_NCAND], 1u); if (pos < CAP) CAND[qA * CAP + pos] = ((kA - loA) << 13) | (unsigned)(8191 - sidx); }
                if (inB && !(flB & FL_TIE)) { const unsigned pos = atomicAdd(&ST[qB * 8 + ST_NCAND], 1u); if (pos < CAP) CAND[qB * CAP + pos] = ((kB - loB) << 13) | (unsigned)(8191 - sidx); }
                const unsigned long long mA = __ballot(selA), mB = __ballot(selB);
                const unsigned val = lane == 0 ? (unsigned)mA : (lane == 1 ? (unsigned)(mA >> 32) : (lane == 2 ? (unsigned)mB : (unsigned)(mB >> 32)));
                if (lane < 4) MASK[(4 * w + lane) * 260 + (t + 1) * 2 + kh] = val;
            }
        }
        if (t < tq) *(h16x8*)(lds + IX_KB + ((t + 1) & 1) * 8192 + sdst) = reg;
        __syncthreads();
    }
}

template <int MODE>
__device__ __forceinline__ void idx_scan(char* lds) {
    unsigned* HIST = (unsigned*)(lds + IX_HIST); unsigned* ST = (unsigned*)(lds + IX_ST); unsigned* FLAG = (unsigned*)(lds + IX_FLAG);
    const int lane = threadIdx.x & 63, w = threadIdx.x >> 6;
    for (int q4 = 0; q4 < 4; ++q4) {
        const int q = 4 * w + q4;
        const unsigned fl = ST[q * 8 + ST_FLAGS];
        if (MODE == 1 && !(fl & FL_ACTIVE)) continue;
        const unsigned need = ST[q * 8 + ST_NEED], lo = ST[q * 8 + ST_LO], hi = ST[q * 8 + ST_HI], sh = ST[q * 8 + ST_SH];
        unsigned c[8];
#pragma unroll
        for (int j = 0; j < 4; ++j) { const unsigned d = HIST[q * 256 + 4 * lane + j]; c[2 * j] = d & 0xFFFFu; c[2 * j + 1] = d >> 16; HIST[q * 256 + 4 * lane + j] = 0u; }
        unsigned tl = 0;
#pragma unroll
        for (int k = 0; k < 8; ++k) tl += c[k];
        unsigned Ssum = tl;
#pragma unroll
        for (int o = 1; o < 64; o <<= 1) { const unsigned v = __shfl_down(Ssum, o); if (lane + o < 64) Ssum += v; }
        const unsigned above = Ssum - tl;
        if (above < need && need <= Ssum) {
            unsigned cum = above; int bstar = 8 * lane; unsigned cnt = 0; bool found = false;
#pragma unroll
            for (int k = 7; k >= 0; --k) { if (!found) { if (cum + c[k] >= need) { bstar = 8 * lane + k; cnt = c[k]; found = true; } else cum += c[k]; } }
            const unsigned nneed = need - cum;
            unsigned nlo, nhi;
            if (MODE == 0) {
                if (bstar >= 256) { nlo = (unsigned)(bstar + 12000) << 18; nhi = bstar == 511 ? 0xFFFFFFFFu : (nlo | 0x3FFFFu); }
                else if (bstar == 255) { nlo = 4128u << 18; nhi = (12255u << 18) | 0x3FFFFu; }
                else { nhi = ((unsigned)(bstar + 3873) << 18) | 0x3FFFFu; nlo = bstar == 0 ? 0u : ((unsigned)(bstar + 3873) << 18); }
            } else {
                nlo = lo + ((unsigned)bstar << sh); const unsigned top = nlo + ((1u << sh) - 1u); nhi = top < hi ? top : hi; if (top < nlo) nhi = hi;
            }
            const unsigned range = nhi - nlo;
            unsigned nfl = 0, nsh = 0;
            if (nlo < nhi && (range >= (1u << 19) || cnt > CAP)) { nfl = FL_ACTIVE; const int bits = 32 - __clz(range); nsh = bits > 9 ? (unsigned)(bits - 9) : 0u; *FLAG = 1u; }
            else if (cnt > CAP) nfl = FL_TIE;
            ST[q * 8 + ST_LO] = nlo; ST[q * 8 + ST_HI] = nhi; ST[q * 8 + ST_NEED] = nneed; ST[q * 8 + ST_CNT] = cnt; ST[q * 8 + ST_FLAGS] = nfl; ST[q * 8 + ST_SH] = nsh;
        }
    }
}

__device__ void idx_unit(const Params& p, int b, int u, char* lds) {
    const h16* P = (const h16*)(p.ws + WS_P); const float* E = (const float*)(p.ws + WS_E);
    unsigned long long* Mk = (unsigned long long*)p.out;
    unsigned* HIST = (unsigned*)(lds + IX_HIST); unsigned* MASK = (unsigned*)(lds + IX_MASK); unsigned* CAND = (unsigned*)(lds + IX_CAND); unsigned* ST = (unsigned*)(lds + IX_ST); unsigned* FLAG = (unsigned*)(lds + IX_FLAG);
    const int tid = threadIdx.x, lane = tid & 63, w = tid >> 6, hl = lane >> 5, cc = lane & 31;
    const int qb = u >> 3, nwords = 4 * qb + 6;
    if (32 * u + 31 < 256) {
        for (int idx = tid; idx < 32 * nwords; idx += NT) {
            const int q = idx & 31, i = idx >> 5, r = 32 * u + q;
            unsigned long long wv;
            if (i == 0) wv = 0xFFFFull; else { const int nv = r - 64 * (i - 1) + 1; wv = nv <= 0 ? 0ull : (nv >= 64 ? ~0ull : ((1ull << nv) - 1ull)); }
            Mk[((size_t)b * NMI + i) * S + r] = wv;
        }
        return;
    }
    for (int i = tid; i < 32 * 256; i += NT) HIST[i] = 0u;
    for (int i = tid; i < 32 * 260; i += NT) MASK[i] = 0u;
    if (tid < 32) { ST[tid * 8 + ST_LO] = 0u; ST[tid * 8 + ST_HI] = 0xFFFFFFFFu; ST[tid * 8 + ST_NEED] = 256u; ST[tid * 8 + ST_CNT] = 0u; ST[tid * 8 + ST_FLAGS] = 0u; ST[tid * 8 + ST_NCAND] = 0u; ST[tid * 8 + ST_SH] = 0u; ST[tid * 8 + ST_RUN] = 0u; }
    if (tid == 0) *FLAG = 0u;
    h16x8 afrag[4]; float wreg[16];
    {
        const int qq = cc >> 3, head = cc & 7;
        const size_t row = (size_t)b * S + 32 * u + 4 * w + qq;
#pragma unroll
        for (int ks = 0; ks < 4; ++ks) afrag[ks] = *(const h16x8*)(P + row * NPAD + C_IQ + head * 64 + 16 * ks + 8 * hl);
#pragma unroll
        for (int q4 = 0; q4 < 4; ++q4) { const f32x4 wv = *(const f32x4*)(E + ((size_t)b * S + 32 * u + 4 * w + q4) * 128 + 64 + 4 * hl); wreg[4 * q4] = wv.x; wreg[4 * q4 + 1] = wv.y; wreg[4 * q4 + 2] = wv.z; wreg[4 * q4 + 3] = wv.w; }
    }
    __syncthreads();
    idx_pass<0>(p, b, u, lds, afrag, wreg);
    idx_scan<0>(lds);
    __syncthreads();
    for (int iter = 0; iter < 8; ++iter) {
        if (*FLAG == 0u) break;
        __syncthreads();
        if (tid == 0) *FLAG = 0u;
        __syncthreads();
        idx_pass<1>(p, b, u, lds, afrag, wreg);
        idx_scan<1>(lds);
        __syncthreads();
    }
    idx_pass<2>(p, b, u, lds, afrag, wreg);
    for (int q4 = 0; q4 < 4; ++q4) {
        const int q = 4 * w + q4;
        const unsigned fl = ST[q * 8 + ST_FLAGS]; if (fl & FL_TIE) continue;
        unsigned nc = ST[q * 8 + ST_NCAND]; if (nc > CAP) nc = CAP;
        const unsigned need = ST[q * 8 + ST_NEED], lo = ST[q * 8 + ST_LO];
        (void)lo;
        const unsigned c0 = lane < nc ? CAND[q * CAP + lane] : 0u, c1 = lane + 64 < nc ? CAND[q * CAP + lane + 64] : 0u;
        unsigned r0 = 0, r1 = 0;
        for (unsigned j = 0; j < nc; ++j) { const unsigned cj = CAND[q * CAP + j]; r0 += cj > c0 ? 1u : 0u; r1 += cj > c1 ? 1u : 0u; }
        if (lane < nc && r0 < need) { const int s = 8191 - (int)(c0 & 0x1FFFu); atomicOr(&MASK[q * 260 + ((s >> 6) + 1) * 2 + ((s >> 5) & 1)], 1u << (s & 31)); }
        if (lane + 64 < nc && r1 < need) { const int s = 8191 - (int)(c1 & 0x1FFFu); atomicOr(&MASK[q * 260 + ((s >> 6) + 1) * 2 + ((s >> 5) & 1)], 1u << (s & 31)); }
    }
    __syncthreads();
    for (int idx = tid; idx < 32 * nwords; idx += NT) {
        const int q = idx & 31, i = idx >> 5, r = 32 * u + q;
        const unsigned long long wv = i == 0 ? 0xFFFFull : ((unsigned long long)MASK[q * 260 + 2 * i] | ((unsigned long long)MASK[q * 260 + 2 * i + 1] << 32));
        Mk[((size_t)b * NMI + i) * S + r] = wv;
    }
    __syncthreads();
}

__device__ void attn_item_naive(const Params& p, int q, char* lds) {
    float* sc = (float*)lds;
    float* qi = sc + 8192;
    float* wq = qi + 512;
    unsigned* hist = (unsigned*)(wq + 16);
    int* sel = (int*)(hist + 256);
    int* misc = sel + 272;
    float* aq = (float*)(misc + 16);
    float* ps = aq + 512;
    h16* P = (h16*)(p.ws + WS_P); const float* E = (const float*)(p.ws + WS_E); const h16* KI = (const h16*)(p.ws + WS_KI);
    const int tid = threadIdx.x, lane = tid & 63, wave = tid >> 6;
    const int b = q >> 13, r = q & (S - 1), n = r + 1;
    const size_t qrow = (size_t)q;
    aq[tid] = (float)P[qrow * NPAD + C_AQ + tid];
    __syncthreads();
    int cnt;
    {
        const unsigned long long* Mk = (const unsigned long long*)p.out;
        if (tid == 0) misc[3] = 0;
        __syncthreads();
        const int ntile = (r >> 6) + 1;
        for (int t = tid; t < ntile; t += NT) {
            unsigned long long wv = Mk[((size_t)b * NMI + (t + 1)) * S + r];
            while (wv) { const int bit = __ffsll((long long)wv) - 1; wv &= wv - 1; const int pos = atomicAdd(&misc[3], 1); if (pos < 256) sel[16 + pos] = 64 * t + bit; }
        }
        __syncthreads();
        cnt = misc[3]; if (cnt > 256) cnt = 256;
    }
    const int nk = 16 + cnt;
    const int h = wave;
    float mx = -INFINITY;
    for (int j = lane; j < nk; j += 64) {
        const size_t krow = j < 16 ? (size_t)(MREAL + j) : (size_t)(b * S + sel[j]);
        const h16* kp = P + krow * NPAD + C_AK + h * 64;
        float dot = 0.f;
#pragma unroll
        for (int c = 0; c < 8; ++c) { const h16x8 hv = *(const h16x8*)(kp + c * 8);
#pragma unroll
            for (int jj = 0; jj < 8; ++jj) dot += aq[h * 64 + c * 8 + jj] * (float)hv[jj]; }
        dot *= 0.125f; ps[h * 272 + j] = dot; mx = fmaxf(mx, dot);
    }
    mx = wave_max(mx);
    float sum = 0.f;
    for (int j = lane; j < nk; j += 64) { const float e = __expf(ps[h * 272 + j] - mx); ps[h * 272 + j] = e; sum += e; }
    sum = wave_sum(sum);
    __syncthreads();
    float acc = 0.f;
    for (int j = 0; j < nk; ++j) {
        const size_t krow = j < 16 ? (size_t)(MREAL + j) : (size_t)(b * S + sel[j]);
        acc += ps[h * 272 + j] * (float)P[krow * NPAD + C_AV + h * 64 + lane];
    }
    P[qrow * NPAD + C_AQ + h * 64 + lane] = (h16)(acc / sum);
    __syncthreads();
}

__device__ __forceinline__ float hgrn_lb(const Params& p, int idx) { const float l0 = p.lb_logits[idx], l1 = p.lb_logits[512 + idx]; return 1.f / (1.f + __expf(l1 - l0)); }

__device__ void hgrn_stepA(const Params& p, int item, char* lds) {
    float* kd = (float*)lds;
    float* kk = kd + 64 * 128;
    float* vv = kk + 64 * 128;
    const h16* P = (const h16*)(p.ws + WS_P); float* ST = (float*)(p.ws + WS_X); float* G = (float*)(p.ws + WS_G);
    const int tid = threadIdx.x;
    const int c = item % NCH, bh = item / NCH, h = bh & 3, b = bh >> 2;
    const int L = c == 0 ? 16 : 64; const size_t rowbase = c == 0 ? (size_t)MREAL : (size_t)(b * S + (c - 1) * 64);
    for (int i = tid; i < L * 128; i += NT) { const int t = i >> 7, v = i & 127; vv[t * 128 + v] = (float)P[(rowbase + t) * NPAD + C_HI + h * 128 + v]; }
    if (tid < 128) {
        const int d = tid; const float lb = hgrn_lb(p, h * 128 + d);
        float bc = 0.f;
        for (int t = 0; t < L; ++t) {
            const float hf = (float)P[(rowbase + t) * NPAD + C_HF + h * 128 + d];
            const float f = lb + (1.f - lb) * sigmoidf_(hf);
            bc += logf(f); kd[t * 128 + d] = bc; kk[t * 128 + d] = 1.f - f;
        }
        for (int t = 0; t < L; ++t) kd[t * 128 + d] = kk[t * 128 + d] * __expf(bc - kd[t * 128 + d]);
        G[(size_t)item * 128 + d] = __expf(bc);
    }
    __syncthreads();
    const int d = tid & 127, vg = tid >> 7;
    float acc[32];
#pragma unroll
    for (int j = 0; j < 32; ++j) acc[j] = 0.f;
    for (int s = 0; s < L; ++s) {
        const float kv = kd[s * 128 + d];
#pragma unroll
        for (int j = 0; j < 32; j += 4) { const f32x4 v4 = *(const f32x4*)(vv + s * 128 + vg * 32 + j); acc[j] += kv * v4.x; acc[j + 1] += kv * v4.y; acc[j + 2] += kv * v4.z; acc[j + 3] += kv * v4.w; }
    }
    float* o = ST + (size_t)item * 16384 + d * 128 + vg * 32;
#pragma unroll
    for (int j = 0; j < 32; j += 4) *(f32x4*)(o + j) = (f32x4){acc[j], acc[j + 1], acc[j + 2], acc[j + 3]};
    __syncthreads();
}

__device__ void hgrn_scan(const Params& p) {
    float* ST = (float*)(p.ws + WS_X); const float* G = (const float*)(p.ws + WS_G);
    for (int idx = blockIdx.x * NT + threadIdx.x; idx < NB * 4 * 16384; idx += gridDim.x * NT) {
        const int bh = idx >> 14, e = idx & 16383, d = e >> 7;
        float Sv = 0.f;
        for (int c = 0; c < NCH; ++c) {
            const size_t off = (size_t)(bh * NCH + c) * 16384 + e;
            const float u = ST[off]; const float g = G[(size_t)(bh * NCH + c) * 128 + d];
            ST[off] = Sv; Sv = g * Sv + u;
        }
    }
}

__device__ void hgrn_stepC(const Params& p, int item, char* lds) {
    float* bq = (float*)lds;
    float* qq = bq + 64 * 65;
    float* kk = qq + 64 * 65;
    float* Am = kk + 64 * 65;
    float* qe = Am + 64 * 65;
    float* vv = qe + 64 * 128;
    h16* P = (h16*)(p.ws + WS_P); const float* ST = (const float*)(p.ws + WS_X);
    const int tid = threadIdx.x;
    const int c = 1 + item % 128, bh = item / 128, h = bh & 3, b = bh >> 2;
    const size_t rowbase = (size_t)(b * S + (c - 1) * 64);
    for (int i = tid; i < 64 * 128; i += NT) { const int t = i >> 7, v = i & 127; vv[t * 128 + v] = (float)P[(rowbase + t) * NPAD + C_HI + h * 128 + v]; }
    float aacc[8];
#pragma unroll
    for (int i = 0; i < 8; ++i) aacc[i] = 0.f;
    for (int half = 0; half < 2; ++half) {
        if (tid < 64) {
            const int d = half * 64 + tid; const float lb = hgrn_lb(p, h * 128 + d);
            float bc = 0.f;
            for (int t = 0; t < 64; ++t) {
                const float hf = (float)P[(rowbase + t) * NPAD + C_HF + h * 128 + d];
                const float f = lb + (1.f - lb) * sigmoidf_(hf);
                bc += logf(f); bq[t * 65 + tid] = bc; kk[t * 65 + tid] = 1.f - f;
            }
        }
        for (int i = tid; i < 64 * 64; i += NT) { const int t = i >> 6, dl = i & 63; qq[t * 65 + dl] = siluf_((float)P[(rowbase + t) * NPAD + C_HQ + h * 128 + half * 64 + dl]); }
        __syncthreads();
#pragma unroll
        for (int i = 0; i < 8; ++i) {
            const int pr = tid + NT * i, t = pr >> 6, s = pr & 63;
            if (s <= t) { float sum = 0.f;
                for (int dl = 0; dl < 64; ++dl) sum += qq[t * 65 + dl] * kk[s * 65 + dl] * __expf(bq[t * 65 + dl] - bq[s * 65 + dl]);
                aacc[i] += sum; }
        }
        for (int i = tid; i < 64 * 64; i += NT) { const int t = i >> 6, dl = i & 63; qe[t * 128 + half * 64 + dl] = qq[t * 65 + dl] * __expf(bq[t * 65 + dl]); }
        __syncthreads();
    }
#pragma unroll
    for (int i = 0; i < 8; ++i) { const int pr = tid + NT * i, t = pr >> 6, s = pr & 63; Am[t * 65 + s] = aacc[i]; }
    __syncthreads();
    const int v = tid & 127, tg = tid >> 7;
    float acc[16];
#pragma unroll
    for (int i = 0; i < 16; ++i) acc[i] = 0.f;
    for (int s = 0; s < 64; ++s) { const float vval = vv[s * 128 + v];
#pragma unroll
        for (int i = 0; i < 16; ++i) acc[i] += Am[(tg * 16 + i) * 65 + s] * vval; }
    const float* sp = ST + (size_t)(bh * NCH + c) * 16384 + v;
    for (int d = 0; d < 128; ++d) { const float sv = sp[d * 128];
#pragma unroll
        for (int i = 0; i < 16; ++i) acc[i] += qe[(tg * 16 + i) * 128 + d] * sv; }
#pragma unroll
    for (int i = 0; i < 16; ++i) P[(rowbase + tg * 16 + i) * NPAD + C_HQ + h * 128 + v] = (h16)acc[i];
    __syncthreads();
}

__device__ void phase_mix(const Params& p) {
    const h16* P = (const h16*)(p.ws + WS_P); h16* MIX = (h16*)(p.ws + WS_X);
    const int lane = threadIdx.x & 63, wave = threadIdx.x >> 6;
    for (int row = blockIdx.x * 8 + wave; row < MREAL; row += gridDim.x * 8) {
        const h16* pr = P + (size_t)row * NPAD; h16* o = MIX + (size_t)row * D;
        { const h16x8 a = *(const h16x8*)(pr + C_AQ + lane * 8); const h16x8 g = *(const h16x8*)(pr + C_AG + lane * 8);
          float ss = 0.f;
#pragma unroll
          for (int j = 0; j < 8; ++j) ss += (float)a[j] * (float)a[j];
          const float rs = rsqrtf(wave_sum(ss) * (1.f / 512.f) + 1e-6f);
          h16x8 ov;
#pragma unroll
          for (int j = 0; j < 8; ++j) ov[j] = (h16)((float)a[j] * rs * p.attn_norm[lane * 8 + j] * siluf_((float)g[j]));
          *(h16x8*)(o + lane * 8) = ov; }
        { const h16x8 a = *(const h16x8*)(pr + C_HQ + lane * 8); const h16x8 g = *(const h16x8*)(pr + C_HG + lane * 8);
          float ss = 0.f;
#pragma unroll
          for (int j = 0; j < 8; ++j) ss += (float)a[j] * (float)a[j];
#pragma unroll
          for (int o2 = 1; o2 < 16; o2 <<= 1) ss += __shfl_xor(ss, o2);
          const float rs = rsqrtf(ss * (1.f / 128.f) + 1e-6f);
          h16x8 ov;
#pragma unroll
          for (int j = 0; j < 8; ++j) ov[j] = (h16)((float)a[j] * rs * p.hgrn_norm[(lane & 15) * 8 + j] * siluf_((float)g[j]));
          *(h16x8*)(o + 512 + lane * 8) = ov; }
    }
}

__device__ void phase_final(const Params& p) {
    const int lane = threadIdx.x & 63, wave = threadIdx.x >> 6;
    for (int row = blockIdx.x * 8 + wave; row < MREAL; row += gridDim.x * 8) {
        float* o = p.out + (size_t)row * D;
        f32x4 v[4]; float ss = 0.f;
        for (int j = 0; j < 4; ++j) { v[j] = *(const f32x4*)(o + (lane + 64 * j) * 4); ss += v[j].x * v[j].x + v[j].y * v[j].y + v[j].z * v[j].z + v[j].w * v[j].w; }
        const float rs = rsqrtf(wave_sum(ss) * (1.f / D) + 1e-6f);
        for (int j = 0; j < 4; ++j) { const f32x4 g = *(const f32x4*)(p.final_norm + (lane + 64 * j) * 4);
            *(f32x4*)(o + (lane + 64 * j) * 4) = (f32x4){v[j].x * rs * g.x, v[j].y * rs * g.y, v[j].z * rs * g.z, v[j].w * rs * g.w}; }
    }
}

constexpr int NPHASE = 9;
__global__ void __launch_bounds__(NT, 2) mega(Params p, int ph_lo, int ph_hi) {
    extern __shared__ __attribute__((aligned(16))) char lds[];
    cg::grid_group grid = cg::this_grid();
#define IN(k) (ph_lo <= (k) && (k) < ph_hi)
#define SYNC(k) do { if ((k) + 1 < ph_hi) grid.sync(); } while (0)
    if (IN(0)) { phase_prep(p, lds); SYNC(0); }
    if (IN(1)) { phase_gemm_in(p, lds); SYNC(1); }
    if (IN(2)) { phase_post(p); SYNC(2); }
    if (IN(3)) {
        constexpr int NA = NB * 4 * NCH;
        for (int it = blockIdx.x; it < 512; it += gridDim.x) { const int uu = it < 256 ? 255 - (it >> 1) : (it - 256) >> 1; idx_unit(p, it & 1, uu, lds); }
        for (int it = blockIdx.x; it < NA; it += gridDim.x) hgrn_stepA(p, it, lds);
        SYNC(3);
    }
    if (IN(4)) { hgrn_scan(p); SYNC(4); }
    if (IN(5)) {
        constexpr int NC = NB * 4 * 128;
        for (int it = blockIdx.x; it < NC; it += gridDim.x) hgrn_stepC(p, it, lds);
        for (int it = blockIdx.x; it < MREAL; it += gridDim.x) attn_item_naive(p, it, lds);
        SYNC(5);
    }
    if (IN(6)) { phase_mix(p); SYNC(6); }
    if (IN(7)) { phase_gemm_out(p, lds); SYNC(7); }
    if (IN(8)) { phase_final(p); }
#undef IN
#undef SYNC
}

extern "C" void kernel_launch(void* const* d_in, const int* in_sizes, int n_in, void* d_out, int out_size, void* d_ws, size_t ws_size, hipStream_t stream) {
    static int grid = 0;
    if (grid == 0) {
        if (n_in != 11 || ws_size < WS_END || out_size != MREAL * D) { fprintf(stderr, "kernel_launch: unexpected shapes n_in %d ws %zu out %d\n", n_in, ws_size, out_size); grid = -1; return; }
        int dev = 0, cus = 0, per_cu = 0;
        hipGetDevice(&dev); hipDeviceGetAttribute(&cus, hipDeviceAttributeMultiprocessorCount, dev);
        hipFuncSetAttribute((const void*)mega, hipFuncAttributeMaxDynamicSharedMemorySize, LDS_BYTES);
        hipOccupancyMaxActiveBlocksPerMultiprocessor(&per_cu, (const void*)mega, NT, LDS_BYTES);
        if (per_cu < 1) { fprintf(stderr, "kernel_launch: occupancy query says %d\n", per_cu); per_cu = 1; }
        grid = cus * 1;
        (void)hipGetLastError();
    }
    if (grid < 0) return;
    Params p{};
    p.x = (const float*)d_in[0]; p.meta = (const float*)d_in[1]; p.mix_norm = (const float*)d_in[2]; p.w_in = (const float*)d_in[3];
    p.idx_g = (const float*)d_in[4]; p.idx_b = (const float*)d_in[5]; p.attn_norm = (const float*)d_in[6]; p.lb_logits = (const float*)d_in[7];
    p.hgrn_norm = (const float*)d_in[8]; p.w_out = (const float*)d_in[9]; p.final_norm = (const float*)d_in[10];
    p.out = (float*)d_out; p.ws = (unsigned char*)d_ws;
#if N_LAUNCH_MODE == 1
    int lo = 0, hi = NPHASE; void* args[] = {&p, &lo, &hi};
    hipError_t e = hipLaunchCooperativeKernel((const void*)mega, dim3(grid), dim3(NT), args, LDS_BYTES, stream);
    if (e != hipSuccess) fprintf(stderr, "cooperative launch failed: %s (grid %d)\n", hipGetErrorString(e), grid);
#else
    for (int ph = 0; ph < NPHASE; ++ph) hipLaunchKernelGGL(mega, dim3(grid), dim3(NT), LDS_BYTES, stream, p, ph, ph + 1);
#endif
}
```

```cpp
#include <hip/hip_runtime.h>
#include <hip/hip_cooperative_groups.h>
#include <cstdint>
#include <cstdio>
namespace cg = cooperative_groups;

typedef _Float16 h16;
typedef _Float16 h16x8 __attribute__((ext_vector_type(8)));
typedef _Float16 h16x4 __attribute__((ext_vector_type(4)));
typedef float f32x4 __attribute__((ext_vector_type(4)));

#ifndef N_LAUNCH_MODE
#define N_LAUNCH_MODE 1
#endif

constexpr int NB = 2, S = 8192, NMETA = 16, D = 1024;
constexpr int MREAL = NB * S;
constexpr int MROWS = MREAL + NMETA;
constexpr int MPAD = 16640;
constexpr int NCOL = 4680, NPAD = 4864;
constexpr int G_IK = 4608;
constexpr int NP2 = 3328;
constexpr int C_AG = 0, C_IQ = 512, C_HQ = 1024, C_HF = 1536, C_HI = 2048, C_HG = 2560, C_IK = 3072, C_IW = 3136;
constexpr int KVROWS = 8320;
constexpr int NCH = 129;
constexpr int NT = 512;

constexpr size_t MiB = 1u << 20;
constexpr size_t WS_WTIN = 1 * MiB, WS_WTOUT = 11 * MiB, WS_ROPE = 13 * MiB, WS_E = 14 * MiB, WS_KI = 23 * MiB, WS_G = 26 * MiB, WS_P = 27 * MiB, WS_QB = 133 * MiB, WS_KB = 149 * MiB, WS_VB = 166 * MiB, WS_X = 190 * MiB, WS_END = 256 * MiB;
static_assert(WS_P + (size_t)MPAD * NP2 * 2 <= WS_QB && WS_QB + (size_t)MREAL * 512 * 2 <= WS_KB && WS_KB + (size_t)NB * KVROWS * 512 * 2 <= WS_VB && WS_VB + (size_t)NB * KVROWS * 512 * 2 <= WS_X, "ws map");
static_assert(WS_X + (size_t)NB * 4 * NCH * 16384 * 4 <= WS_END, "ST");

constexpr int LDS_BYTES = 140 * 1024;

struct Params {
    const float *x, *meta, *mix_norm, *w_in, *idx_g, *idx_b, *attn_norm, *lb_logits, *hgrn_norm, *w_out, *final_norm;
    float* out; unsigned char* ws;
};

__device__ __forceinline__ float wave_sum(float v) {
#pragma unroll
    for (int o = 1; o < 64; o <<= 1) v += __shfl_xor(v, o);
    return v;
}
__device__ __forceinline__ float wave_max(float v) {
#pragma unroll
    for (int o = 1; o < 64; o <<= 1) v = fmaxf(v, __shfl_xor(v, o));
    return v;
}
__device__ __forceinline__ float sigmoidf_(float x) { return 1.f / (1.f + __expf(-x)); }
__device__ __forceinline__ float siluf_(float x) { return x * sigmoidf_(x); }
__device__ __forceinline__ int oldcol(int n) { return n < 2560 ? n : (n < 4608 ? n + 72 : (n < 4672 ? 2560 + (n - 4608) : 2624 + (n - 4672))); }
__device__ __forceinline__ unsigned skey(float x) { if (x == 0.f) x = 0.f; unsigned u = __float_as_uint(x); return (u & 0x80000000u) ? ~u : (u | 0x80000000u); }

__device__ __forceinline__ void transpose_item(const float* __restrict__ W, int ldw, int nvalid, bool remap, h16* __restrict__ WT, int K, int item, float* tile) {
    constexpr float C2 = 0.125f * 1.4426950408889634f;
    const int nkt = K / 64, nb = item / nkt, kb = item % nkt, n0 = nb * 64, k0 = kb * 64, tid = threadIdx.x;
    {
        const int nl = tid & 63, kl = tid >> 6, n = n0 + nl;
        int src = -1; if (n < nvalid) src = remap ? oldcol(n) : n;
        const float scl = (remap && n < 512) ? C2 : 1.f;
        for (int kk = kl; kk < 64; kk += 8) tile[kk * 65 + nl] = (src >= 0) ? W[(size_t)(k0 + kk) * ldw + src] * scl : 0.f;
    }
    __syncthreads();
    {
        const int kl = tid & 63, nl = tid >> 6;
        for (int nn = nl; nn < 64; nn += 8) WT[(size_t)(n0 + nn) * K + k0 + kl] = (h16)tile[kl * 65 + nn];
    }
    __syncthreads();
}

__device__ __forceinline__ void phase_prep(const Params& p, char* lds) {
    float* tile = (float*)lds;
    h16* WTin = (h16*)(p.ws + WS_WTIN); h16* WTout = (h16*)(p.ws + WS_WTOUT);
    constexpr int I_IN = (NPAD / 64) * (D / 64), I_OUT = (D / 64) * (D / 64);
    for (int it = blockIdx.x; it < I_IN + I_OUT; it += gridDim.x) {
        if (it < I_IN) transpose_item(p.w_in, NCOL, NCOL, true, WTin, D, it, tile);
        else transpose_item(p.w_out, D, D, false, WTout, D, it - I_IN, tile);
    }
    h16* HN = (h16*)(p.ws + WS_X);
    const int lane = threadIdx.x & 63, wave = threadIdx.x >> 6;
    for (int row = blockIdx.x * 8 + wave; row < MPAD; row += gridDim.x * 8) {
        h16* o = HN + (size_t)row * D;
        if (row >= MROWS) {
            for (int j = 0; j < 4; ++j) { h16x4 z = {(h16)0.f, (h16)0.f, (h16)0.f, (h16)0.f}; *(h16x4*)(o + (lane + 64 * j) * 4) = z; }
            continue;
        }
        const float* src = row < MREAL ? p.x + (size_t)row * D : p.meta + (size_t)(row - MREAL) * D;
        f32x4 v[4]; float ss = 0.f;
        for (int j = 0; j < 4; ++j) { v[j] = *(const f32x4*)(src + (lane + 64 * j) * 4); ss += v[j].x * v[j].x + v[j].y * v[j].y + v[j].z * v[j].z + v[j].w * v[j].w; }
        const float rs = rsqrtf(wave_sum(ss) * (1.f / D) + 1e-6f);
        for (int j = 0; j < 4; ++j) {
            const f32x4 g = *(const f32x4*)(p.mix_norm + (lane + 64 * j) * 4);
            h16x4 hv = {(h16)(v[j].x * rs * g.x), (h16)(v[j].y * rs * g.y), (h16)(v[j].z * rs * g.z), (h16)(v[j].w * rs * g.w)};
            *(h16x4*)(o + (lane + 64 * j) * 4) = hv;
        }
    }
    {
        h16* KB = (h16*)(p.ws + WS_KB); h16* VB = (h16*)(p.ws + WS_VB);
        for (int idx = blockIdx.x * NT + threadIdx.x; idx < NB * 112 * 64; idx += gridDim.x * NT) {
            const int c = idx & 63, rr = (idx >> 6) % 112, b = idx / (112 * 64);
            const int row = b * KVROWS + (rr < 48 ? 16 + rr : 8256 + (rr - 48));
            const h16x8 z = {(h16)0.f, (h16)0.f, (h16)0.f, (h16)0.f, (h16)0.f, (h16)0.f, (h16)0.f, (h16)0.f};
            *(h16x8*)(KB + (size_t)row * 512 + c * 8) = z; *(h16x8*)(VB + (size_t)row * 512 + c * 8) = z;
        }
    }
    float* ROPE = (float*)(p.ws + WS_ROPE);
    const double inv[8] = {1.0, 0.1939227432012558, 0.03760603070259094, 0.007292664609849453, 0.0014142135623842478, 0.00027424818836152554, 5.3182957344688475e-05, 1.0313385246263351e-05};
    for (int idx = blockIdx.x * NT + threadIdx.x; idx < (S + NMETA) * 8; idx += gridDim.x * NT) {
        const int t = idx >> 3, i = idx & 7;
        double iv = inv[0];
        if (i == 1) iv = inv[1]; else if (i == 2) iv = inv[2]; else if (i == 3) iv = inv[3]; else if (i == 4) iv = inv[4]; else if (i == 5) iv = inv[5]; else if (i == 6) iv = inv[6]; else if (i == 7) iv = inv[7];
        const double rev = (double)t * iv * 0.15915494309189535;
        const float fr = (float)(rev - __builtin_rint(rev));
        ROPE[idx * 2] = __builtin_amdgcn_cosf(fr); ROPE[idx * 2 + 1] = __builtin_amdgcn_sinf(fr);
    }
}

template <int EPI>
__device__ __forceinline__ void gemm_tile(const Params& p, const h16* __restrict__ A, int lda, const h16* __restrict__ Bt, int ldb, int K, int pm, int pn, char* lds) {
    h16* As = (h16*)lds;
    h16* Bs = As + 128 * 40;
    const int tid = threadIdx.x, lane = tid & 63, wave = tid >> 6, wr = wave >> 2, wc = wave & 3;
    const int arow = tid >> 2, apart = tid & 3;
    const h16* ag = A + (size_t)(pm * 128 + arow) * lda + apart * 8;
    const h16* bg0 = Bt + (size_t)(pn * 256 + (tid >> 2)) * ldb + apart * 8;
    const h16* bg1 = Bt + (size_t)(pn * 256 + 128 + (tid >> 2)) * ldb + apart * 8;
    f32x4 acc[4][4];
#pragma unroll
    for (int m = 0; m < 4; ++m)
#pragma unroll
        for (int n = 0; n < 4; ++n) acc[m][n] = (f32x4){0.f, 0.f, 0.f, 0.f};
    h16x8 ra = *(const h16x8*)ag, rb0 = *(const h16x8*)bg0, rb1 = *(const h16x8*)bg1;
    const int nk = K / 32;
    for (int kt = 0; kt < nk; ++kt) {
        *(h16x8*)(As + arow * 40 + apart * 8) = ra;
        *(h16x8*)(Bs + (tid >> 2) * 40 + apart * 8) = rb0;
        *(h16x8*)(Bs + (128 + (tid >> 2)) * 40 + apart * 8) = rb1;
        __syncthreads();
        if (kt + 1 < nk) { ra = *(const h16x8*)(ag + (kt + 1) * 32); rb0 = *(const h16x8*)(bg0 + (kt + 1) * 32); rb1 = *(const h16x8*)(bg1 + (kt + 1) * 32); }
        h16x8 af[4], bf[4];
#pragma unroll
        for (int m = 0; m < 4; ++m) af[m] = *(const h16x8*)(As + (wr * 64 + m * 16 + (lane & 15)) * 40 + (lane >> 4) * 8);
#pragma unroll
        for (int n = 0; n < 4; ++n) bf[n] = *(const h16x8*)(Bs + (wc * 64 + n * 16 + (lane & 15)) * 40 + (lane >> 4) * 8);
#pragma unroll
        for (int m = 0; m < 4; ++m)
#pragma unroll
            for (int n = 0; n < 4; ++n) acc[m][n] = __builtin_amdgcn_mfma_f32_16x16x32_f16(af[m], bf[n], acc[m][n], 0, 0, 0);
        __syncthreads();
    }
#pragma unroll
    for (int m = 0; m < 4; ++m)
#pragma unroll
        for (int n = 0; n < 4; ++n)
#pragma unroll
            for (int r = 0; r < 4; ++r) {
                const int grow = pm * 128 + wr * 64 + m * 16 + (lane >> 4) * 4 + r, gcol = pn * 256 + wc * 64 + n * 16 + (lane & 15);
                const float v = acc[m][n][r];
                if (EPI == 0) {
                    if (gcol < 512) { if (grow < MREAL) ((h16*)(p.ws + WS_QB))[(size_t)grow * 512 + gcol] = (h16)v; }
                    else if (gcol < 1536) {
                        h16* dst = (h16*)(p.ws + (gcol < 1024 ? WS_KB : WS_VB)); const int cc = (gcol - 512) & 511;
                        if (grow < MREAL) dst[((size_t)(grow >> 13) * KVROWS + 64 + (grow & (S - 1))) * 512 + cc] = (h16)v;
                        else if (grow < MROWS) { dst[(size_t)(grow - MREAL) * 512 + cc] = (h16)v; dst[((size_t)KVROWS + (grow - MREAL)) * 512 + cc] = (h16)v; }
                    } else {
                        ((h16*)(p.ws + WS_P))[(size_t)grow * NP2 + (gcol - 1536)] = (h16)v;
                        if (gcol >= G_IK && gcol < G_IK + 128) ((float*)(p.ws + WS_E))[(size_t)grow * 128 + (gcol - G_IK)] = v;
                    }
                } else {
                    p.out[(size_t)grow * D + gcol] = p.x[(size_t)grow * D + gcol] + v;
                }
            }
}

__device__ __forceinline__ void phase_gemm_in(const Params& p, char* lds) {
    constexpr int NM = MPAD / 128, NN = NPAD / 256;
    for (int t = blockIdx.x; t < NM * NN; t += gridDim.x)
        gemm_tile<0>(p, (const h16*)(p.ws + WS_X), D, (const h16*)(p.ws + WS_WTIN), D, D, t / NN, t % NN, lds);
}
__device__ __forceinline__ void phase_gemm_out(const Params& p, char* lds) {
    constexpr int NM = MREAL / 128, NN = D / 256;
    for (int t = blockIdx.x; t < NM * NN; t += gridDim.x)
        gemm_tile<1>(p, (const h16*)(p.ws + WS_X), D, (const h16*)(p.ws + WS_WTOUT), D, D, t / NN, t % NN, lds);
}

__device__ __forceinline__ void phase_post(const Params& p) {
    h16* P = (h16*)(p.ws + WS_P); const float* E = (const float*)(p.ws + WS_E); h16* KI = (h16*)(p.ws + WS_KI); const float* ROPE = (const float*)(p.ws + WS_ROPE);
    h16* QBf = (h16*)(p.ws + WS_QB); h16* KBf = (h16*)(p.ws + WS_KB);
    const int lane = threadIdx.x & 63, wave = threadIdx.x >> 6;
    for (int row = blockIdx.x * 8 + wave; row < MROWS; row += gridDim.x * 8) {
        const int t = row < MREAL ? NMETA + (row & (S - 1)) : row - MREAL;
        {
            const int head = lane >> 3, i = lane & 7;
            const float c = ROPE[(t * 8 + i) * 2], s = ROPE[(t * 8 + i) * 2 + 1];
            auto rope2 = [&](h16* base) { h16* pr = base + head * 64; const float x1 = (float)pr[i], x2 = (float)pr[i + 8]; pr[i] = (h16)(x1 * c - x2 * s); pr[i + 8] = (h16)(x2 * c + x1 * s); };
            if (row < MREAL) { rope2(QBf + (size_t)row * 512); rope2(P + (size_t)row * NP2 + C_IQ); rope2(KBf + ((size_t)(row >> 13) * KVROWS + 64 + (row & (S - 1))) * 512); }
            else { rope2(KBf + (size_t)(row - MREAL) * 512); rope2(KBf + ((size_t)KVROWS + (row - MREAL)) * 512); }
        }
        const float v = E[(size_t)row * 128 + lane];
        const float mean = wave_sum(v) * (1.f / 64.f); const float d = v - mean;
        const float var = wave_sum(d * d) * (1.f / 64.f);
        float y = d * rsqrtf(var + 1e-6f) * p.idx_g[lane] + p.idx_b[lane];
        const float other = __shfl_xor(y, 8);
        if (lane < 16) {
            const int i = lane & 7; const float c = ROPE[(t * 8 + i) * 2], s = ROPE[(t * 8 + i) * 2 + 1];
            y = lane < 8 ? (y * c - other * s) : (y * c + other * s);
        }
        KI[(size_t)row * 64 + lane] = (h16)y;
    }
}

constexpr int NMI = 130;
constexpr int QB = 32, CAP = 128;
constexpr int IX_KB = 0, IX_HIST = 16384, IX_MASK = 49152, IX_CAND = 82432, IX_ST = 98816, IX_FLAG = 99840;
typedef float f32x16 __attribute__((ext_vector_type(16)));
#define ST_LO 0
#define ST_HI 1
#define ST_NEED 2
#define ST_CNT 3
#define ST_FLAGS 4
#define ST_NCAND 5
#define ST_SH 6
#define ST_RUN 7
#define FL_ACTIVE 1u
#define FL_TIE 2u

__device__ __forceinline__ unsigned skey_c(float x) { x = x + 0.f; const unsigned u = __float_as_uint(x); return u ^ (((unsigned)((int)u >> 31)) | 0x80000000u); }
__device__ __forceinline__ int custom_bin(unsigned key) {
    const int k14 = (int)(key >> 18); const int a = k14 - 12000, bb = k14 - 3873;
    const int lowpart = min(max(bb, 0), 255);
    return max(min(a, 511), lowpart);
}

template <int MODE>
__device__ __forceinline__ void idx_pass(const Params& p, int b, int u, char* lds, const h16x8 (&afrag)[4], const float (&wreg)[16]) {
    const h16* KI = (const h16*)(p.ws + WS_KI) + (size_t)b * S * 64;
    unsigned* HIST = (unsigned*)(lds + IX_HIST); unsigned* MASK = (unsigned*)(lds + IX_MASK); unsigned* CAND = (unsigned*)(lds + IX_CAND); unsigned* ST = (unsigned*)(lds + IX_ST);
    const int tid = threadIdx.x, lane = tid & 63, w = tid >> 6, hl = lane >> 5, cc = lane & 31;
    const int tq = u >> 1;
    const int qA = 4 * w + hl, qB = 4 * w + 2 + hl;
    const int rA = 32 * u + qA, rB = 32 * u + qB;
    unsigned loA = 0, hiA = 0, loB = 0, hiB = 0, flA = 0, flB = 0, shA = 0, shB = 0, needA = 0, needB = 0, runA = 0, runB = 0;
    if (MODE != 0) { loA = ST[qA * 8 + ST_LO]; hiA = ST[qA * 8 + ST_HI]; flA = ST[qA * 8 + ST_FLAGS]; shA = ST[qA * 8 + ST_SH]; needA = ST[qA * 8 + ST_NEED];
                     loB = ST[qB * 8 + ST_LO]; hiB = ST[qB * 8 + ST_HI]; flB = ST[qB * 8 + ST_FLAGS]; shB = ST[qB * 8 + ST_SH]; needB = ST[qB * 8 + ST_NEED]; }
    const bool anyTie = (MODE == 2) && (__ballot((flA | flB) & FL_TIE) != 0ull);
    const int si = tid >> 3, sc_ = tid & 7;
    const int sdst = si * 128 + ((sc_ ^ ((si >> 1) & 7)) << 4);
    h16x8 reg = *(const h16x8*)(KI + (size_t)si * 64 + sc_ * 8);
    *(h16x8*)(lds + IX_KB + sdst) = reg;
    __syncthreads();
    for (int t = 0; t <= tq; ++t) {
        if (t < tq) reg = *(const h16x8*)(KI + (size_t)(64 * (t + 1) + si) * 64 + sc_ * 8);
        const char* kb = lds + IX_KB + (t & 1) * 8192;
#pragma unroll
        for (int kh = 0; kh < 2; ++kh) {
            f32x16 acc = {0.f, 0.f, 0.f, 0.f, 0.f, 0.f, 0.f, 0.f, 0.f, 0.f, 0.f, 0.f, 0.f, 0.f, 0.f, 0.f};
            const int ki = 32 * kh + cc;
#pragma unroll
            for (int ks = 0; ks < 4; ++ks) {
                const h16x8 bfrag = *(const h16x8*)(kb + ki * 128 + (((2 * ks + hl) ^ ((ki >> 1) & 7)) << 4));
                acc = __builtin_amdgcn_mfma_f32_32x32x16_f16(afrag[ks], bfrag, acc, 0, 0, 0);
            }
            float pq[4];
#pragma unroll
            for (int q4 = 0; q4 < 4; ++q4)
                pq[q4] = __builtin_fmaf(wreg[4 * q4 + 3], fmaxf(acc[4 * q4 + 3], 0.f), __builtin_fmaf(wreg[4 * q4 + 2], fmaxf(acc[4 * q4 + 2], 0.f), __builtin_fmaf(wreg[4 * q4 + 1], fmaxf(acc[4 * q4 + 1], 0.f), wreg[4 * q4] * fmaxf(acc[4 * q4], 0.f))));
            const auto r01 = __builtin_amdgcn_permlane32_swap(__float_as_uint(pq[0]), __float_as_uint(pq[1]), false, false);
            const auto r23 = __builtin_amdgcn_permlane32_swap(__float_as_uint(pq[2]), __float_as_uint(pq[3]), false, false);
            const float sA = __uint_as_float(r01[0]) + __uint_as_float(r01[1]);
            const float sB = __uint_as_float(r23[0]) + __uint_as_float(r23[1]);
            const int sidx = 64 * t + 32 * kh + cc;
            const bool vA = sidx <= rA, vB = sidx <= rB;
            const unsigned kA = skey_c(sA), kB = skey_c(sB);
            if (MODE == 0) {
                const int bA = custom_bin(kA), bB = custom_bin(kB);
                if (vA) atomicAdd(&HIST[qA * 256 + (bA >> 1)], 1u << (16 * (bA & 1)));
                if (vB) atomicAdd(&HIST[qB * 256 + (bB >> 1)], 1u << (16 * (bB & 1)));
            } else if (MODE == 1) {
                if (vA && (flA & FL_ACTIVE) && (kA - loA) <= (hiA - loA)) { const unsigned sb = (kA - loA) >> shA; atomicAdd(&HIST[qA * 256 + (sb >> 1)], 1u << (16 * (sb & 1))); }
                if (vB && (flB & FL_ACTIVE) && (kB - loB) <= (hiB - loB)) { const unsigned sb = (kB - loB) >> shB; atomicAdd(&HIST[qB * 256 + (sb >> 1)], 1u << (16 * (sb & 1))); }
            } else {
                bool selA = vA && kA > hiA, selB = vB && kB > hiB;
                const bool inA = vA && (kA - loA) <= (hiA - loA), inB = vB && (kB - loB) <= (hiB - loB);
                if (anyTie) {
                    const unsigned long long eA = __ballot(inA && (flA & FL_TIE)), eB = __ballot(inB && (flB & FL_TIE));
                    const unsigned pA = hl ? (unsigned)(eA >> 32) : (unsigned)eA, pB = hl ? (unsigned)(eB >> 32) : (unsigned)eB;
                    const unsigned below = (1u << cc) - 1u;
                    if (inA && (flA & FL_TIE) && runA + __popc(pA & below) < needA) selA = true;
                    if (inB && (flB & FL_TIE) && runB + __popc(pB & below) < needB) selB = true;
                    runA += __popc(pA); runB += __popc(pB);
                }
                if (inA && !(flA & FL_TIE)) { const unsigned pos = atomicAdd(&ST[qA * 8 + ST_NCAND], 1u); if (pos < CAP) CAND[qA * CAP + pos] = ((kA - loA) << 13) | (unsigned)(8191 - sidx); }
                if (inB && !(flB & FL_TIE)) { const unsigned pos = atomicAdd(&ST[qB * 8 + ST_NCAND], 1u); if (pos < CAP) CAND[qB * CAP + pos] = ((kB - loB) << 13) | (unsigned)(8191 - sidx); }
                const unsigned long long mA = __ballot(selA), mB = __ballot(selB);
                const unsigned val = lane == 0 ? (unsigned)mA : (lane == 1 ? (unsigned)(mA >> 32) : (lane == 2 ? (unsigned)mB : (unsigned)(mB >> 32)));
                if (lane < 4) MASK[(4 * w + lane) * 260 + (t + 1) * 2 + kh] = val;
            }
        }
        if (t < tq) *(h16x8*)(lds + IX_KB + ((t + 1) & 1) * 8192 + sdst) = reg;
        __syncthreads();
    }
}

template <int MODE>
__device__ __forceinline__ void idx_scan(char* lds) {
    unsigned* HIST = (unsigned*)(lds + IX_HIST); unsigned* ST = (unsigned*)(lds + IX_ST); unsigned* FLAG = (unsigned*)(lds + IX_FLAG);
    const int lane = threadIdx.x & 63, w = threadIdx.x >> 6;
    for (int q4 = 0; q4 < 4; ++q4) {
        const int q = 4 * w + q4;
        const unsigned fl = ST[q * 8 + ST_FLAGS];
        if (MODE == 1 && !(fl & FL_ACTIVE)) continue;
        const unsigned need = ST[q * 8 + ST_NEED], lo = ST[q * 8 + ST_LO], hi = ST[q * 8 + ST_HI], sh = ST[q * 8 + ST_SH];
        unsigned c[8];
#pragma unroll
        for (int j = 0; j < 4; ++j) { const unsigned d = HIST[q * 256 + 4 * lane + j]; c[2 * j] = d & 0xFFFFu; c[2 * j + 1] = d >> 16; HIST[q * 256 + 4 * lane + j] = 0u; }
        unsigned tl = 0;
#pragma unroll
        for (int k = 0; k < 8; ++k) tl += c[k];
        unsigned Ssum = tl;
#pragma unroll
        for (int o = 1; o < 64; o <<= 1) { const unsigned v = __shfl_down(Ssum, o); if (lane + o < 64) Ssum += v; }
        const unsigned above = Ssum - tl;
        if (above < need && need <= Ssum) {
            unsigned cum = above; int bstar = 8 * lane; unsigned cnt = 0; bool found = false;
#pragma unroll
            for (int k = 7; k >= 0; --k) { if (!found) { if (cum + c[k] >= need) { bstar = 8 * lane + k; cnt = c[k]; found = true; } else cum += c[k]; } }
            const unsigned nneed = need - cum;
            unsigned nlo, nhi;
            if (MODE == 0) {
                if (bstar >= 256) { nlo = (unsigned)(bstar + 12000) << 18; nhi = bstar == 511 ? 0xFFFFFFFFu : (nlo | 0x3FFFFu); }
                else if (bstar == 255) { nlo = 4128u << 18; nhi = (12255u << 18) | 0x3FFFFu; }
                else { nhi = ((unsigned)(bstar + 3873) << 18) | 0x3FFFFu; nlo = bstar == 0 ? 0u : ((unsigned)(bstar + 3873) << 18); }
            } else {
                nlo = lo + ((unsigned)bstar << sh); const unsigned top = nlo + ((1u << sh) - 1u); nhi = top < hi ? top : hi; if (top < nlo) nhi = hi;
            }
            const unsigned range = nhi - nlo;
            unsigned nfl = 0, nsh = 0;
            if (nlo < nhi && (range >= (1u << 19) || cnt > CAP)) { nfl = FL_ACTIVE; const int bits = 32 - __clz(range); nsh = bits > 9 ? (unsigned)(bits - 9) : 0u; *FLAG = 1u; }
            else if (cnt > CAP) nfl = FL_TIE;
            ST[q * 8 + ST_LO] = nlo; ST[q * 8 + ST_HI] = nhi; ST[q * 8 + ST_NEED] = nneed; ST[q * 8 + ST_CNT] = cnt; ST[q * 8 + ST_FLAGS] = nfl; ST[q * 8 + ST_SH] = nsh;
        }
    }
}

__device__ __forceinline__ void idx_unit(const Params& p, int b, int u, char* lds) {
    const h16* P = (const h16*)(p.ws + WS_P); const float* E = (const float*)(p.ws + WS_E);
    unsigned long long* Mk = (unsigned long long*)p.out;
    unsigned* HIST = (unsigned*)(lds + IX_HIST); unsigned* MASK = (unsigned*)(lds + IX_MASK); unsigned* CAND = (unsigned*)(lds + IX_CAND); unsigned* ST = (unsigned*)(lds + IX_ST); unsigned* FLAG = (unsigned*)(lds + IX_FLAG);
    const int tid = threadIdx.x, lane = tid & 63, w = tid >> 6, hl = lane >> 5, cc = lane & 31;
    const int qb = u >> 3, nwords = 4 * qb + 6;
    if (32 * u + 31 < 256) {
        for (int idx = tid; idx < 32 * nwords; idx += NT) {
            const int q = idx & 31, i = idx >> 5, r = 32 * u + q;
            unsigned long long wv;
            if (i == 0) wv = 0xFFFFull; else { const int nv = r - 64 * (i - 1) + 1; wv = nv <= 0 ? 0ull : (nv >= 64 ? ~0ull : ((1ull << nv) - 1ull)); }
            Mk[((size_t)b * NMI + i) * S + r] = wv;
        }
        return;
    }
    for (int i = tid; i < 32 * 256; i += NT) HIST[i] = 0u;
    for (int i = tid; i < 32 * 260; i += NT) MASK[i] = 0u;
    if (tid < 32) { ST[tid * 8 + ST_LO] = 0u; ST[tid * 8 + ST_HI] = 0xFFFFFFFFu; ST[tid * 8 + ST_NEED] = 256u; ST[tid * 8 + ST_CNT] = 0u; ST[tid * 8 + ST_FLAGS] = 0u; ST[tid * 8 + ST_NCAND] = 0u; ST[tid * 8 + ST_SH] = 0u; ST[tid * 8 + ST_RUN] = 0u; }
    if (tid == 0) *FLAG = 0u;
    h16x8 afrag[4]; float wreg[16];
    {
        const int qq = cc >> 3, head = cc & 7;
        const size_t row = (size_t)b * S + 32 * u + 4 * w + qq;
#pragma unroll
        for (int ks = 0; ks < 4; ++ks) afrag[ks] = *(const h16x8*)(P + row * NP2 + C_IQ + head * 64 + 16 * ks + 8 * hl);
#pragma unroll
        for (int q4 = 0; q4 < 4; ++q4) { const f32x4 wv = *(const f32x4*)(E + ((size_t)b * S + 32 * u + 4 * w + q4) * 128 + 64 + 4 * hl); wreg[4 * q4] = wv.x; wreg[4 * q4 + 1] = wv.y; wreg[4 * q4 + 2] = wv.z; wreg[4 * q4 + 3] = wv.w; }
    }
    __syncthreads();
    idx_pass<0>(p, b, u, lds, afrag, wreg);
    idx_scan<0>(lds);
    __syncthreads();
    for (int iter = 0; iter < 8; ++iter) {
        if (*FLAG == 0u) break;
        __syncthreads();
        if (tid == 0) *FLAG = 0u;
        __syncthreads();
        idx_pass<1>(p, b, u, lds, afrag, wreg);
        idx_scan<1>(lds);
        __syncthreads();
    }
    idx_pass<2>(p, b, u, lds, afrag, wreg);
    for (int q4 = 0; q4 < 4; ++q4) {
        const int q = 4 * w + q4;
        const unsigned fl = ST[q * 8 + ST_FLAGS]; if (fl & FL_TIE) continue;
        unsigned nc = ST[q * 8 + ST_NCAND]; if (nc > CAP) nc = CAP;
        const unsigned need = ST[q * 8 + ST_NEED], lo = ST[q * 8 + ST_LO];
        (void)lo;
        const unsigned c0 = lane < nc ? CAND[q * CAP + lane] : 0u, c1 = lane + 64 < nc ? CAND[q * CAP + lane + 64] : 0u;
        unsigned r0 = 0, r1 = 0;
        for (unsigned j = 0; j < nc; ++j) { const unsigned cj = CAND[q * CAP + j]; r0 += cj > c0 ? 1u : 0u; r1 += cj > c1 ? 1u : 0u; }
        if (lane < nc && r0 < need) { const int s = 8191 - (int)(c0 & 0x1FFFu); atomicOr(&MASK[q * 260 + ((s >> 6) + 1) * 2 + ((s >> 5) & 1)], 1u << (s & 31)); }
        if (lane + 64 < nc && r1 < need) { const int s = 8191 - (int)(c1 & 0x1FFFu); atomicOr(&MASK[q * 260 + ((s >> 6) + 1) * 2 + ((s >> 5) & 1)], 1u << (s & 31)); }
    }
    __syncthreads();
    for (int idx = tid; idx < 32 * nwords; idx += NT) {
        const int q = idx & 31, i = idx >> 5, r = 32 * u + q;
        const unsigned long long wv = i == 0 ? 0xFFFFull : ((unsigned long long)MASK[q * 260 + 2 * i] | ((unsigned long long)MASK[q * 260 + 2 * i + 1] << 32));
        Mk[((size_t)b * NMI + i) * S + r] = wv;
    }
    __syncthreads();
}

namespace attn_body {
using bf16=_Float16;
typedef _Float16 fh16x8 __attribute__((ext_vector_type(8)));
typedef unsigned u32x2 __attribute__((ext_vector_type(2)));
#define MFH(a,b,c,x,y,z) __builtin_amdgcn_mfma_f32_32x32x16_f16(__builtin_bit_cast(fh16x8,(a)),__builtin_bit_cast(fh16x8,(b)),(c),0,0,0)
using bf16x8=__attribute__((ext_vector_type(8)))short;
using s16x4=__attribute__((ext_vector_type(4)))short;
using f32x16=__attribute__((ext_vector_type(16)))float;
using u32x4=__attribute__((ext_vector_type(4)))unsigned;
constexpr int BATCH=2,NHEAD=8,SEQ=8192,D=64,DM=NHEAD*D,KVROWS=8320,NMI_=130;
constexpr int NW=8,QBLK=32,QB=QBLK*NW,KVBLK=64,NQB=SEQ/QB;
constexpr int ATTN_PITCH=DM, ATTN_UNIT_ROWS=QB;
__device__ __forceinline__ int crow(int r,int hi){return (r&3)+8*(r>>2)+4*hi;}
#define SBAR() __builtin_amdgcn_sched_barrier(0)
__device__ __forceinline__ float msel(int m,int pos,float keepv){ const int t=__builtin_amdgcn_sbfe(m,pos,1); float d; asm("v_bfi_b32 %0, %1, %2, %3":"=v"(d):"v"(t),"v"(keepv),"s"(0xFF800000u)); return d; }
__device__ __forceinline__ void cinit(f32x16&p0,f32x16&p1,const u32x2&m,int hi,float nmh){
  const int m0=(int)(m[0]>>(4*hi)), m1=(int)(m[1]>>(4*hi));
  #pragma unroll
  for(int r=0;r<16;++r){ const int pos=(r&3)+8*(r>>2); p0[r]=msel(m0,pos,nmh); p1[r]=msel(m1,pos,nmh); }
  asm volatile("s_nop 1":"+v"(p0),"+v"(p1));
}
__device__ __forceinline__ void mload(u32x2&m,const unsigned long long*p){ asm volatile("global_load_dwordx2 %0, %1, off":"=v"(m):"v"(p):"memory"); }
constexpr int NSLOT=3, SLOTB=8192;
constexpr int LDS_K=0, LDS_V=NSLOT*SLOTB, LDS_WS=2*NSLOT*SLOTB, LDS_OST=LDS_WS+NW*64*4, LDS_BYTES=LDS_OST+NW*4096;
constexpr float C2=0.125f*1.4426950408889634f;
__device__ __forceinline__ void glds16(const void*gsrc,unsigned lds_dst){unsigned keep;
  asm volatile("s_mov_b32 %0, m0\n\ts_mov_b32 m0, %2\n\ts_nop 0\n\tglobal_load_lds_dwordx4 %1, off\n\ts_mov_b32 m0, %0":"=&s"(keep):"v"(gsrc),"s"(lds_dst):"memory");}
__device__ __forceinline__ float max3f(float a,float b,float c){float r;asm("v_max3_f32 %0, %1, %2, %3":"=v"(r):"v"(a),"v"(b),"v"(c));return r;}
__device__ __forceinline__ float max2f(float a,float b){float r;asm("v_max_f32_e32 %0, %1, %2":"=v"(r):"v"(a),"v"(b));return r;}
__device__ __forceinline__ float fadd_s(float a,float b){float r;asm("v_add_f32_e32 %0, %1, %2":"=v"(r):"v"(a),"v"(b));return r;}
__device__ __forceinline__ float fsub_s(float a,float b){float r;asm("v_sub_f32_e32 %0, %1, %2":"=v"(r):"v"(a),"v"(b));return r;}
typedef float f32x2_t __attribute__((ext_vector_type(2))); typedef _Float16 bf16x2_t __attribute__((ext_vector_type(2)));
__device__ __forceinline__ unsigned cvtpk_s(float lo,float hi){f32x2_t v={lo,hi};bf16x2_t b=__builtin_convertvector(v,bf16x2_t);return __builtin_bit_cast(unsigned,b);}
#define WAIT_BAR(N) asm volatile("s_waitcnt vmcnt(" #N ") lgkmcnt(0)\n\ts_barrier":::"memory")
#define WAIT_BAR_M(N,M) do{ asm volatile("s_waitcnt vmcnt(" #N ") lgkmcnt(0)\n\ts_barrier":::"memory"); __builtin_amdgcn_sched_barrier(0); asm volatile("":"+v"(M)); }while(0)
#define WAIT_BAR_M2(N,M,M2) do{ asm volatile("s_waitcnt vmcnt(" #N ") lgkmcnt(0)\n\ts_barrier":::"memory"); __builtin_amdgcn_sched_barrier(0); asm volatile("":"+v"(M),"+v"(M2)); }while(0)

__device__ __forceinline__ void qkt(f32x16&p0,f32x16&p1,const char*Kslot,const bf16x8*qr,int r32,int hi){
  const char*kb=Kslot+hi*1024+r32*16;
  #pragma unroll
  for(int d0=0;d0<4;++d0){
    const bf16x8 b0=*reinterpret_cast<const bf16x8*>(kb+d0*2048);
    const bf16x8 b1=*reinterpret_cast<const bf16x8*>(kb+d0*2048+512);
    p0=MFH(b0,qr[d0],p0,0,0,0);p1=MFH(b1,qr[d0],p1,0,0,0);}
}
typedef __attribute__((address_space(3))) const char* lds_cptr;
typedef short v4i16_t __attribute__((ext_vector_type(4)));
__device__ __forceinline__ void kload8(bf16x8*kf,lds_cptr kp){
  kf[0]=*(const __attribute__((address_space(3))) bf16x8*)(kp);      kf[1]=*(const __attribute__((address_space(3))) bf16x8*)(kp+512);
  kf[2]=*(const __attribute__((address_space(3))) bf16x8*)(kp+2048); kf[3]=*(const __attribute__((address_space(3))) bf16x8*)(kp+2560);
  kf[4]=*(const __attribute__((address_space(3))) bf16x8*)(kp+4096); kf[5]=*(const __attribute__((address_space(3))) bf16x8*)(kp+4608);
  kf[6]=*(const __attribute__((address_space(3))) bf16x8*)(kp+6144); kf[7]=*(const __attribute__((address_space(3))) bf16x8*)(kp+6656);
}
__device__ __forceinline__ void kload2(bf16x8*kf,lds_cptr kp,int j){ kf[2*j]=*(const __attribute__((address_space(3))) bf16x8*)(kp+j*2048); kf[2*j+1]=*(const __attribute__((address_space(3))) bf16x8*)(kp+j*2048+512); }
__device__ __forceinline__ s16x4 vtr(lds_cptr p){ return __builtin_bit_cast(s16x4,__builtin_amdgcn_ds_read_tr16_b64_v4i16((__attribute__((address_space(3))) v4i16_t*)p)); }
__device__ __forceinline__ float rowmax(const f32x16&p0,const f32x16&p1){
  float a=max3f(p0[0],p0[1],p1[0]),b=max3f(p0[2],p0[3],p1[1]);a=max3f(a,p1[2],p1[3]);
  #pragma unroll
  for(int r=4;r<16;r+=4){a=max3f(a,p0[r],p0[r+1]);b=max3f(b,p0[r+2],p0[r+3]);a=max3f(a,p1[r],p1[r+1]);b=max3f(b,p1[r+2],p1[r+3]);}
  const float m=max2f(a,b);
  auto rr=__builtin_amdgcn_permlane32_swap(__float_as_uint(m),__float_as_uint(m),false,false);
  return max2f(__uint_as_float(rr[0]),__uint_as_float(rr[1]));
}
__device__ __forceinline__ void pv(f32x16*o,int vb,bf16x8 pa0,bf16x8 pa1,bf16x8 pa2,bf16x8 pa3){
  #pragma unroll
  for(int d0=0;d0<2;++d0){s16x4 lo[4],hi[4];
    #pragma unroll
    for(int ks=0;ks<4;++ks){
      asm volatile("ds_read_b64_tr_b16 %0,%1 offset:%c2":"=&v"(lo[ks]):"v"(vb),"i"(d0*4096+ks*1024):"memory");
      asm volatile("ds_read_b64_tr_b16 %0,%1 offset:%c2":"=&v"(hi[ks]):"v"(vb),"i"(d0*4096+ks*1024+512):"memory");}
    asm volatile("s_waitcnt lgkmcnt(0)":::"memory");SBAR();
    #define PK(k) (bf16x8){lo[k][0],lo[k][1],lo[k][2],lo[k][3],hi[k][0],hi[k][1],hi[k][2],hi[k][3]}
    o[d0]=MFH(pa0,PK(0),o[d0],0,0,0);
    o[d0]=MFH(pa1,PK(1),o[d0],0,0,0);
    o[d0]=MFH(pa2,PK(2),o[d0],0,0,0);
    o[d0]=MFH(pa3,PK(3),o[d0],0,0,0);
    #undef PK
  }
}

#ifndef ATTN_STORE16
#define ATTN_STORE16(p,v) (*(u32x4*)(p)=(v))
#endif
template<int THRL> __device__ __forceinline__ void attn_unit(int b,int h,int qb,const bf16*Q,const bf16*__restrict__ K,const bf16*__restrict__ V,bf16*O,const unsigned long long*__restrict__ Mk,char*shm){
  const int tid=threadIdx.x,lane=tid&63,r32=lane&31,hi=lane>>5; const int wid=__builtin_amdgcn_readfirstlane(tid>>6);
  const long rowbase=(long)b*SEQ, kvbase=(long)b*KVROWS; const int q0=qb*QB;
  const bf16*Qw=Q+(rowbase+q0+wid*QBLK)*DM+h*D;
  const bf16*Kh=K+kvbase*DM+h*D,*Vh=V+kvbase*DM+h*D;
  const unsigned long long*mrow=Mk+(long)b*NMI_*SEQ+(q0+wid*QBLK+r32);
  u32x2 mA,mB; mload(mA,mrow); mload(mB,mrow+SEQ);
  const unsigned lds0=(unsigned)(uintptr_t)shm;
  float*wsf=(float*)(shm+LDS_WS)+wid*64;
  const bf16*ksrc=Kh+(long)lane*DM+wid*8;
  const bf16*vsrc=Vh+(long)(16*(wid&3)+(lane>>2))*DM+(wid>>2)*32+(lane&3)*8;
  const unsigned kdst=lds0+LDS_K+wid*1024, vdst=lds0+LDS_V+wid*1024;
  #define DMA_K(t,slot) glds16(ksrc+(long)(t)*KVBLK*DM,(unsigned)__builtin_amdgcn_readfirstlane(kdst+(slot)))
  #define DMA_V(t,slot) glds16(vsrc+(long)(t)*KVBLK*DM,(unsigned)__builtin_amdgcn_readfirstlane(vdst+(slot)))
  const int vb0=(int)(lds0+LDS_V)+((lane>>4)&1)*32+(lane&3)*8+(4*hi+((lane&15)>>2))*64;
  const char*Kbase=shm+LDS_K; bf16x8 kf[8];
  const lds_cptr shm3=(lds_cptr)shm; const lds_cptr kp0=shm3+LDS_K+hi*1024+r32*16; const lds_cptr vp0=shm3+LDS_V+((lane>>4)&1)*32+(lane&3)*8+(4*hi+((lane&15)>>2))*64;
  const int NT=(q0+QB)/KVBLK+2;
  DMA_K(0,0);DMA_V(0,0);DMA_K(1,SLOTB);
  bf16x8 qr[4];
  #pragma unroll
  for(int d0=0;d0<4;++d0)qr[d0]=*reinterpret_cast<const bf16x8*>(&Qw[(long)r32*DM+d0*16+hi*8]);
  float mhat=0.f,l_reg=0.f;f32x16 o[2];o[0]=f32x16{};o[1]=f32x16{};
  const int qrel=wid*QBLK+r32;
  bool resc=false;
  #define START(P0,P1) do{ const float rm=rowmax(P0,P1); resc=false; \
    { const float dl=rm; mhat=fadd_s(mhat,dl); \
      _Pragma("unroll") for(int r=0;r<16;++r){P0[r]=fsub_s(P0[r],dl);P1[r]=fsub_s(P1[r],dl);} \
      } \
    _Pragma("unroll") for(int r=0;r<16;++r)P0[r]=__builtin_amdgcn_exp2f(P0[r]); }while(0)
  #define RESC() do{ if(resc){ asm volatile("s_waitcnt lgkmcnt(0)":::"memory"); \
      _Pragma("unroll") for(int d_=0;d_<2;++d_) _Pragma("unroll") for(int r=0;r<16;++r)o[d_][r]*=wsf[crow(r,hi)]; } }while(0)
  f32x16 pA0,pA1,pB0,pB1;
  int sl_prev=0,sl_cur=0,sl_next=SLOTB;
  #define ROT() do{sl_prev=sl_cur;sl_cur=sl_next;sl_next=(sl_next==(NSLOT-1)*SLOTB)?0:sl_next+SLOTB;}while(0)
  DMA_K(2,2*SLOTB);
  WAIT_BAR_M2(3,mA,mB);
  cinit(pA0,pA1,mA,hi,0.f);qkt(pA0,pA1,Kbase,qr,r32,hi);asm volatile("s_nop 15\n\ts_nop 7":"+v"(pA0),"+v"(pA1));
  START(pA0,pA1);
  _Pragma("unroll") for(int r=0;r<16;++r)pA1[r]=__builtin_amdgcn_exp2f(pA1[r]);
  WAIT_BAR(0);
  DMA_K(3,0);DMA_V(1,SLOTB);
  ROT();
  kload8(kf,kp0+sl_cur);
  WAIT_BAR(2);
  s16x4 vlo[8],vhi[8]; u32x4 pw0,pw1,pw2,pw3;
  #define PKW(P,B) cvtpk_s(P[B],P[B+1])
  #define PAF(k) __builtin_bit_cast(bf16x8,pw##k)
  #define VFR(i) (bf16x8){vlo[i][0],vlo[i][1],vlo[i][2],vlo[i][3],vhi[i][0],vhi[i][1],vhi[i][2],vhi[i][3]}
  #define PIN(x) asm volatile("":"+v"(x))
  #define MX3(a,b,c) __builtin_fmaxf(__builtin_fmaxf((a),(b)),(c))
  #define GAPA(MF,A0,A1,A2,A3,W0,W1,PW) do{ MF; sacc+=A0; sacc+=A1; sacc+=A2; sacc+=A3; PIN(sacc); W0; W1; PIN(PW); SBAR(); }while(0)
  #define EX(v) __builtin_amdgcn_exp2f(v)
  #define GAPB(MF,X,B) do{ MF; X[B]=EX(X[B]); X[B+1]=EX(X[B+1]); X[B+2]=EX(X[B+2]); X[B+3]=EX(X[B+3]); PIN(X); SBAR(); }while(0)
  #define VRD(i) do{ vlo[i]=vtr(vp_+(((i)>>2)*4096+((i)&3)*1024)); vhi[i]=vtr(vp_+(((i)>>2)*4096+((i)&3)*1024+512)); }while(0)
  #define KRD(G,j) do{ if(G){ kload2(kf,kp0+sl_next,j); SBAR(); } }while(0)
  #define STEP(C0,C1,P0,P1,t,GK,GV,GL,MC,MN,GM) do{ SBAR(); \
    if(GM){mload(MN,mrow+(long)((t)+1)*SEQ);} \
    cinit(C0,C1,MC,hi,-mhat); SBAR(); \
    const lds_cptr vp_=vp0+sl_prev; \
    VRD(0); SBAR(); float sacc=(P0[0]+P0[1]); \
    GAPA(C0=MFH(kf[0],qr[0],C0,0,0,0), P0[2],P0[3],P0[4],P0[5],     pw0[0]=PKW(P0,0), pw0[1]=PKW(P0,2), pw0); \
    VRD(4); SBAR(); GAPA(C1=MFH(kf[1],qr[0],C1,0,0,0), P0[6],P0[7],P0[8],P0[9],     pw0[2]=PKW(P0,4), pw0[3]=PKW(P0,6), pw0); \
    VRD(1); SBAR(); GAPA(C0=MFH(kf[2],qr[1],C0,0,0,0),   P0[10],P0[11],P0[12],P0[13], pw1[0]=PKW(P0,8), pw1[1]=PKW(P0,10), pw1); \
    VRD(5); SBAR(); GAPA(C1=MFH(kf[3],qr[1],C1,0,0,0),   P0[14],P0[15],P1[0],P1[1],   pw1[2]=PKW(P0,12),pw1[3]=PKW(P0,14), pw1); \
    VRD(2); SBAR(); GAPA(C0=MFH(kf[4],qr[2],C0,0,0,0),   P1[2],P1[3],P1[4],P1[5],     pw2[0]=PKW(P1,0), pw2[1]=PKW(P1,2), pw2); \
    VRD(6); SBAR(); GAPA(C1=MFH(kf[5],qr[2],C1,0,0,0),   P1[6],P1[7],P1[8],P1[9],     pw2[2]=PKW(P1,4), pw2[3]=PKW(P1,6), pw2); \
    VRD(3); SBAR(); GAPA(C0=MFH(kf[6],qr[3],C0,0,0,0),   P1[10],P1[11],P1[12],P1[13], pw3[0]=PKW(P1,8), pw3[1]=PKW(P1,10), pw3); \
    VRD(7); SBAR(); GAPA(C1=MFH(kf[7],qr[3],C1,0,0,0),   P1[14],P1[15],0.f,0.f,       pw3[2]=PKW(P1,12),pw3[3]=PKW(P1,14), pw3); \
    l_reg+=sacc; \
    if(GK){DMA_K((t)+3,sl_cur);} if(GV){DMA_V((t)+1,sl_next);} \
    { float a=MX3(C0[0],C0[1],C1[0]),b=MX3(C0[2],C0[3],C1[1]); a=MX3(a,C1[2],C1[3]); \
      _Pragma("unroll") for(int r=4;r<16;r+=4){a=MX3(a,C0[r],C0[r+1]);b=MX3(b,C0[r+2],C0[r+3]);a=MX3(a,C1[r],C1[r+1]);b=MX3(b,C1[r+2],C1[r+3]);} \
      float rm=__builtin_fmaxf(a,b); { auto rr=__builtin_amdgcn_permlane32_swap(__float_as_uint(rm),__float_as_uint(rm),false,false); rm=__builtin_fmaxf(__uint_as_float(rr[0]),__uint_as_float(rr[1])); } \
      resc=false; \
      if(__builtin_expect(__any(rm>(float)THRL),0)){ const float dl=__builtin_fmaxf(rm,0.f); mhat+=dl; \
        _Pragma("unroll") for(int r=0;r<16;++r){C0[r]-=dl;C1[r]-=dl;} \
        const float f=__builtin_amdgcn_exp2f(-dl); l_reg*=f; if(hi==0)wsf[r32]=f; resc=true; } } \
    SBAR(); \
    GAPB(o[0]=MFH(PAF(0),VFR(0),o[0],0,0,0), C0,0); \
    GAPB(o[1]=MFH(PAF(0),VFR(4),o[1],0,0,0), C0,4); \
    KRD(GL,0); GAPB(o[0]=MFH(PAF(1),VFR(1),o[0],0,0,0), C0,8); \
    KRD(GL,1); GAPB(o[1]=MFH(PAF(1),VFR(5),o[1],0,0,0), C0,12); \
    KRD(GL,2); GAPB(o[0]=MFH(PAF(2),VFR(2),o[0],0,0,0), C1,0); \
    KRD(GL,3); GAPB(o[1]=MFH(PAF(2),VFR(6),o[1],0,0,0), C1,4); \
    GAPB(o[0]=MFH(PAF(3),VFR(3),o[0],0,0,0), C1,8); \
    GAPB(o[1]=MFH(PAF(3),VFR(7),o[1],0,0,0), C1,12); \
    }while(0)
  int t=1;
  for(;t+5<NT;t+=2){
    STEP(pB0,pB1,pA0,pA1,t,true,true,true,mB,mA,true);     WAIT_BAR_M(2,mA); RESC(); ROT();
    STEP(pA0,pA1,pB0,pB1,t+1,true,true,true,mA,mB,true);   WAIT_BAR_M(2,mB); RESC(); ROT();
  }
  #define ENDW(tt,M) do{ if((tt)+3<NT){WAIT_BAR_M(2,M);} else if((tt)+2<NT){WAIT_BAR_M(1,M);} else {WAIT_BAR_M(0,M);} }while(0)
  for(;t+1<NT;t+=2){
    STEP(pB0,pB1,pA0,pA1,t,(t+3<NT),(t+1<NT),(t+1<NT),mB,mA,(t+1<NT));       ENDW(t,mA);   RESC(); ROT();
    STEP(pA0,pA1,pB0,pB1,t+1,(t+4<NT),(t+2<NT),(t+2<NT),mA,mB,(t+2<NT));     ENDW(t+1,mB); RESC(); ROT();
  }
  STEP(pB0,pB1,pA0,pA1,NT-1,false,false,false,mB,mA,false); RESC();
  { float sacc=pB0[0]+pB0[1]; _Pragma("unroll") for(int r=2;r<16;++r)sacc+=pB0[r]; _Pragma("unroll") for(int r=0;r<16;++r)sacc+=pB1[r]; l_reg+=sacc;
    pw0=(u32x4){PKW(pB0,0),PKW(pB0,2),PKW(pB0,4),PKW(pB0,6)};pw1=(u32x4){PKW(pB0,8),PKW(pB0,10),PKW(pB0,12),PKW(pB0,14)};pw2=(u32x4){PKW(pB1,0),PKW(pB1,2),PKW(pB1,4),PKW(pB1,6)};pw3=(u32x4){PKW(pB1,8),PKW(pB1,10),PKW(pB1,12),PKW(pB1,14)};
    SBAR(); pv(o,vb0+sl_cur,PAF(0),PAF(1),PAF(2),PAF(3)); }
  #undef PKW
  #undef PAF
  #undef VFR
  #undef PIN
  #undef MX3
  #undef GAPA
  #undef GAPB
  #undef EX
  #undef VRD
  #undef KRD
  #undef STEP
  #undef ENDW
  {auto rr=__builtin_amdgcn_permlane32_swap(__float_as_uint(l_reg),__float_as_uint(l_reg),false,false);l_reg=__uint_as_float(rr[0])+__uint_as_float(rr[1]);}
  if(hi==0)wsf[32+r32]=l_reg;asm volatile("s_waitcnt lgkmcnt(0)":::"memory");
  float rli[16];
  #pragma unroll
  for(int r=0;r<16;++r)rli[r]=__builtin_amdgcn_rcpf(wsf[32+crow(r,hi)]);
  bf16*Ow=O+(rowbase+q0+wid*QBLK)*DM+h*D;
  { bf16*stg=(bf16*)(shm+LDS_OST)+wid*2048;
    #pragma unroll
    for(int r=0;r<16;++r){const int orow=crow(r,hi);
      #pragma unroll
      for(int d0=0;d0<2;++d0)stg[orow*64+d0*32+r32]=(bf16)(o[d0][r]*rli[r]);}
    asm volatile("s_waitcnt lgkmcnt(0)":::"memory");
    #pragma unroll
    for(int i=0;i<4;++i){const int row=i*8+(lane>>3),ch=lane&7; const u32x4 v=*(const u32x4*)(stg+row*64+ch*8); ATTN_STORE16(Ow+(long)row*DM+ch*8,v);} }
  asm volatile("s_waitcnt lgkmcnt(0)\n\ts_barrier":::"memory");
  #undef DMA_K
  #undef DMA_V
  #undef START
  #undef RESC
  #undef ROT
}
constexpr int ATTN_LDS_BYTES=LDS_BYTES;
struct AttnTensors { const bf16* Q; const bf16* K; const bf16* V; bf16* O; const unsigned long long* Mk; };
struct AttnUnit { int bh; int qb; };
struct StaticOrder {
  int vcu,G;
  __device__ __forceinline__ explicit StaticOrder(int grid,int block):vcu((grid%8==0)?((block%8)*(grid/8)+block/8):block),G(grid){}
  __device__ __forceinline__ bool next(int i,AttnUnit&u)const{ const int v=vcu+G*(i>>1); if(v>=256)return false; const int s=v&15; u.bh=v>>4; u.qb=(i&1)?s:31-s; return true; }
};
template<class Sched,int THRL=8> __device__ __forceinline__ void attn_phase(char*lds,const AttnTensors&T,const Sched&S){
  AttnUnit u;
  for(int i=0;S.next(i,u);++i){ attn_unit<THRL>(u.bh/NHEAD,u.bh%NHEAD,u.qb,T.Q,T.K,T.V,T.O,T.Mk,lds); }
}
#undef SBAR
#undef WAIT_BAR
#undef WAIT_BAR_M
#undef WAIT_BAR_M2
#undef MFH
}

__device__ __forceinline__ float hgrn_lb(const Params& p, int idx) { const float l0 = p.lb_logits[idx], l1 = p.lb_logits[512 + idx]; return 1.f / (1.f + __expf(l1 - l0)); }

__device__ __forceinline__ void hgrn_stepA(const Params& p, int item, char* lds) {
    float* kd = (float*)lds;
    float* kk = kd + 64 * 128;
    float* vv = kk + 64 * 128;
    const h16* P = (const h16*)(p.ws + WS_P); float* ST = (float*)(p.ws + WS_X); float* G = (float*)(p.ws + WS_G);
    const int tid = threadIdx.x;
    const int c = item % NCH, bh = item / NCH, h = bh & 3, b = bh >> 2;
    const int L = c == 0 ? 16 : 64; const size_t rowbase = c == 0 ? (size_t)MREAL : (size_t)(b * S + (c - 1) * 64);
    for (int i = tid; i < L * 128; i += NT) { const int t = i >> 7, v = i & 127; vv[t * 128 + v] = (float)P[(rowbase + t) * NP2 + C_HI + h * 128 + v]; }
    if (tid < 128) {
        const int d = tid; const float lb = hgrn_lb(p, h * 128 + d);
        float bc = 0.f;
        for (int t = 0; t < L; ++t) {
            const float hf = (float)P[(rowbase + t) * NP2 + C_HF + h * 128 + d];
            const float f = lb + (1.f - lb) * sigmoidf_(hf);
            bc += logf(f); kd[t * 128 + d] = bc; kk[t * 128 + d] = 1.f - f;
        }
        for (int t = 0; t < L; ++t) kd[t * 128 + d] = kk[t * 128 + d] * __expf(bc - kd[t * 128 + d]);
        G[(size_t)item * 128 + d] = __expf(bc);
    }
    __syncthreads();
    const int d = tid & 127, vg = tid >> 7;
    float acc[32];
#pragma unroll
    for (int j = 0; j < 32; ++j) acc[j] = 0.f;
    for (int s = 0; s < L; ++s) {
        const float kv = kd[s * 128 + d];
#pragma unroll
        for (int j = 0; j < 32; j += 4) { const f32x4 v4 = *(const f32x4*)(vv + s * 128 + vg * 32 + j); acc[j] += kv * v4.x; acc[j + 1] += kv * v4.y; acc[j + 2] += kv * v4.z; acc[j + 3] += kv * v4.w; }
    }
    float* o = ST + (size_t)item * 16384 + d * 128 + vg * 32;
#pragma unroll
    for (int j = 0; j < 32; j += 4) *(f32x4*)(o + j) = (f32x4){acc[j], acc[j + 1], acc[j + 2], acc[j + 3]};
    __syncthreads();
}

__device__ __forceinline__ void hgrn_scan(const Params& p) {
    float* ST = (float*)(p.ws + WS_X); const float* G = (const float*)(p.ws + WS_G);
    for (int idx = blockIdx.x * NT + threadIdx.x; idx < NB * 4 * 16384; idx += gridDim.x * NT) {
        const int bh = idx >> 14, e = idx & 16383, d = e >> 7;
        float Sv = 0.f;
        for (int c = 0; c < NCH; ++c) {
            const size_t off = (size_t)(bh * NCH + c) * 16384 + e;
            const float u = ST[off]; const float g = G[(size_t)(bh * NCH + c) * 128 + d];
            ST[off] = Sv; Sv = g * Sv + u;
        }
    }
}

__device__ __forceinline__ void hgrn_stepC(const Params& p, int item, char* lds) {
    float* bq = (float*)lds;
    float* qq = bq + 64 * 65;
    float* kk = qq + 64 * 65;
    float* Am = kk + 64 * 65;
    float* qe = Am + 64 * 65;
    float* vv = qe + 64 * 128;
    h16* P = (h16*)(p.ws + WS_P); const float* ST = (const float*)(p.ws + WS_X);
    const int tid = threadIdx.x;
    const int c = 1 + item % 128, bh = item / 128, h = bh & 3, b = bh >> 2;
    const size_t rowbase = (size_t)(b * S + (c - 1) * 64);
    for (int i = tid; i < 64 * 128; i += NT) { const int t = i >> 7, v = i & 127; vv[t * 128 + v] = (float)P[(rowbase + t) * NP2 + C_HI + h * 128 + v]; }
    float aacc[8];
#pragma unroll
    for (int i = 0; i < 8; ++i) aacc[i] = 0.f;
    for (int half = 0; half < 2; ++half) {
        if (tid < 64) {
            const int d = half * 64 + tid; const float lb = hgrn_lb(p, h * 128 + d);
            float bc = 0.f;
            for (int t = 0; t < 64; ++t) {
                const float hf = (float)P[(rowbase + t) * NP2 + C_HF + h * 128 + d];
                const float f = lb + (1.f - lb) * sigmoidf_(hf);
                bc += logf(f); bq[t * 65 + tid] = bc; kk[t * 65 + tid] = 1.f - f;
            }
        }
        for (int i = tid; i < 64 * 64; i += NT) { const int t = i >> 6, dl = i & 63; qq[t * 65 + dl] = siluf_((float)P[(rowbase + t) * NP2 + C_HQ + h * 128 + half * 64 + dl]); }
        __syncthreads();
#pragma unroll
        for (int i = 0; i < 8; ++i) {
            const int pr = tid + NT * i, t = pr >> 6, s = pr & 63;
            if (s <= t) { float sum = 0.f;
                for (int dl = 0; dl < 64; ++dl) sum += qq[t * 65 + dl] * kk[s * 65 + dl] * __expf(bq[t * 65 + dl] - bq[s * 65 + dl]);
                aacc[i] += sum; }
        }
        for (int i = tid; i < 64 * 64; i += NT) { const int t = i >> 6, dl = i & 63; qe[t * 128 + half * 64 + dl] = qq[t * 65 + dl] * __expf(bq[t * 65 + dl]); }
        __syncthreads();
    }
#pragma unroll
    for (int i = 0; i < 8; ++i) { const int pr = tid + NT * i, t = pr >> 6, s = pr & 63; Am[t * 65 + s] = aacc[i]; }
    __syncthreads();
    const int v = tid & 127, tg = tid >> 7;
    float acc[16];
#pragma unroll
    for (int i = 0; i < 16; ++i) acc[i] = 0.f;
    for (int s = 0; s < 64; ++s) { const float vval = vv[s * 128 + v];
#pragma unroll
        for (int i = 0; i < 16; ++i) acc[i] += Am[(tg * 16 + i) * 65 + s] * vval; }
    const float* sp = ST + (size_t)(bh * NCH + c) * 16384 + v;
    for (int d = 0; d < 128; ++d) { const float sv = sp[d * 128];
#pragma unroll
        for (int i = 0; i < 16; ++i) acc[i] += qe[(tg * 16 + i) * 128 + d] * sv; }
#pragma unroll
    for (int i = 0; i < 16; ++i) P[(rowbase + tg * 16 + i) * NP2 + C_HQ + h * 128 + v] = (h16)acc[i];
    __syncthreads();
}

__device__ __forceinline__ void phase_mix(const Params& p) {
    const h16* P = (const h16*)(p.ws + WS_P); h16* MIX = (h16*)(p.ws + WS_X);
    const int lane = threadIdx.x & 63, wave = threadIdx.x >> 6;
    for (int row = blockIdx.x * 8 + wave; row < MREAL; row += gridDim.x * 8) {
        const h16* pr = P + (size_t)row * NP2; h16* o = MIX + (size_t)row * D; const h16* qo = (const h16*)(p.ws + WS_QB) + (size_t)row * 512;
        { const h16x8 a = *(const h16x8*)(qo + lane * 8); const h16x8 g = *(const h16x8*)(pr + C_AG + lane * 8);
          float ss = 0.f;
#pragma unroll
          for (int j = 0; j < 8; ++j) ss += (float)a[j] * (float)a[j];
          const float rs = rsqrtf(wave_sum(ss) * (1.f / 512.f) + 1e-6f);
          h16x8 ov;
#pragma unroll
          for (int j = 0; j < 8; ++j) ov[j] = (h16)((float)a[j] * rs * p.attn_norm[lane * 8 + j] * siluf_((float)g[j]));
          *(h16x8*)(o + lane * 8) = ov; }
        { const h16x8 a = *(const h16x8*)(pr + C_HQ + lane * 8); const h16x8 g = *(const h16x8*)(pr + C_HG + lane * 8);
          float ss = 0.f;
#pragma unroll
          for (int j = 0; j < 8; ++j) ss += (float)a[j] * (float)a[j];
#pragma unroll
          for (int o2 = 1; o2 < 16; o2 <<= 1) ss += __shfl_xor(ss, o2);
          const float rs = rsqrtf(ss * (1.f / 128.f) + 1e-6f);
          h16x8 ov;
#pragma unroll
          for (int j = 0; j < 8; ++j) ov[j] = (h16)((float)a[j] * rs * p.hgrn_norm[(lane & 15) * 8 + j] * siluf_((float)g[j]));
          *(h16x8*)(o + 512 + lane * 8) = ov; }
    }
}

__device__ __forceinline__ void phase_final(const Params& p) {
    const int lane = threadIdx.x & 63, wave = threadIdx.x >> 6;
    for (int row = blockIdx.x * 8 + wave; row < MREAL; row += gridDim.x * 8) {
        float* o = p.out + (size_t)row * D;
        f32x4 v[4]; float ss = 0.f;
        for (int j = 0; j < 4; ++j) { v[j] = *(const f32x4*)(o + (lane + 64 * j) * 4); ss += v[j].x * v[j].x + v[j].y * v[j].y + v[j].z * v[j].z + v[j].w * v[j].w; }
        const float rs = rsqrtf(wave_sum(ss) * (1.f / D) + 1e-6f);
        for (int j = 0; j < 4; ++j) { const f32x4 g = *(const f32x4*)(p.final_norm + (lane + 64 * j) * 4);
            *(f32x4*)(o + (lane + 64 * j) * 4) = (f32x4){v[j].x * rs * g.x, v[j].y * rs * g.y, v[j].z * rs * g.z, v[j].w * rs * g.w}; }
    }
}

constexpr int NPHASE = 9;
__global__ void __launch_bounds__(NT, 2) mega(Params p, int ph_lo, int ph_hi) {
    extern __shared__ __attribute__((aligned(16))) char lds[];
    cg::grid_group grid = cg::this_grid();
#define IN(k) (ph_lo <= (k) && (k) < ph_hi)
#define SYNC(k) do { if ((k) + 1 < ph_hi) grid.sync(); } while (0)
    if (IN(0)) { phase_prep(p, lds); SYNC(0); }
    if (IN(1)) { phase_gemm_in(p, lds); SYNC(1); }
    if (IN(2)) { phase_post(p); SYNC(2); }
    if (IN(3)) {
        constexpr int NA = NB * 4 * NCH;
        for (int it = blockIdx.x; it < 512; it += gridDim.x) { const int uu = it < 256 ? 255 - (it >> 1) : (it - 256) >> 1; idx_unit(p, it & 1, uu, lds); }
        for (int it = blockIdx.x; it < NA; it += gridDim.x) hgrn_stepA(p, it, lds);
        SYNC(3);
    }
    if (IN(4)) { hgrn_scan(p); SYNC(4); }
    if (IN(5)) {
        constexpr int NC = NB * 4 * 128;
        for (int it = blockIdx.x; it < NC; it += gridDim.x) hgrn_stepC(p, it, lds);
        {
            const attn_body::AttnTensors AT{(const h16*)(p.ws + WS_QB), (const h16*)(p.ws + WS_KB), (const h16*)(p.ws + WS_VB), (h16*)(p.ws + WS_QB), (const unsigned long long*)p.out};
            const attn_body::StaticOrder SO((int)gridDim.x, (int)blockIdx.x);
            attn_body::attn_phase<attn_body::StaticOrder>(lds, AT, SO);
        }
        SYNC(5);
    }
    if (IN(6)) { phase_mix(p); SYNC(6); }
    if (IN(7)) { phase_gemm_out(p, lds); SYNC(7); }
    if (IN(8)) { phase_final(p); }
#undef IN
#undef SYNC
}

extern "C" void kernel_launch(void* const* d_in, const int* in_sizes, int n_in, void* d_out, int out_size, void* d_ws, size_t ws_size, hipStream_t stream) {
    static int grid = 0;
    if (grid == 0) {
        if (n_in != 11 || ws_size < WS_END || out_size != MREAL * D) { fprintf(stderr, "kernel_launch: unexpected shapes n_in %d ws %zu out %d\n", n_in, ws_size, out_size); grid = -1; return; }
        int dev = 0, cus = 0, per_cu = 0;
        hipGetDevice(&dev); hipDeviceGetAttribute(&cus, hipDeviceAttributeMultiprocessorCount, dev);
        hipFuncSetAttribute((const void*)mega, hipFuncAttributeMaxDynamicSharedMemorySize, LDS_BYTES);
        hipOccupancyMaxActiveBlocksPerMultiprocessor(&per_cu, (const void*)mega, NT, LDS_BYTES);
        if (per_cu < 1) { fprintf(stderr, "kernel_launch: occupancy query says %d\n", per_cu); per_cu = 1; }
        grid = cus * 1;
        (void)hipGetLastError();
    }
    if (grid < 0) return;
    Params p{};
    p.x = (const float*)d_in[0]; p.meta = (const float*)d_in[1]; p.mix_norm = (const float*)d_in[2]; p.w_in = (const float*)d_in[3];
    p.idx_g = (const float*)d_in[4]; p.idx_b = (const float*)d_in[5]; p.attn_norm = (const float*)d_in[6]; p.lb_logits = (const float*)d_in[7];
    p.hgrn_norm = (const float*)d_in[8]; p.w_out = (const float*)d_in[9]; p.final_norm = (const float*)d_in[10];
    p.out = (float*)d_out; p.ws = (unsigned char*)d_ws;
#if N_LAUNCH_MODE == 1
    int lo = 0, hi = NPHASE; void* args[] = {&p, &lo, &hi};
    hipError_t e = hipLaunchCooperativeKernel((const void*)mega, dim3(grid), dim3(NT), args, LDS_BYTES, stream);
    if (e != hipSuccess) fprintf(stderr, "cooperative launch failed: %s (grid %d)\n", hipGetErrorString(e), grid);
#else
    for (int ph = 0; ph < NPHASE; ++ph) hipLaunchKernelGGL(mega, dim3(grid), dim3(NT), LDS_BYTES, stream, p, ph, ph + 1);
#endif
}
```

```cpp
#include <hip/hip_runtime.h>
#include <hip/hip_cooperative_groups.h>
#include <cstdint>
#include <cstdio>
namespace cg = cooperative_groups;

typedef _Float16 h16;
typedef _Float16 h16x8 __attribute__((ext_vector_type(8)));
typedef _Float16 h16x4 __attribute__((ext_vector_type(4)));
typedef float f32x4 __attribute__((ext_vector_type(4)));

#ifndef PROBE
#define PROBE 0
#endif
#ifndef N_LAUNCH_MODE
#define N_LAUNCH_MODE 1
#endif

constexpr int NB = 2, S = 8192, NMETA = 16, D = 1024;
constexpr int MREAL = NB * S;
constexpr int MROWS = MREAL + NMETA;
constexpr int MPAD = 16640;
constexpr int NCOL = 4680, NPAD = 4864;
constexpr int G_IK = 4608;
constexpr int NP2 = 3328;
constexpr int C_AG = 0, C_IQ = 512, C_HQ = 1024, C_HF = 1536, C_HI = 2048, C_HG = 2560, C_IK = 3072, C_IW = 3136;
constexpr int KVROWS = 8320;
constexpr int NCH = 129;
constexpr int NT = 512;

constexpr size_t MiB = 1u << 20;
constexpr size_t WS_WTIN = 1 * MiB, WS_WTOUT = 11 * MiB, WS_ROPE = 13 * MiB, WS_E = 14 * MiB, WS_KI = 23 * MiB, WS_G = 26 * MiB, WS_P = 27 * MiB, WS_QB = 133 * MiB, WS_KB = 149 * MiB, WS_VB = 166 * MiB, WS_X = 190 * MiB, WS_END = 256 * MiB;
static_assert(WS_P + (size_t)MPAD * NP2 * 2 <= WS_QB && WS_QB + (size_t)MREAL * 512 * 2 <= WS_KB && WS_KB + (size_t)NB * KVROWS * 512 * 2 <= WS_VB && WS_VB + (size_t)NB * KVROWS * 512 * 2 <= WS_X, "ws map");
static_assert(WS_X + (size_t)NB * 4 * NCH * 16384 * 4 <= WS_END, "ST");

constexpr int LDS_BYTES = 140 * 1024;

struct Params {
    const float *x, *meta, *mix_norm, *w_in, *idx_g, *idx_b, *attn_norm, *lb_logits, *hgrn_norm, *w_out, *final_norm;
    float* out; unsigned char* ws;
};

__device__ __forceinline__ float wave_sum(float v) {
#pragma unroll
    for (int o = 1; o < 64; o <<= 1) v += __shfl_xor(v, o);
    return v;
}
__device__ __forceinline__ float wave_max(float v) {
#pragma unroll
    for (int o = 1; o < 64; o <<= 1) v = fmaxf(v, __shfl_xor(v, o));
    return v;
}
__device__ __forceinline__ float sigmoidf_(float x) { return 1.f / (1.f + __expf(-x)); }
__device__ __forceinline__ float siluf_(float x) { return x * sigmoidf_(x); }
__device__ __forceinline__ int oldcol(int n) { return n < 2560 ? n : (n < 4608 ? n + 72 : (n < 4672 ? 2560 + (n - 4608) : 2624 + (n - 4672))); }
__device__ __forceinline__ unsigned skey(float x) { if (x == 0.f) x = 0.f; unsigned u = __float_as_uint(x); return (u & 0x80000000u) ? ~u : (u | 0x80000000u); }

__device__ __forceinline__ void transpose_item(const float* __restrict__ W, int ldw, int nvalid, bool remap, h16* __restrict__ WT, int K, int item, float* tile) {
    constexpr float C2 = 0.125f * 1.4426950408889634f;
    const int nkt = K / 64, nb = item / nkt, kb = item % nkt, n0 = nb * 64, k0 = kb * 64, tid = threadIdx.x;
    {
        const int nl = tid & 63, kl = tid >> 6, n = n0 + nl;
        int src = -1; if (n < nvalid) src = remap ? oldcol(n) : n;
        const float scl = (remap && n < 512) ? C2 : 1.f;
        for (int kk = kl; kk < 64; kk += 8) tile[kk * 65 + nl] = (src >= 0) ? W[(size_t)(k0 + kk) * ldw + src] * scl : 0.f;
    }
    __syncthreads();
    {
        const int kl = tid & 63, nl = tid >> 6;
        for (int nn = nl; nn < 64; nn += 8) WT[(size_t)(n0 + nn) * K + k0 + kl] = (h16)tile[kl * 65 + nn];
    }
    __syncthreads();
}

__device__ __forceinline__ void phase_prep(const Params& p, char* lds) {
    float* tile = (float*)lds;
    h16* WTin = (h16*)(p.ws + WS_WTIN); h16* WTout = (h16*)(p.ws + WS_WTOUT);
    constexpr int I_IN = (NPAD / 64) * (D / 64), I_OUT = (D / 64) * (D / 64);
    for (int it = blockIdx.x; it < I_IN + I_OUT; it += gridDim.x) {
        if (it < I_IN) transpose_item(p.w_in, NCOL, NCOL, true, WTin, D, it, tile);
        else transpose_item(p.w_out, D, D, false, WTout, D, it - I_IN, tile);
    }
    h16* HN = (h16*)(p.ws + WS_X);
    const int lane = threadIdx.x & 63, wave = threadIdx.x >> 6;
    for (int row = blockIdx.x * 8 + wave; row < MPAD; row += gridDim.x * 8) {
        h16* o = HN + (size_t)row * D;
        if (row >= MROWS) {
            for (int j = 0; j < 4; ++j) { h16x4 z = {(h16)0.f, (h16)0.f, (h16)0.f, (h16)0.f}; *(h16x4*)(o + (lane + 64 * j) * 4) = z; }
            continue;
        }
        const float* src = row < MREAL ? p.x + (size_t)row * D : p.meta + (size_t)(row - MREAL) * D;
        f32x4 v[4]; float ss = 0.f;
        for (int j = 0; j < 4; ++j) { v[j] = *(const f32x4*)(src + (lane + 64 * j) * 4); ss += v[j].x * v[j].x + v[j].y * v[j].y + v[j].z * v[j].z + v[j].w * v[j].w; }
        const float rs = rsqrtf(wave_sum(ss) * (1.f / D) + 1e-6f);
        for (int j = 0; j < 4; ++j) {
            const f32x4 g = *(const f32x4*)(p.mix_norm + (lane + 64 * j) * 4);
            h16x4 hv = {(h16)(v[j].x * rs * g.x), (h16)(v[j].y * rs * g.y), (h16)(v[j].z * rs * g.z), (h16)(v[j].w * rs * g.w)};
            *(h16x4*)(o + (lane + 64 * j) * 4) = hv;
        }
    }
    {
        h16* KB = (h16*)(p.ws + WS_KB); h16* VB = (h16*)(p.ws + WS_VB);
        for (int idx = blockIdx.x * NT + threadIdx.x; idx < NB * 112 * 64; idx += gridDim.x * NT) {
            const int c = idx & 63, rr = (idx >> 6) % 112, b = idx / (112 * 64);
            const int row = b * KVROWS + (rr < 48 ? 16 + rr : 8256 + (rr - 48));
            const h16x8 z = {(h16)0.f, (h16)0.f, (h16)0.f, (h16)0.f, (h16)0.f, (h16)0.f, (h16)0.f, (h16)0.f};
            *(h16x8*)(KB + (size_t)row * 512 + c * 8) = z; *(h16x8*)(VB + (size_t)row * 512 + c * 8) = z;
        }
    }
    float* ROPE = (float*)(p.ws + WS_ROPE);
    const double inv[8] = {1.0, 0.1939227432012558, 0.03760603070259094, 0.007292664609849453, 0.0014142135623842478, 0.00027424818836152554, 5.3182957344688475e-05, 1.0313385246263351e-05};
    for (int idx = blockIdx.x * NT + threadIdx.x; idx < (S + NMETA) * 8; idx += gridDim.x * NT) {
        const int t = idx >> 3, i = idx & 7;
        double iv = inv[0];
        if (i == 1) iv = inv[1]; else if (i == 2) iv = inv[2]; else if (i == 3) iv = inv[3]; else if (i == 4) iv = inv[4]; else if (i == 5) iv = inv[5]; else if (i == 6) iv = inv[6]; else if (i == 7) iv = inv[7];
        const double rev = (double)t * iv * 0.15915494309189535;
        const float fr = (float)(rev - __builtin_rint(rev));
        ROPE[idx * 2] = __builtin_amdgcn_cosf(fr); ROPE[idx * 2 + 1] = __builtin_amdgcn_sinf(fr);
    }
}

template <int EPI>
__device__ __forceinline__ void gemm_tile(const Params& p, const h16* __restrict__ A, int lda, const h16* __restrict__ Bt, int ldb, int K, int pm, int pn, char* lds) {
    h16* As = (h16*)lds;
    h16* Bs = As + 128 * 40;
    const int tid = threadIdx.x, lane = tid & 63, wave = tid >> 6, wr = wave >> 2, wc = wave & 3;
    const int arow = tid >> 2, apart = tid & 3;
    const h16* ag = A + (size_t)(pm * 128 + arow) * lda + apart * 8;
    const h16* bg0 = Bt + (size_t)(pn * 256 + (tid >> 2)) * ldb + apart * 8;
    const h16* bg1 = Bt + (size_t)(pn * 256 + 128 + (tid >> 2)) * ldb + apart * 8;
    f32x4 acc[4][4];
#pragma unroll
    for (int m = 0; m < 4; ++m)
#pragma unroll
        for (int n = 0; n < 4; ++n) acc[m][n] = (f32x4){0.f, 0.f, 0.f, 0.f};
    h16x8 ra = *(const h16x8*)ag, rb0 = *(const h16x8*)bg0, rb1 = *(const h16x8*)bg1;
    const int nk = K / 32;
    for (int kt = 0; kt < nk; ++kt) {
        *(h16x8*)(As + arow * 40 + apart * 8) = ra;
        *(h16x8*)(Bs + (tid >> 2) * 40 + apart * 8) = rb0;
        *(h16x8*)(Bs + (128 + (tid >> 2)) * 40 + apart * 8) = rb1;
        __syncthreads();
        if (kt + 1 < nk) { ra = *(const h16x8*)(ag + (kt + 1) * 32); rb0 = *(const h16x8*)(bg0 + (kt + 1) * 32); rb1 = *(const h16x8*)(bg1 + (kt + 1) * 32); }
        h16x8 af[4], bf[4];
#pragma unroll
        for (int m = 0; m < 4; ++m) af[m] = *(const h16x8*)(As + (wr * 64 + m * 16 + (lane & 15)) * 40 + (lane >> 4) * 8);
#pragma unroll
        for (int n = 0; n < 4; ++n) bf[n] = *(const h16x8*)(Bs + (wc * 64 + n * 16 + (lane & 15)) * 40 + (lane >> 4) * 8);
#pragma unroll
        for (int m = 0; m < 4; ++m)
#pragma unroll
            for (int n = 0; n < 4; ++n) acc[m][n] = __builtin_amdgcn_mfma_f32_16x16x32_f16(af[m], bf[n], acc[m][n], 0, 0, 0);
        __syncthreads();
    }
#pragma unroll
    for (int m = 0; m < 4; ++m)
#pragma unroll
        for (int n = 0; n < 4; ++n)
#pragma unroll
            for (int r = 0; r < 4; ++r) {
                const int grow = pm * 128 + wr * 64 + m * 16 + (lane >> 4) * 4 + r, gcol = pn * 256 + wc * 64 + n * 16 + (lane & 15);
                const float v = acc[m][n][r];
                if (EPI == 0) {
                    if (gcol < 512) { if (grow < MREAL) ((h16*)(p.ws + WS_QB))[(size_t)grow * 512 + gcol] = (h16)v; }
                    else if (gcol < 1536) {
                        h16* dst = (h16*)(p.ws + (gcol < 1024 ? WS_KB : WS_VB)); const int cc = (gcol - 512) & 511;
                        if (grow < MREAL) dst[((size_t)(grow >> 13) * KVROWS + 64 + (grow & (S - 1))) * 512 + cc] = (h16)v;
                        else if (grow < MROWS) { dst[(size_t)(grow - MREAL) * 512 + cc] = (h16)v; dst[((size_t)KVROWS + (grow - MREAL)) * 512 + cc] = (h16)v; }
                    } else {
                        ((h16*)(p.ws + WS_P))[(size_t)grow * NP2 + (gcol - 1536)] = (h16)v;
                        if (gcol >= G_IK && gcol < G_IK + 128) ((float*)(p.ws + WS_E))[(size_t)grow * 128 + (gcol - G_IK)] = v;
                    }
                } else {
                    p.out[(size_t)grow * D + gcol] = p.x[(size_t)grow * D + gcol] + v;
                }
            }
}

__device__ __forceinline__ void phase_gemm_in(const Params& p, char* lds) {
    constexpr int NM = MPAD / 128, NN = NPAD / 256;
    for (int t = blockIdx.x; t < NM * NN; t += gridDim.x)
        gemm_tile<0>(p, (const h16*)(p.ws + WS_X), D, (const h16*)(p.ws + WS_WTIN), D, D, t / NN, t % NN, lds);
}
__device__ __forceinline__ void phase_gemm_out(const Params& p, char* lds) {
    constexpr int NM = MREAL / 128, NN = D / 256;
    for (int t = blockIdx.x; t < NM * NN; t += gridDim.x)
        gemm_tile<1>(p, (const h16*)(p.ws + WS_X), D, (const h16*)(p.ws + WS_WTOUT), D, D, t / NN, t % NN, lds);
}

__device__ __forceinline__ void phase_post(const Params& p) {
    h16* P = (h16*)(p.ws + WS_P); const float* E = (const float*)(p.ws + WS_E); h16* KI = (h16*)(p.ws + WS_KI); const float* ROPE = (const float*)(p.ws + WS_ROPE);
    h16* QBf = (h16*)(p.ws + WS_QB); h16* KBf = (h16*)(p.ws + WS_KB);
    const int lane = threadIdx.x & 63, wave = threadIdx.x >> 6;
    for (int row = blockIdx.x * 8 + wave; row < MROWS; row += gridDim.x * 8) {
        const int t = row < MREAL ? NMETA + (row & (S - 1)) : row - MREAL;
        {
            const int head = lane >> 3, i = lane & 7;
            const float c = ROPE[(t * 8 + i) * 2], s = ROPE[(t * 8 + i) * 2 + 1];
            auto rope2 = [&](h16* base) { h16* pr = base + head * 64; const float x1 = (float)pr[i], x2 = (float)pr[i + 8]; pr[i] = (h16)(x1 * c - x2 * s); pr[i + 8] = (h16)(x2 * c + x1 * s); };
            if (row < MREAL) { rope2(QBf + (size_t)row * 512); rope2(P + (size_t)row * NP2 + C_IQ); rope2(KBf + ((size_t)(row >> 13) * KVROWS + 64 + (row & (S - 1))) * 512); }
            else { rope2(KBf + (size_t)(row - MREAL) * 512); rope2(KBf + ((size_t)KVROWS + (row - MREAL)) * 512); }
        }
        const float v = E[(size_t)row * 128 + lane];
        const float mean = wave_sum(v) * (1.f / 64.f); const float d = v - mean;
        const float var = wave_sum(d * d) * (1.f / 64.f);
        float y = d * rsqrtf(var + 1e-6f) * p.idx_g[lane] + p.idx_b[lane];
        const float other = __shfl_xor(y, 8);
        if (lane < 16) {
            const int i = lane & 7; const float c = ROPE[(t * 8 + i) * 2], s = ROPE[(t * 8 + i) * 2 + 1];
            y = lane < 8 ? (y * c - other * s) : (y * c + other * s);
        }
        KI[(size_t)row * 64 + lane] = (h16)y;
    }
}

constexpr int NMI = 130;
constexpr int QB = 32, CAP = 128;
constexpr int IX_KB = 0, IX_HIST = 32768, IX_MASK = 32768  , IX_CAND = 98304, IX_CANDI = 114688, IX_ST = 131072, IX_FLAG = 132096;
constexpr int HROW = 512;
typedef float f32x16 __attribute__((ext_vector_type(16)));
#define ST_LO 0
#define ST_HI 1
#define ST_NEED 2
#define ST_CNT 3
#define ST_FLAGS 4
#define ST_NCAND 5
#define ST_SH 6
#define ST_RUN 7
#define FL_ACTIVE 1u
#define FL_TIE 2u

__device__ __forceinline__ float relu_(float x) { return __builtin_amdgcn_fmed3f(x, 0.f, __builtin_inff()); }
__device__ __forceinline__ unsigned skey_c(float x) { const unsigned u = __float_as_uint(x); return u ^ (((unsigned)((int)u >> 31)) | 0x80000000u); }
__device__ __forceinline__ int custom_bin(unsigned key) {
    const int k14 = (int)(key >> 18); const int a = k14 - 11488, bb = k14 - 3873;
    const int lowpart = min(max(bb, 0), 511);
    return max(min(a, 1023), lowpart);
}

__device__ __forceinline__ void glds16(const void* gsrc, unsigned lds_dst) { unsigned keep;
    asm volatile("s_mov_b32 %0, m0\n\ts_mov_b32 m0, %2\n\ts_nop 0\n\tglobal_load_lds_dwordx4 %1, off\n\ts_mov_b32 m0, %0" : "=&s"(keep) : "v"(gsrc), "s"(lds_dst) : "memory"); }

struct IdxLane { unsigned loA, hiA, loB, hiB, flA, flB, shA, shB, needA, needB, runA, runB; int qA, qB, rA, rB; bool anyTie; };

template <int MODE, bool DIAG>
__device__ __forceinline__ void idx_tile(char* lds, const char* kb, int t, const h16x8 (&afrag)[4], const float (&wreg)[16], IdxLane& L) {
    unsigned* HIST = (unsigned*)(lds + IX_HIST); unsigned* MASK = (unsigned*)(lds + IX_MASK); unsigned* CAND = (unsigned*)(lds + IX_CAND); unsigned* CANDI = (unsigned*)(lds + IX_CANDI); unsigned* ST = (unsigned*)(lds + IX_ST);
    const int lane = threadIdx.x & 63, w = threadIdx.x >> 6, hl = lane >> 5, cc = lane & 31;
    h16x8 bf[2][4];
#pragma unroll
    for (int kh = 0; kh < 2; ++kh)
#pragma unroll
        for (int ks = 0; ks < 4; ++ks) { const int ki = 32 * kh + cc; bf[kh][ks] = *(const h16x8*)(kb + ki * 128 + (((2 * ks + hl) ^ ((ki >> 1) & 7)) << 4)); }
    f32x16 accs[2];
    accs[0] = (f32x16){0.f, 0.f, 0.f, 0.f, 0.f, 0.f, 0.f, 0.f, 0.f, 0.f, 0.f, 0.f, 0.f, 0.f, 0.f, 0.f}; accs[1] = accs[0];
#pragma unroll
    for (int ks = 0; ks < 4; ++ks) { accs[0] = __builtin_amdgcn_mfma_f32_32x32x16_f16(afrag[ks], bf[0][ks], accs[0], 0, 0, 0); accs[1] = __builtin_amdgcn_mfma_f32_32x32x16_f16(afrag[ks], bf[1][ks], accs[1], 0, 0, 0); }
#pragma unroll
    for (int kh = 0; kh < 2; ++kh) {
        const f32x16 acc = accs[kh];
        float pq[4];
#pragma unroll
        for (int q4 = 0; q4 < 4; ++q4)
            pq[q4] = __builtin_fmaf(wreg[4 * q4 + 3], relu_(acc[4 * q4 + 3]), __builtin_fmaf(wreg[4 * q4 + 2], relu_(acc[4 * q4 + 2]), __builtin_fmaf(wreg[4 * q4 + 1], relu_(acc[4 * q4 + 1]), __builtin_fmaf(wreg[4 * q4], relu_(acc[4 * q4]), 0.f))));
        const auto r01 = __builtin_amdgcn_permlane32_swap(__float_as_uint(pq[0]), __float_as_uint(pq[1]), false, false);
        const auto r23 = __builtin_amdgcn_permlane32_swap(__float_as_uint(pq[2]), __float_as_uint(pq[3]), false, false);
        const float sA = __uint_as_float(r01[0]) + __uint_as_float(r01[1]);
        const float sB = __uint_as_float(r23[0]) + __uint_as_float(r23[1]);
        const int sidx = 64 * t + 32 * kh + cc;
        const bool vA = DIAG ? (sidx <= L.rA) : true, vB = DIAG ? (sidx <= L.rB) : true;
        const unsigned kA = skey_c(sA), kB = skey_c(sB);
        if (MODE == 0) {
            const int bA = custom_bin(kA), bB = custom_bin(kB);
            if (vA) atomicAdd(&HIST[L.qA * HROW + (bA >> 1)], 1u << (16 * (bA & 1)));
            if (vB) atomicAdd(&HIST[L.qB * HROW + (bB >> 1)], 1u << (16 * (bB & 1)));
        } else if (MODE == 1) {
            if (vA && (L.flA & FL_ACTIVE) && (kA - L.loA) <= (L.hiA - L.loA)) { const unsigned sb = (kA - L.loA) >> L.shA; atomicAdd(&HIST[L.qA * HROW + (sb >> 1)], 1u << (16 * (sb & 1))); }
            if (vB && (L.flB & FL_ACTIVE) && (kB - L.loB) <= (L.hiB - L.loB)) { const unsigned sb = (kB - L.loB) >> L.shB; atomicAdd(&HIST[L.qB * HROW + (sb >> 1)], 1u << (16 * (sb & 1))); }
        } else {
            bool selA = vA && kA > L.hiA, selB = vB && kB > L.hiB;
            const bool inA = vA && (kA - L.loA) <= (L.hiA - L.loA), inB = vB && (kB - L.loB) <= (L.hiB - L.loB);
            if (L.anyTie) {
                const unsigned long long eA = __ballot(inA && (L.flA & FL_TIE)), eB = __ballot(inB && (L.flB & FL_TIE));
                const unsigned pA = hl ? (unsigned)(eA >> 32) : (unsigned)eA, pB = hl ? (unsigned)(eB >> 32) : (unsigned)eB;
                const unsigned below = (1u << cc) - 1u;
                if (inA && (L.flA & FL_TIE) && L.runA + __popc(pA & below) < L.needA) selA = true;
                if (inB && (L.flB & FL_TIE) && L.runB + __popc(pB & below) < L.needB) selB = true;
                L.runA += __popc(pA); L.runB += __popc(pB);
            }
            if (inA && !(L.flA & FL_TIE)) { const unsigned pos = atomicAdd(&ST[L.qA * 8 + ST_NCAND], 1u); if (pos < CAP) { CAND[L.qA * CAP + pos] = kA; CANDI[L.qA * CAP + pos] = (unsigned)sidx; } }
            if (inB && !(L.flB & FL_TIE)) { const unsigned pos = atomicAdd(&ST[L.qB * 8 + ST_NCAND], 1u); if (pos < CAP) { CAND[L.qB * CAP + pos] = kB; CANDI[L.qB * CAP + pos] = (unsigned)sidx; } }
            const unsigned long long mA = __ballot(selA), mB = __ballot(selB);
            const unsigned val = lane == 0 ? (unsigned)mA : (lane == 1 ? (unsigned)(mA >> 32) : (lane == 2 ? (unsigned)mB : (unsigned)(mB >> 32)));
            if (lane < 4) MASK[(4 * w + lane) * 260 + (t + 1) * 2 + kh] = val;
        }
    }
}

template <int MODE>
__device__ __forceinline__ void idx_pass(const Params& p, int b, int u, char* lds, const h16x8 (&afrag)[4], const float (&wreg)[16]) {
    const h16* KI = (const h16*)(p.ws + WS_KI) + (size_t)b * S * 64;
    unsigned* ST = (unsigned*)(lds + IX_ST);
    const int tid = threadIdx.x, lane = tid & 63, hl = lane >> 5; const int w = __builtin_amdgcn_readfirstlane(tid >> 6);
    const int tq = u >> 1;
    IdxLane L{};
    L.qA = 4 * w + hl; L.qB = 4 * w + 2 + hl; L.rA = 32 * u + L.qA; L.rB = 32 * u + L.qB;
    if (MODE != 0) { L.loA = ST[L.qA * 8 + ST_LO]; L.hiA = ST[L.qA * 8 + ST_HI]; L.flA = ST[L.qA * 8 + ST_FLAGS]; L.shA = ST[L.qA * 8 + ST_SH]; L.needA = ST[L.qA * 8 + ST_NEED];
                     L.loB = ST[L.qB * 8 + ST_LO]; L.hiB = ST[L.qB * 8 + ST_HI]; L.flB = ST[L.qB * 8 + ST_FLAGS]; L.shB = ST[L.qB * 8 + ST_SH]; L.needB = ST[L.qB * 8 + ST_NEED]; }
    L.anyTie = (MODE == 2) && (__ballot((L.flA | L.flB) & FL_TIE) != 0ull);
    const int si = 8 * w + (lane >> 3);
    const h16* ksrc = KI + (size_t)si * 64 + (((lane & 7) ^ ((si >> 1) & 7)) << 3);
    const unsigned lds0 = (unsigned)(uintptr_t)lds + IX_KB + (unsigned)w * 1024u;
#define IDX_DMA(tt) glds16(ksrc + (size_t)(tt) * 64 * 64, (unsigned)__builtin_amdgcn_readfirstlane(lds0 + (unsigned)((tt) & 3) * 8192u))
#define IDX_WAIT(N) asm volatile("s_waitcnt vmcnt(" #N ") lgkmcnt(0)\n\ts_barrier" ::: "memory")
    IDX_DMA(0); if (tq >= 1) IDX_DMA(1); if (tq >= 2) IDX_DMA(2);
    if (tq >= 2) IDX_WAIT(2); else if (tq == 1) IDX_WAIT(1); else IDX_WAIT(0);
    for (int t = 0; t < tq; ++t) {
        if (t + 3 <= tq) IDX_DMA(t + 3);
        idx_tile<MODE, false>(lds, lds + IX_KB + (t & 3) * 8192, t, afrag, wreg, L);
        if (t + 3 <= tq) IDX_WAIT(2); else if (t + 2 <= tq) IDX_WAIT(1); else IDX_WAIT(0);
    }
    idx_tile<MODE, true>(lds, lds + IX_KB + (tq & 3) * 8192, tq, afrag, wreg, L);
    IDX_WAIT(0);
#undef IDX_DMA
#undef IDX_WAIT
}

template <int MODE>
__device__ __forceinline__ void idx_scan(char* lds) {
    unsigned* HIST = (unsigned*)(lds + IX_HIST); unsigned* ST = (unsigned*)(lds + IX_ST); unsigned* FLAG = (unsigned*)(lds + IX_FLAG);
    const int lane = threadIdx.x & 63, w = threadIdx.x >> 6;
    for (int q4 = 0; q4 < 4; ++q4) {
        const int q = 4 * w + q4;
        const unsigned fl = ST[q * 8 + ST_FLAGS];
        if (MODE == 1 && !(fl & FL_ACTIVE)) continue;
        const unsigned need = ST[q * 8 + ST_NEED], lo = ST[q * 8 + ST_LO], hi = ST[q * 8 + ST_HI], sh = ST[q * 8 + ST_SH];
        unsigned c[16];
#pragma unroll
        for (int j = 0; j < 8; ++j) { const unsigned d = HIST[q * HROW + 8 * lane + j]; c[2 * j] = d & 0xFFFFu; c[2 * j + 1] = d >> 16; HIST[q * HROW + 8 * lane + j] = 0u; }
        unsigned tl = 0;
#pragma unroll
        for (int k = 0; k < 16; ++k) tl += c[k];
        unsigned Ssum = tl;
#pragma unroll
        for (int o = 1; o < 64; o <<= 1) { const unsigned v = __shfl_down(Ssum, o); if (lane + o < 64) Ssum += v; }
        const unsigned above = Ssum - tl;
        if (above < need && need <= Ssum) {
            unsigned cum = above; int bstar = 16 * lane; unsigned cnt = 0; bool found = false;
#pragma unroll
            for (int k = 15; k >= 0; --k) { if (!found) { if (cum + c[k] >= need) { bstar = 16 * lane + k; cnt = c[k]; found = true; } else cum += c[k]; } }
            const unsigned nneed = need - cum;
            unsigned nlo, nhi;
            if (MODE == 0) {
                if (bstar >= 512) { nlo = (unsigned)(bstar + 11488) << 18; nhi = bstar == 1023 ? 0xFFFFFFFFu : (nlo | 0x3FFFFu); }
                else if (bstar == 511) { nlo = 4384u << 18; nhi = (11999u << 18) | 0x3FFFFu; }
                else { nhi = ((unsigned)(bstar + 3873) << 18) | 0x3FFFFu; nlo = bstar == 0 ? 0u : ((unsigned)(bstar + 3873) << 18); }
            } else {
                nlo = lo + ((unsigned)bstar << sh); const unsigned top = nlo + ((1u << sh) - 1u); nhi = top < hi ? top : hi; if (top < nlo) nhi = hi;
            }
            const unsigned range = nhi - nlo;
            unsigned nfl = 0, nsh = 0;
            if (nlo < nhi && cnt > CAP) { nfl = FL_ACTIVE; const int bits = 32 - __clz(range); nsh = bits > 10 ? (unsigned)(bits - 10) : 0u; *FLAG = 1u; }
            else if (cnt > CAP) nfl = FL_TIE;
            ST[q * 8 + ST_LO] = nlo; ST[q * 8 + ST_HI] = nhi; ST[q * 8 + ST_NEED] = nneed; ST[q * 8 + ST_CNT] = cnt; ST[q * 8 + ST_FLAGS] = nfl; ST[q * 8 + ST_SH] = nsh;
        }
    }
}

__device__ __forceinline__ void idx_unit(const Params& p, int b, int u, char* lds, int dry = 0) {
    const h16* P = (const h16*)(p.ws + WS_P); const float* E = (const float*)(p.ws + WS_E);
    unsigned long long* Mk = (unsigned long long*)p.out + (dry ? (size_t)(36u << 20) / 8 : 0);
    unsigned* HIST = (unsigned*)(lds + IX_HIST); unsigned* MASK = (unsigned*)(lds + IX_MASK); unsigned* CAND = (unsigned*)(lds + IX_CAND); unsigned* ST = (unsigned*)(lds + IX_ST); unsigned* FLAG = (unsigned*)(lds + IX_FLAG);
    const int tid = threadIdx.x, lane = tid & 63, w = tid >> 6, hl = lane >> 5, cc = lane & 31;
    const int qb = u >> 3, nwords = 4 * qb + 6;
    if (32 * u + 31 < 256) {
        for (int idx = tid; idx < 32 * nwords; idx += NT) {
            const int q = idx & 31, i = idx >> 5, r = 32 * u + q;
            unsigned long long wv;
            if (i == 0) wv = 0xFFFFull; else { const int nv = r - 64 * (i - 1) + 1; wv = nv <= 0 ? 0ull : (nv >= 64 ? ~0ull : ((1ull << nv) - 1ull)); }
            Mk[((size_t)b * NMI + i) * S + r] = wv;
        }
        return;
    }
    for (int i = tid; i < 32 * HROW; i += NT) HIST[i] = 0u;
    if (tid < 32) { ST[tid * 8 + ST_LO] = 0u; ST[tid * 8 + ST_HI] = 0xFFFFFFFFu; ST[tid * 8 + ST_NEED] = 256u; ST[tid * 8 + ST_CNT] = 0u; ST[tid * 8 + ST_FLAGS] = 0u; ST[tid * 8 + ST_NCAND] = 0u; ST[tid * 8 + ST_SH] = 0u; ST[tid * 8 + ST_RUN] = 0u; }
    if (tid == 0) *FLAG = 0u;
    h16x8 afrag[4]; float wreg[16];
    {
        const int qq = cc >> 3, head = cc & 7;
        const size_t row = (size_t)b * S + 32 * u + 4 * w + qq;
#pragma unroll
        for (int ks = 0; ks < 4; ++ks) afrag[ks] = *(const h16x8*)(P + row * NP2 + C_IQ + head * 64 + 16 * ks + 8 * hl);
#pragma unroll
        for (int q4 = 0; q4 < 4; ++q4) { const f32x4 wv = *(const f32x4*)(E + ((size_t)b * S + 32 * u + 4 * w + q4) * 128 + 64 + 4 * hl); wreg[4 * q4] = wv.x; wreg[4 * q4 + 1] = wv.y; wreg[4 * q4 + 2] = wv.z; wreg[4 * q4 + 3] = wv.w; }
    }
#pragma unroll
    for (int ks = 0; ks < 4; ++ks) asm volatile("" : "+v"(afrag[ks]));
#pragma unroll
    for (int i = 0; i < 16; ++i) asm volatile("" : "+v"(wreg[i]));
    __syncthreads();
#if PROBE == 9
    idx_pass<0>(p, b, u, lds, afrag, wreg);
    for (int i = tid; i < 32 * HROW; i += NT) HIST[i] = 0u;
    __syncthreads();
#endif
    if (!dry) idx_pass<0>(p, b, u, lds, afrag, wreg);
    idx_scan<0>(lds);
    __syncthreads();
    for (int iter = 0; iter < 8; ++iter) {
        if (*FLAG == 0u || PROBE == 14) break;
        __syncthreads();
        if (tid == 0) *FLAG = 0u;
        __syncthreads();
        if (!dry) idx_pass<1>(p, b, u, lds, afrag, wreg);
        idx_scan<1>(lds);
        __syncthreads();
    }
    for (int i = tid; i < 32 * 260; i += NT) MASK[i] = 0u;
    __syncthreads();
    if (!dry) idx_pass<2>(p, b, u, lds, afrag, wreg);
#if PROBE == 8
    if (tid < 32) ST[tid * 8 + ST_NCAND] = 0u;
    __syncthreads();
    idx_pass<2>(p, b, u, lds, afrag, wreg);
#endif
    for (int rrep = 0; rrep < (PROBE == 13 ? 2 : 1); ++rrep)
    for (int q4 = 0; q4 < 4; ++q4) {
        const int q = 4 * w + q4;
        const unsigned fl = ST[q * 8 + ST_FLAGS]; if (fl & FL_TIE) continue;
        unsigned nc = ST[q * 8 + ST_NCAND]; if (nc > CAP) nc = CAP;
        const unsigned need = ST[q * 8 + ST_NEED], lo = ST[q * 8 + ST_LO];
        (void)lo;
        const unsigned* CANDI = (const unsigned*)(lds + IX_CANDI);
        const unsigned k0 = lane < nc ? CAND[q * CAP + lane] : 0u, k1 = lane + 64 < nc ? CAND[q * CAP + lane + 64] : 0u;
        const unsigned i0 = lane < nc ? CANDI[q * CAP + lane] : 0u, i1 = lane + 64 < nc ? CANDI[q * CAP + lane + 64] : 0u;
        unsigned r0 = 0, r1 = 0;
        for (unsigned j = 0; j < nc; ++j) { const unsigned kj = CAND[q * CAP + j], ij = CANDI[q * CAP + j];
            r0 += (kj > k0 || (kj == k0 && ij < i0)) ? 1u : 0u; r1 += (kj > k1 || (kj == k1 && ij < i1)) ? 1u : 0u; }
        if (lane < nc && r0 < need) { const int s = (int)i0; atomicOr(&MASK[q * 260 + ((s >> 6) + 1) * 2 + ((s >> 5) & 1)], 1u << (s & 31)); }
        if (lane + 64 < nc && r1 < need) { const int s = (int)i1; atomicOr(&MASK[q * 260 + ((s >> 6) + 1) * 2 + ((s >> 5) & 1)], 1u << (s & 31)); }
    }
    __syncthreads();
    for (int idx = tid; idx < 32 * nwords; idx += NT) {
        const int q = idx & 31, i = idx >> 5, r = 32 * u + q;
        const unsigned long long wv = i == 0 ? 0xFFFFull : ((unsigned long long)MASK[q * 260 + 2 * i] | ((unsigned long long)MASK[q * 260 + 2 * i + 1] << 32));
        Mk[((size_t)b * NMI + i) * S + r] = wv;
    }
    __syncthreads();
}

namespace attn_body {
using bf16=_Float16;
typedef _Float16 fh16x8 __attribute__((ext_vector_type(8)));
typedef unsigned u32x2 __attribute__((ext_vector_type(2)));
#define MFH(a,b,c,x,y,z) __builtin_amdgcn_mfma_f32_32x32x16_f16(__builtin_bit_cast(fh16x8,(a)),__builtin_bit_cast(fh16x8,(b)),(c),0,0,0)
using bf16x8=__attribute__((ext_vector_type(8)))short;
using s16x4=__attribute__((ext_vector_type(4)))short;
using f32x16=__attribute__((ext_vector_type(16)))float;
using u32x4=__attribute__((ext_vector_type(4)))unsigned;
constexpr int BATCH=2,NHEAD=8,SEQ=8192,D=64,DM=NHEAD*D,KVROWS=8320,NMI_=130;
constexpr int NW=8,QBLK=32,QB=QBLK*NW,KVBLK=64,NQB=SEQ/QB;
constexpr int ATTN_PITCH=DM, ATTN_UNIT_ROWS=QB;
__device__ __forceinline__ int crow(int r,int hi){return (r&3)+8*(r>>2)+4*hi;}
#define SBAR() __builtin_amdgcn_sched_barrier(0)
__device__ __forceinline__ float msel(int m,int pos,float keepv){ const int t=__builtin_amdgcn_sbfe(m,pos,1); float d; asm("v_bfi_b32 %0, %1, %2, %3":"=v"(d):"v"(t),"v"(keepv),"s"(0xFF800000u)); return d; }
__device__ __forceinline__ void cinit(f32x16&p0,f32x16&p1,const u32x2&m,int hi,float nmh){
  const int m0=(int)(m[0]>>(4*hi)), m1=(int)(m[1]>>(4*hi));
  #pragma unroll
  for(int r=0;r<16;++r){ const int pos=(r&3)+8*(r>>2); p0[r]=msel(m0,pos,nmh); p1[r]=msel(m1,pos,nmh); }
  asm volatile("s_nop 1":"+v"(p0),"+v"(p1));
}
__device__ __forceinline__ void mload(u32x2&m,const unsigned long long*p){ asm volatile("global_load_dwordx2 %0, %1, off":"=v"(m):"v"(p):"memory"); }
constexpr int NSLOT=3, SLOTB=8192;
constexpr int LDS_K=0, LDS_V=NSLOT*SLOTB, LDS_WS=2*NSLOT*SLOTB, LDS_OST=LDS_WS+NW*64*4, LDS_BYTES=LDS_OST+NW*4096;
constexpr float C2=0.125f*1.4426950408889634f;
__device__ __forceinline__ void glds16(const void*gsrc,unsigned lds_dst){unsigned keep;
  asm volatile("s_mov_b32 %0, m0\n\ts_mov_b32 m0, %2\n\ts_nop 0\n\tglobal_load_lds_dwordx4 %1, off\n\ts_mov_b32 m0, %0":"=&s"(keep):"v"(gsrc),"s"(lds_dst):"memory");}
__device__ __forceinline__ float max3f(float a,float b,float c){float r;asm("v_max3_f32 %0, %1, %2, %3":"=v"(r):"v"(a),"v"(b),"v"(c));return r;}
__device__ __forceinline__ float max2f(float a,float b){float r;asm("v_max_f32_e32 %0, %1, %2":"=v"(r):"v"(a),"v"(b));return r;}
__device__ __forceinline__ float fadd_s(float a,float b){float r;asm("v_add_f32_e32 %0, %1, %2":"=v"(r):"v"(a),"v"(b));return r;}
__device__ __forceinline__ float fsub_s(float a,float b){float r;asm("v_sub_f32_e32 %0, %1, %2":"=v"(r):"v"(a),"v"(b));return r;}
typedef float f32x2_t __attribute__((ext_vector_type(2))); typedef _Float16 bf16x2_t __attribute__((ext_vector_type(2)));
__device__ __forceinline__ unsigned cvtpk_s(float lo,float hi){f32x2_t v={lo,hi};bf16x2_t b=__builtin_convertvector(v,bf16x2_t);return __builtin_bit_cast(unsigned,b);}
#define WAIT_BAR(N) asm volatile("s_waitcnt vmcnt(" #N ") lgkmcnt(0)\n\ts_barrier":::"memory")
#define WAIT_BAR_M(N,M) do{ asm volatile("s_waitcnt vmcnt(" #N ") lgkmcnt(0)\n\ts_barrier":::"memory"); __builtin_amdgcn_sched_barrier(0); asm volatile("":"+v"(M)); }while(0)
#define WAIT_BAR_M2(N,M,M2) do{ asm volatile("s_waitcnt vmcnt(" #N ") lgkmcnt(0)\n\ts_barrier":::"memory"); __builtin_amdgcn_sched_barrier(0); asm volatile("":"+v"(M),"+v"(M2)); }while(0)

__device__ __forceinline__ void qkt(f32x16&p0,f32x16&p1,const char*Kslot,const bf16x8*qr,int r32,int hi){
  const char*kb=Kslot+hi*1024+r32*16;
  #pragma unroll
  for(int d0=0;d0<4;++d0){
    const bf16x8 b0=*reinterpret_cast<const bf16x8*>(kb+d0*2048);
    const bf16x8 b1=*reinterpret_cast<const bf16x8*>(kb+d0*2048+512);
    p0=MFH(b0,qr[d0],p0,0,0,0);p1=MFH(b1,qr[d0],p1,0,0,0);}
}
typedef __attribute__((address_space(3))) const char* lds_cptr;
typedef short v4i16_t __attribute__((ext_vector_type(4)));
__device__ __forceinline__ void kload8(bf16x8*kf,lds_cptr kp){
  kf[0]=*(const __attribute__((address_space(3))) bf16x8*)(kp);      kf[1]=*(const __attribute__((address_space(3))) bf16x8*)(kp+512);
  kf[2]=*(const __attribute__((address_space(3))) bf16x8*)(kp+2048); kf[3]=*(const __attribute__((address_space(3))) bf16x8*)(kp+2560);
  kf[4]=*(const __attribute__((address_space(3))) bf16x8*)(kp+4096); kf[5]=*(const __attribute__((address_space(3))) bf16x8*)(kp+4608);
  kf[6]=*(const __attribute__((address_space(3))) bf16x8*)(kp+6144); kf[7]=*(const __attribute__((address_space(3))) bf16x8*)(kp+6656);
}
__device__ __forceinline__ void kload2(bf16x8*kf,lds_cptr kp,int j){ kf[2*j]=*(const __attribute__((address_space(3))) bf16x8*)(kp+j*2048); kf[2*j+1]=*(const __attribute__((address_space(3))) bf16x8*)(kp+j*2048+512); }
__device__ __forceinline__ s16x4 vtr(lds_cptr p){ return __builtin_bit_cast(s16x4,__builtin_amdgcn_ds_read_tr16_b64_v4i16((__attribute__((address_space(3))) v4i16_t*)p)); }
__device__ __forceinline__ float rowmax(const f32x16&p0,const f32x16&p1){
  float a=max3f(p0[0],p0[1],p1[0]),b=max3f(p0[2],p0[3],p1[1]);a=max3f(a,p1[2],p1[3]);
  #pragma unroll
  for(int r=4;r<16;r+=4){a=max3f(a,p0[r],p0[r+1]);b=max3f(b,p0[r+2],p0[r+3]);a=max3f(a,p1[r],p1[r+1]);b=max3f(b,p1[r+2],p1[r+3]);}
  const float m=max2f(a,b);
  auto rr=__builtin_amdgcn_permlane32_swap(__float_as_uint(m),__float_as_uint(m),false,false);
  return max2f(__uint_as_float(rr[0]),__uint_as_float(rr[1]));
}
__device__ __forceinline__ void pv(f32x16*o,int vb,bf16x8 pa0,bf16x8 pa1,bf16x8 pa2,bf16x8 pa3){
  #pragma unroll
  for(int d0=0;d0<2;++d0){s16x4 lo[4],hi[4];
    #pragma unroll
    for(int ks=0;ks<4;++ks){
      asm volatile("ds_read_b64_tr_b16 %0,%1 offset:%c2":"=&v"(lo[ks]):"v"(vb),"i"(d0*4096+ks*1024):"memory");
      asm volatile("ds_read_b64_tr_b16 %0,%1 offset:%c2":"=&v"(hi[ks]):"v"(vb),"i"(d0*4096+ks*1024+512):"memory");}
    asm volatile("s_waitcnt lgkmcnt(0)":::"memory");SBAR();
    #define PK(k) (bf16x8){lo[k][0],lo[k][1],lo[k][2],lo[k][3],hi[k][0],hi[k][1],hi[k][2],hi[k][3]}
    o[d0]=MFH(pa0,PK(0),o[d0],0,0,0);
    o[d0]=MFH(pa1,PK(1),o[d0],0,0,0);
    o[d0]=MFH(pa2,PK(2),o[d0],0,0,0);
    o[d0]=MFH(pa3,PK(3),o[d0],0,0,0);
    #undef PK
  }
}

#ifndef ATTN_STORE16
#define ATTN_STORE16(p,v) (*(u32x4*)(p)=(v))
#endif
template<int THRL> __device__ __forceinline__ void attn_unit(int b,int h,int qb,const bf16*Q,const bf16*__restrict__ K,const bf16*__restrict__ V,bf16*O,const unsigned long long*__restrict__ Mk,char*shm){
  const int tid=threadIdx.x,lane=tid&63,r32=lane&31,hi=lane>>5; const int wid=__builtin_amdgcn_readfirstlane(tid>>6);
  const long rowbase=(long)b*SEQ, kvbase=(long)b*KVROWS; const int q0=qb*QB;
  const bf16*Qw=Q+(rowbase+q0+wid*QBLK)*DM+h*D;
  const bf16*Kh=K+kvbase*DM+h*D,*Vh=V+kvbase*DM+h*D;
  const unsigned long long*mrow=Mk+(long)b*NMI_*SEQ+(q0+wid*QBLK+r32);
  u32x2 mA,mB; mload(mA,mrow); mload(mB,mrow+SEQ);
  const unsigned lds0=(unsigned)(uintptr_t)shm;
  float*wsf=(float*)(shm+LDS_WS)+wid*64;
  const bf16*ksrc=Kh+(long)lane*DM+wid*8;
  const bf16*vsrc=Vh+(long)(16*(wid&3)+(lane>>2))*DM+(wid>>2)*32+(lane&3)*8;
  const unsigned kdst=lds0+LDS_K+wid*1024, vdst=lds0+LDS_V+wid*1024;
  #define DMA_K(t,slot) glds16(ksrc+(long)(t)*KVBLK*DM,(unsigned)__builtin_amdgcn_readfirstlane(kdst+(slot)))
  #define DMA_V(t,slot) glds16(vsrc+(long)(t)*KVBLK*DM,(unsigned)__builtin_amdgcn_readfirstlane(vdst+(slot)))
  const int vb0=(int)(lds0+LDS_V)+((lane>>4)&1)*32+(lane&3)*8+(4*hi+((lane&15)>>2))*64;
  const char*Kbase=shm+LDS_K; bf16x8 kf[8];
  const lds_cptr shm3=(lds_cptr)shm; const lds_cptr kp0=shm3+LDS_K+hi*1024+r32*16; const lds_cptr vp0=shm3+LDS_V+((lane>>4)&1)*32+(lane&3)*8+(4*hi+((lane&15)>>2))*64;
  const int NT=(q0+QB)/KVBLK+2;
  DMA_K(0,0);DMA_V(0,0);DMA_K(1,SLOTB);
  bf16x8 qr[4];
  #pragma unroll
  for(int d0=0;d0<4;++d0)qr[d0]=*reinterpret_cast<const bf16x8*>(&Qw[(long)r32*DM+d0*16+hi*8]);
  float mhat=0.f,l_reg=0.f;f32x16 o[2];o[0]=f32x16{};o[1]=f32x16{};
  const int qrel=wid*QBLK+r32;
  bool resc=false;
  #define START(P0,P1) do{ const float rm=rowmax(P0,P1); resc=false; \
    { const float dl=rm; mhat=fadd_s(mhat,dl); \
      _Pragma("unroll") for(int r=0;r<16;++r){P0[r]=fsub_s(P0[r],dl);P1[r]=fsub_s(P1[r],dl);} \
      } \
    _Pragma("unroll") for(int r=0;r<16;++r)P0[r]=__builtin_amdgcn_exp2f(P0[r]); }while(0)
  #define RESC() do{ if(resc){ asm volatile("s_waitcnt lgkmcnt(0)":::"memory"); \
      _Pragma("unroll") for(int d_=0;d_<2;++d_) _Pragma("unroll") for(int r=0;r<16;++r)o[d_][r]*=wsf[crow(r,hi)]; } }while(0)
  f32x16 pA0,pA1,pB0,pB1;
  int sl_prev=0,sl_cur=0,sl_next=SLOTB;
  #define ROT() do{sl_prev=sl_cur;sl_cur=sl_next;sl_next=(sl_next==(NSLOT-1)*SLOTB)?0:sl_next+SLOTB;}while(0)
  DMA_K(2,2*SLOTB);
  WAIT_BAR_M2(3,mA,mB);
  cinit(pA0,pA1,mA,hi,0.f);qkt(pA0,pA1,Kbase,qr,r32,hi);asm volatile("s_nop 15\n\ts_nop 7":"+v"(pA0),"+v"(pA1));
  START(pA0,pA1);
  _Pragma("unroll") for(int r=0;r<16;++r)pA1[r]=__builtin_amdgcn_exp2f(pA1[r]);
  WAIT_BAR(0);
  DMA_K(3,0);DMA_V(1,SLOTB);
  ROT();
  kload8(kf,kp0+sl_cur);
  WAIT_BAR(2);
  s16x4 vlo[8],vhi[8]; u32x4 pw0,pw1,pw2,pw3;
  #define PKW(P,B) cvtpk_s(P[B],P[B+1])
  #define PAF(k) __builtin_bit_cast(bf16x8,pw##k)
  #define VFR(i) (bf16x8){vlo[i][0],vlo[i][1],vlo[i][2],vlo[i][3],vhi[i][0],vhi[i][1],vhi[i][2],vhi[i][3]}
  #define PIN(x) asm volatile("":"+v"(x))
  #define MX3(a,b,c) __builtin_fmaxf(__builtin_fmaxf((a),(b)),(c))
  #define GAPA(MF,A0,A1,A2,A3,W0,W1,PW) do{ MF; sacc+=A0; sacc+=A1; sacc+=A2; sacc+=A3; PIN(sacc); W0; W1; PIN(PW); SBAR(); }while(0)
  #define EX(v) __builtin_amdgcn_exp2f(v)
  #define GAPB(MF,X,B) do{ MF; X[B]=EX(X[B]); X[B+1]=EX(X[B+1]); X[B+2]=EX(X[B+2]); X[B+3]=EX(X[B+3]); PIN(X); SBAR(); }while(0)
  #define VRD(i) do{ vlo[i]=vtr(vp_+(((i)>>2)*4096+((i)&3)*1024)); vhi[i]=vtr(vp_+(((i)>>2)*4096+((i)&3)*1024+512)); }while(0)
  #define KRD(G,j) do{ if(G){ kload2(kf,kp0+sl_next,j); SBAR(); } }while(0)
  #define STEP(C0,C1,P0,P1,t,GK,GV,GL,MC,MN,GM) do{ SBAR(); \
    if(GM){mload(MN,mrow+(long)((t)+1)*SEQ);} \
    cinit(C0,C1,MC,hi,-mhat); SBAR(); \
    const lds_cptr vp_=vp0+sl_prev; \
    VRD(0); SBAR(); float sacc=(P0[0]+P0[1]); \
    GAPA(C0=MFH(kf[0],qr[0],C0,0,0,0), P0[2],P0[3],P0[4],P0[5],     pw0[0]=PKW(P0,0), pw0[1]=PKW(P0,2), pw0); \
    VRD(4); SBAR(); GAPA(C1=MFH(kf[1],qr[0],C1,0,0,0), P0[6],P0[7],P0[8],P0[9],     pw0[2]=PKW(P0,4), pw0[3]=PKW(P0,6), pw0); \
    VRD(1); SBAR(); GAPA(C0=MFH(kf[2],qr[1],C0,0,0,0),   P0[10],P0[11],P0[12],P0[13], pw1[0]=PKW(P0,8), pw1[1]=PKW(P0,10), pw1); \
    VRD(5); SBAR(); GAPA(C1=MFH(kf[3],qr[1],C1,0,0,0),   P0[14],P0[15],P1[0],P1[1],   pw1[2]=PKW(P0,12),pw1[3]=PKW(P0,14), pw1); \
    VRD(2); SBAR(); GAPA(C0=MFH(kf[4],qr[2],C0,0,0,0),   P1[2],P1[3],P1[4],P1[5],     pw2[0]=PKW(P1,0), pw2[1]=PKW(P1,2), pw2); \
    VRD(6); SBAR(); GAPA(C1=MFH(kf[5],qr[2],C1,0,0,0),   P1[6],P1[7],P1[8],P1[9],     pw2[2]=PKW(P1,4), pw2[3]=PKW(P1,6), pw2); \
    VRD(3); SBAR(); GAPA(C0=MFH(kf[6],qr[3],C0,0,0,0),   P1[10],P1[11],P1[12],P1[13], pw3[0]=PKW(P1,8), pw3[1]=PKW(P1,10), pw3); \
    VRD(7); SBAR(); GAPA(C1=MFH(kf[7],qr[3],C1,0,0,0),   P1[14],P1[15],0.f,0.f,       pw3[2]=PKW(P1,12),pw3[3]=PKW(P1,14), pw3); \
    l_reg+=sacc; \
    if(GK){DMA_K((t)+3,sl_cur);} if(GV){DMA_V((t)+1,sl_next);} \
    { float a=MX3(C0[0],C0[1],C1[0]),b=MX3(C0[2],C0[3],C1[1]); a=MX3(a,C1[2],C1[3]); \
      _Pragma("unroll") for(int r=4;r<16;r+=4){a=MX3(a,C0[r],C0[r+1]);b=MX3(b,C0[r+2],C0[r+3]);a=MX3(a,C1[r],C1[r+1]);b=MX3(b,C1[r+2],C1[r+3]);} \
      float rm=__builtin_fmaxf(a,b); { auto rr=__builtin_amdgcn_permlane32_swap(__float_as_uint(rm),__float_as_uint(rm),false,false); rm=__builtin_fmaxf(__uint_as_float(rr[0]),__uint_as_float(rr[1])); } \
      resc=false; \
      if(__builtin_expect(__any(rm>(float)THRL),0)){ const float dl=__builtin_fmaxf(rm,0.f); mhat+=dl; \
        _Pragma("unroll") for(int r=0;r<16;++r){C0[r]-=dl;C1[r]-=dl;} \
        const float f=__builtin_amdgcn_exp2f(-dl); l_reg*=f; if(hi==0)wsf[r32]=f; resc=true; } } \
    SBAR(); \
    GAPB(o[0]=MFH(PAF(0),VFR(0),o[0],0,0,0), C0,0); \
    GAPB(o[1]=MFH(PAF(0),VFR(4),o[1],0,0,0), C0,4); \
    KRD(GL,0); GAPB(o[0]=MFH(PAF(1),VFR(1),o[0],0,0,0), C0,8); \
    KRD(GL,1); GAPB(o[1]=MFH(PAF(1),VFR(5),o[1],0,0,0), C0,12); \
    KRD(GL,2); GAPB(o[0]=MFH(PAF(2),VFR(2),o[0],0,0,0), C1,0); \
    KRD(GL,3); GAPB(o[1]=MFH(PAF(2),VFR(6),o[1],0,0,0), C1,4); \
    GAPB(o[0]=MFH(PAF(3),VFR(3),o[0],0,0,0), C1,8); \
    GAPB(o[1]=MFH(PAF(3),VFR(7),o[1],0,0,0), C1,12); \
    }while(0)
  int t=1;
  for(;t+5<NT;t+=2){
    STEP(pB0,pB1,pA0,pA1,t,true,true,true,mB,mA,true);     WAIT_BAR_M(2,mA); RESC(); ROT();
    STEP(pA0,pA1,pB0,pB1,t+1,true,true,true,mA,mB,true);   WAIT_BAR_M(2,mB); RESC(); ROT();
  }
  #define ENDW(tt,M) do{ if((tt)+3<NT){WAIT_BAR_M(2,M);} else if((tt)+2<NT){WAIT_BAR_M(1,M);} else {WAIT_BAR_M(0,M);} }while(0)
  for(;t+1<NT;t+=2){
    STEP(pB0,pB1,pA0,pA1,t,(t+3<NT),(t+1<NT),(t+1<NT),mB,mA,(t+1<NT));       ENDW(t,mA);   RESC(); ROT();
    STEP(pA0,pA1,pB0,pB1,t+1,(t+4<NT),(t+2<NT),(t+2<NT),mA,mB,(t+2<NT));     ENDW(t+1,mB); RESC(); ROT();
  }
  STEP(pB0,pB1,pA0,pA1,NT-1,false,false,false,mB,mA,false); RESC();
  { float sacc=pB0[0]+pB0[1]; _Pragma("unroll") for(int r=2;r<16;++r)sacc+=pB0[r]; _Pragma("unroll") for(int r=0;r<16;++r)sacc+=pB1[r]; l_reg+=sacc;
    pw0=(u32x4){PKW(pB0,0),PKW(pB0,2),PKW(pB0,4),PKW(pB0,6)};pw1=(u32x4){PKW(pB0,8),PKW(pB0,10),PKW(pB0,12),PKW(pB0,14)};pw2=(u32x4){PKW(pB1,0),PKW(pB1,2),PKW(pB1,4),PKW(pB1,6)};pw3=(u32x4){PKW(pB1,8),PKW(pB1,10),PKW(pB1,12),PKW(pB1,14)};
    SBAR(); pv(o,vb0+sl_cur,PAF(0),PAF(1),PAF(2),PAF(3)); }
  #undef PKW
  #undef PAF
  #undef VFR
  #undef PIN
  #undef MX3
  #undef GAPA
  #undef GAPB
  #undef EX
  #undef VRD
  #undef KRD
  #undef STEP
  #undef ENDW
  {auto rr=__builtin_amdgcn_permlane32_swap(__float_as_uint(l_reg),__float_as_uint(l_reg),false,false);l_reg=__uint_as_float(rr[0])+__uint_as_float(rr[1]);}
  if(hi==0)wsf[32+r32]=l_reg;asm volatile("s_waitcnt lgkmcnt(0)":::"memory");
  float rli[16];
  #pragma unroll
  for(int r=0;r<16;++r)rli[r]=__builtin_amdgcn_rcpf(wsf[32+crow(r,hi)]);
  bf16*Ow=O+(rowbase+q0+wid*QBLK)*DM+h*D;
  { bf16*stg=(bf16*)(shm+LDS_OST)+wid*2048;
    #pragma unroll
    for(int r=0;r<16;++r){const int orow=crow(r,hi);
      #pragma unroll
      for(int d0=0;d0<2;++d0)stg[orow*64+d0*32+r32]=(bf16)(o[d0][r]*rli[r]);}
    asm volatile("s_waitcnt lgkmcnt(0)":::"memory");
    #pragma unroll
    for(int i=0;i<4;++i){const int row=i*8+(lane>>3),ch=lane&7; const u32x4 v=*(const u32x4*)(stg+row*64+ch*8); ATTN_STORE16(Ow+(long)row*DM+ch*8,v);} }
  asm volatile("s_waitcnt lgkmcnt(0)\n\ts_barrier":::"memory");
  #undef DMA_K
  #undef DMA_V
  #undef START
  #undef RESC
  #undef ROT
}
constexpr int ATTN_LDS_BYTES=LDS_BYTES;
struct AttnTensors { const bf16* Q; const bf16* K; const bf16* V; bf16* O; const unsigned long long* Mk; };
struct AttnUnit { int bh; int qb; };
struct StaticOrder {
  int vcu,G;
  __device__ __forceinline__ explicit StaticOrder(int grid,int block):vcu((grid%8==0)?((block%8)*(grid/8)+block/8):block),G(grid){}
  __device__ __forceinline__ bool next(int i,AttnUnit&u)const{ const int v=vcu+G*(i>>1); if(v>=256)return false; const int s=v&15; u.bh=v>>4; u.qb=(i&1)?s:31-s; return true; }
};
template<class Sched,int THRL=8> __device__ __forceinline__ void attn_phase(char*lds,const AttnTensors&T,const Sched&S){
  AttnUnit u;
  for(int i=0;S.next(i,u);++i){ attn_unit<THRL>(u.bh/NHEAD,u.bh%NHEAD,u.qb,T.Q,T.K,T.V,T.O,T.Mk,lds); }
}
#undef SBAR
#undef WAIT_BAR
#undef WAIT_BAR_M
#undef WAIT_BAR_M2
#undef MFH
}

__device__ __forceinline__ float hgrn_lb(const Params& p, int idx) { const float l0 = p.lb_logits[idx], l1 = p.lb_logits[512 + idx]; return 1.f / (1.f + __expf(l1 - l0)); }

__device__ __forceinline__ void hgrn_stepA(const Params& p, int item, char* lds) {
    float* kd = (float*)lds;
    float* kk = kd + 64 * 128;
    float* vv = kk + 64 * 128;
    const h16* P = (const h16*)(p.ws + WS_P); float* ST = (float*)(p.ws + WS_X); float* G = (float*)(p.ws + WS_G);
    const int tid = threadIdx.x;
    const int c = item % NCH, bh = item / NCH, h = bh & 3, b = bh >> 2;
    const int L = c == 0 ? 16 : 64; const size_t rowbase = c == 0 ? (size_t)MREAL : (size_t)(b * S + (c - 1) * 64);
    for (int i = tid; i < L * 128; i += NT) { const int t = i >> 7, v = i & 127; vv[t * 128 + v] = (float)P[(rowbase + t) * NP2 + C_HI + h * 128 + v]; }
    if (tid < 128) {
        const int d = tid; const float lb = hgrn_lb(p, h * 128 + d);
        float bc = 0.f;
        for (int t = 0; t < L; ++t) {
            const float hf = (float)P[(rowbase + t) * NP2 + C_HF + h * 128 + d];
            const float f = lb + (1.f - lb) * sigmoidf_(hf);
            bc += logf(f); kd[t * 128 + d] = bc; kk[t * 128 + d] = 1.f - f;
        }
        for (int t = 0; t < L; ++t) kd[t * 128 + d] = kk[t * 128 + d] * __expf(bc - kd[t * 128 + d]);
        G[(size_t)item * 128 + d] = __expf(bc);
    }
    __syncthreads();
    const int d = tid & 127, vg = tid >> 7;
    float acc[32];
#pragma unroll
    for (int j = 0; j < 32; ++j) acc[j] = 0.f;
    for (int s = 0; s < L; ++s) {
        const float kv = kd[s * 128 + d];
#pragma unroll
        for (int j = 0; j < 32; j += 4) { const f32x4 v4 = *(const f32x4*)(vv + s * 128 + vg * 32 + j); acc[j] += kv * v4.x; acc[j + 1] += kv * v4.y; acc[j + 2] += kv * v4.z; acc[j + 3] += kv * v4.w; }
    }
    float* o = ST + (size_t)item * 16384 + d * 128 + vg * 32;
#pragma unroll
    for (int j = 0; j < 32; j += 4) *(f32x4*)(o + j) = (f32x4){acc[j], acc[j + 1], acc[j + 2], acc[j + 3]};
    __syncthreads();
}

__device__ __forceinline__ void hgrn_scan(const Params& p) {
    float* ST = (float*)(p.ws + WS_X); const float* G = (const float*)(p.ws + WS_G);
    for (int idx = blockIdx.x * NT + threadIdx.x; idx < NB * 4 * 16384; idx += gridDim.x * NT) {
        const int bh = idx >> 14, e = idx & 16383, d = e >> 7;
        float Sv = 0.f;
        for (int c = 0; c < NCH; ++c) {
            const size_t off = (size_t)(bh * NCH + c) * 16384 + e;
            const float u = ST[off]; const float g = G[(size_t)(bh * NCH + c) * 128 + d];
            ST[off] = Sv; Sv = g * Sv + u;
        }
    }
}

__device__ __forceinline__ void hgrn_stepC(const Params& p, int item, char* lds) {
    float* bq = (float*)lds;
    float* qq = bq + 64 * 65;
    float* kk = qq + 64 * 65;
    float* Am = kk + 64 * 65;
    float* qe = Am + 64 * 65;
    float* vv = qe + 64 * 128;
    h16* P = (h16*)(p.ws + WS_P); const float* ST = (const float*)(p.ws + WS_X);
    const int tid = threadIdx.x;
    const int c = 1 + item % 128, bh = item / 128, h = bh & 3, b = bh >> 2;
    const size_t rowbase = (size_t)(b * S + (c - 1) * 64);
    for (int i = tid; i < 64 * 128; i += NT) { const int t = i >> 7, v = i & 127; vv[t * 128 + v] = (float)P[(rowbase + t) * NP2 + C_HI + h * 128 + v]; }
    float aacc[8];
#pragma unroll
    for (int i = 0; i < 8; ++i) aacc[i] = 0.f;
    for (int half = 0; half < 2; ++half) {
        if (tid < 64) {
            const int d = half * 64 + tid; const float lb = hgrn_lb(p, h * 128 + d);
            float bc = 0.f;
            for (int t = 0; t < 64; ++t) {
                const float hf = (float)P[(rowbase + t) * NP2 + C_HF + h * 128 + d];
                const float f = lb + (1.f - lb) * sigmoidf_(hf);
                bc += logf(f); bq[t * 65 + tid] = bc; kk[t * 65 + tid] = 1.f - f;
            }
        }
        for (int i = tid; i < 64 * 64; i += NT) { const int t = i >> 6, dl = i & 63; qq[t * 65 + dl] = siluf_((float)P[(rowbase + t) * NP2 + C_HQ + h * 128 + half * 64 + dl]); }
        __syncthreads();
#pragma unroll
        for (int i = 0; i < 8; ++i) {
            const int pr = tid + NT * i, t = pr >> 6, s = pr & 63;
            if (s <= t) { float sum = 0.f;
                for (int dl = 0; dl < 64; ++dl) sum += qq[t * 65 + dl] * kk[s * 65 + dl] * __expf(bq[t * 65 + dl] - bq[s * 65 + dl]);
                aacc[i] += sum; }
        }
        for (int i = tid; i < 64 * 64; i += NT) { const int t = i >> 6, dl = i & 63; qe[t * 128 + half * 64 + dl] = qq[t * 65 + dl] * __expf(bq[t * 65 + dl]); }
        __syncthreads();
    }
#pragma unroll
    for (int i = 0; i < 8; ++i) { const int pr = tid + NT * i, t = pr >> 6, s = pr & 63; Am[t * 65 + s] = aacc[i]; }
    __syncthreads();
    const int v = tid & 127, tg = tid >> 7;
    float acc[16];
#pragma unroll
    for (int i = 0; i < 16; ++i) acc[i] = 0.f;
    for (int s = 0; s < 64; ++s) { const float vval = vv[s * 128 + v];
#pragma unroll
        for (int i = 0; i < 16; ++i) acc[i] += Am[(tg * 16 + i) * 65 + s] * vval; }
    const float* sp = ST + (size_t)(bh * NCH + c) * 16384 + v;
    for (int d = 0; d < 128; ++d) { const float sv = sp[d * 128];
#pragma unroll
        for (int i = 0; i < 16; ++i) acc[i] += qe[(tg * 16 + i) * 128 + d] * sv; }
#pragma unroll
    for (int i = 0; i < 16; ++i) P[(rowbase + tg * 16 + i) * NP2 + C_HQ + h * 128 + v] = (h16)acc[i];
    __syncthreads();
}

__device__ __forceinline__ void phase_mix(const Params& p) {
    const h16* P = (const h16*)(p.ws + WS_P); h16* MIX = (h16*)(p.ws + WS_X);
    const int lane = threadIdx.x & 63, wave = threadIdx.x >> 6;
    for (int row = blockIdx.x * 8 + wave; row < MREAL; row += gridDim.x * 8) {
        const h16* pr = P + (size_t)row * NP2; h16* o = MIX + (size_t)row * D; const h16* qo = (const h16*)(p.ws + WS_QB) + (size_t)row * 512;
        { const h16x8 a = *(const h16x8*)(qo + lane * 8); const h16x8 g = *(const h16x8*)(pr + C_AG + lane * 8);
          float ss = 0.f;
#pragma unroll
          for (int j = 0; j < 8; ++j) ss += (float)a[j] * (float)a[j];
          const float rs = rsqrtf(wave_sum(ss) * (1.f / 512.f) + 1e-6f);
          h16x8 ov;
#pragma unroll
          for (int j = 0; j < 8; ++j) ov[j] = (h16)((float)a[j] * rs * p.attn_norm[lane * 8 + j] * siluf_((float)g[j]));
          *(h16x8*)(o + lane * 8) = ov; }
        { const h16x8 a = *(const h16x8*)(pr + C_HQ + lane * 8); const h16x8 g = *(const h16x8*)(pr + C_HG + lane * 8);
          float ss = 0.f;
#pragma unroll
          for (int j = 0; j < 8; ++j) ss += (float)a[j] * (float)a[j];
#pragma unroll
          for (int o2 = 1; o2 < 16; o2 <<= 1) ss += __shfl_xor(ss, o2);
          const float rs = rsqrtf(ss * (1.f / 128.f) + 1e-6f);
          h16x8 ov;
#pragma unroll
          for (int j = 0; j < 8; ++j) ov[j] = (h16)((float)a[j] * rs * p.hgrn_norm[(lane & 15) * 8 + j] * siluf_((float)g[j]));
          *(h16x8*)(o + 512 + lane * 8) = ov; }
    }
}

__device__ __forceinline__ void phase_final(const Params& p) {
    const int lane = threadIdx.x & 63, wave = threadIdx.x >> 6;
    for (int row = blockIdx.x * 8 + wave; row < MREAL; row += gridDim.x * 8) {
        float* o = p.out + (size_t)row * D;
        f32x4 v[4]; float ss = 0.f;
        for (int j = 0; j < 4; ++j) { v[j] = *(const f32x4*)(o + (lane + 64 * j) * 4); ss += v[j].x * v[j].x + v[j].y * v[j].y + v[j].z * v[j].z + v[j].w * v[j].w; }
        const float rs = rsqrtf(wave_sum(ss) * (1.f / D) + 1e-6f);
        for (int j = 0; j < 4; ++j) { const f32x4 g = *(const f32x4*)(p.final_norm + (lane + 64 * j) * 4);
            *(f32x4*)(o + (lane + 64 * j) * 4) = (f32x4){v[j].x * rs * g.x, v[j].y * rs * g.y, v[j].z * rs * g.z, v[j].w * rs * g.w}; }
    }
}

constexpr int NPHASE = 9;
__global__ void __launch_bounds__(NT, 2) mega(Params p, int ph_lo, int ph_hi) {
    extern __shared__ __attribute__((aligned(16))) char lds[];
    cg::grid_group grid = cg::this_grid();
#define IN(k) (ph_lo <= (k) && (k) < ph_hi)
#define SYNC(k) do { if ((k) + 1 < ph_hi) grid.sync(); } while (0)
    if (IN(0)) { phase_prep(p, lds); if (PROBE == 4) phase_prep(p, lds); SYNC(0); }
    if (PROBE == 2) { for (int i = 0; i < 8; ++i) grid.sync(); }
    if (IN(1)) { phase_gemm_in(p, lds); if (PROBE == 1) phase_gemm_in(p, lds); SYNC(1); }
    if (IN(2)) { phase_post(p); SYNC(2); }
    if (IN(3)) {
        constexpr int NA = NB * 4 * NCH;
        for (int rep = 0; rep < ((PROBE == 3 || PROBE == 12) ? 2 : 1); ++rep)
        for (int it = blockIdx.x; it < 512; it += gridDim.x) { const int uu = it < 256 ? 255 - (it >> 1) : (it - 256) >> 1; idx_unit(p, it & 1, uu, lds, (PROBE == 12 && rep == 1) ? 1 : 0); }
        for (int rep = 0; rep < (PROBE == 5 ? 2 : 1); ++rep)
        for (int it = blockIdx.x; it < NA; it += gridDim.x) hgrn_stepA(p, it, lds);
        SYNC(3);
    }
    if (IN(4)) { hgrn_scan(p); SYNC(4); }
    if (IN(5)) {
        constexpr int NC = NB * 4 * 128;
        for (int it = blockIdx.x; it < NC; it += gridDim.x) hgrn_stepC(p, it, lds);
        {
            const attn_body::AttnTensors AT{(const h16*)(p.ws + WS_QB), (const h16*)(p.ws + WS_KB), (const h16*)(p.ws + WS_VB), (h16*)(p.ws + WS_QB), (const unsigned long long*)p.out};
            const attn_body::StaticOrder SO((int)gridDim.x, (int)blockIdx.x);
            attn_body::attn_phase<attn_body::StaticOrder>(lds, AT, SO);
        }
        SYNC(5);
    }
    if (IN(6)) { phase_mix(p); if (PROBE == 6) phase_mix(p); SYNC(6); }
    if (IN(7)) { phase_gemm_out(p, lds); if (PROBE == 7) phase_gemm_out(p, lds); SYNC(7); }
    if (IN(8)) { phase_final(p); }
#undef IN
#undef SYNC
}

extern "C" void kernel_launch(void* const* d_in, const int* in_sizes, int n_in, void* d_out, int out_size, void* d_ws, size_t ws_size, hipStream_t stream) {
    static int grid = 0;
    if (grid == 0) {
        if (n_in != 11 || ws_size < WS_END || out_size != MREAL * D) { fprintf(stderr, "kernel_launch: unexpected shapes n_in %d ws %zu out %d\n", n_in, ws_size, out_size); grid = -1; return; }
        int dev = 0, cus = 0, per_cu = 0;
        hipGetDevice(&dev); hipDeviceGetAttribute(&cus, hipDeviceAttributeMultiprocessorCount, dev);
        hipFuncSetAttribute((const void*)mega, hipFuncAttributeMaxDynamicSharedMemorySize, LDS_BYTES);
        hipOccupancyMaxActiveBlocksPerMultiprocessor(&per_cu, (const void*)mega, NT, LDS_BYTES);
        if (per_cu < 1) { fprintf(stderr, "kernel_launch: occupancy query says %d\n", per_cu); per_cu = 1; }
        grid = cus * 1;
        (void)hipGetLastError();
    }
    if (grid < 0) return;
    Params p{};
    p.x = (const float*)d_in[0]; p.meta = (const float*)d_in[1]; p.mix_norm = (const float*)d_in[2]; p.w_in = (const float*)d_in[3];
    p.idx_g = (const float*)d_in[4]; p.idx_b = (const float*)d_in[5]; p.attn_norm = (const float*)d_in[6]; p.lb_logits = (const float*)d_in[7];
    p.hgrn_norm = (const float*)d_in[8]; p.w_out = (const float*)d_in[9]; p.final_norm = (const float*)d_in[10];
    p.out = (float*)d_out; p.ws = (unsigned char*)d_ws;
#if N_LAUNCH_MODE == 1
    int lo = 0, hi = NPHASE; void* args[] = {&p, &lo, &hi};
    hipError_t e = hipLaunchCooperativeKernel((const void*)mega, dim3(grid), dim3(NT), args, LDS_BYTES, stream);
    if (e != hipSuccess) fprintf(stderr, "cooperative launch failed: %s (grid %d)\n", hipGetErrorString(e), grid);
#else
    for (int ph = 0; ph < NPHASE; ++ph) hipLaunchKernelGGL(mega, dim3(grid), dim3(NT), LDS_BYTES, stream, p, ph, ph + 1);
#endif
}
```

```cpp
#include <hip/hip_runtime.h>
#include <hip/hip_cooperative_groups.h>
#include <cstdint>
#include <cstdio>
namespace cg = cooperative_groups;

typedef _Float16 h16;
typedef _Float16 h16x8 __attribute__((ext_vector_type(8)));
typedef _Float16 h16x4 __attribute__((ext_vector_type(4)));
typedef float f32x4 __attribute__((ext_vector_type(4)));

#ifndef PROBE
#define PROBE 0
#endif
#ifndef N_LAUNCH_MODE
#define N_LAUNCH_MODE 1
#endif

constexpr int NB = 2, S = 8192, NMETA = 16, D = 1024;
constexpr int MREAL = NB * S;
constexpr int MROWS = MREAL + NMETA;
constexpr int MPAD = 16640;
constexpr int NCOL = 4680, NPAD = 4864;
constexpr int G_IK = 4608;
constexpr int NP2 = 3328;
constexpr int C_AG = 0, C_IQ = 512, C_HQ = 1024, C_HF = 1536, C_HI = 2048, C_HG = 2560, C_IK = 3072, C_IW = 3136;
constexpr int KVROWS = 8320;
constexpr int NCH = 129;
constexpr int NT = 512;

constexpr size_t MiB = 1u << 20;
constexpr size_t WS_WTIN = 1 * MiB, WS_WTOUT = 11 * MiB, WS_ROPE = 13 * MiB, WS_E = 14 * MiB, WS_KI = 23 * MiB, WS_G = 26 * MiB, WS_P = 27 * MiB, WS_QB = 133 * MiB, WS_KB = 149 * MiB, WS_VB = 166 * MiB, WS_X = 190 * MiB, WS_END = 256 * MiB;
static_assert(WS_P + (size_t)MPAD * NP2 * 2 <= WS_QB && WS_QB + (size_t)MREAL * 512 * 2 <= WS_KB && WS_KB + (size_t)NB * KVROWS * 512 * 2 <= WS_VB && WS_VB + (size_t)NB * KVROWS * 512 * 2 <= WS_X, "ws map");
static_assert(WS_X + (size_t)NB * 4 * NCH * 16384 * 4 <= WS_END, "ST");

constexpr int LDS_BYTES = 140 * 1024;

struct Params {
    const float *x, *meta, *mix_norm, *w_in, *idx_g, *idx_b, *attn_norm, *lb_logits, *hgrn_norm, *w_out, *final_norm;
    float* out; unsigned char* ws;
};

__device__ __forceinline__ float wave_sum(float v) {
#pragma unroll
    for (int o = 1; o < 64; o <<= 1) v += __shfl_xor(v, o);
    return v;
}
__device__ __forceinline__ float wave_max(float v) {
#pragma unroll
    for (int o = 1; o < 64; o <<= 1) v = fmaxf(v, __shfl_xor(v, o));
    return v;
}
__device__ __forceinline__ float sigmoidf_(float x) { return 1.f / (1.f + __expf(-x)); }
__device__ __forceinline__ float siluf_(float x) { return x * sigmoidf_(x); }
__device__ __forceinline__ int oldcol(int n) { return n < 2560 ? n : (n < 4608 ? n + 72 : (n < 4672 ? 2560 + (n - 4608) : 2624 + (n - 4672))); }
__device__ __forceinline__ unsigned skey(float x) { if (x == 0.f) x = 0.f; unsigned u = __float_as_uint(x); return (u & 0x80000000u) ? ~u : (u | 0x80000000u); }

__device__ __forceinline__ void transpose_item(const float* __restrict__ W, int ldw, int nvalid, bool remap, h16* __restrict__ WT, int K, int item, float* tile) {
    constexpr float C2 = 0.125f * 1.4426950408889634f;
    const int nkt = K / 64, nb = item / nkt, kb = item % nkt, n0 = nb * 64, k0 = kb * 64, tid = threadIdx.x;
    {
        const int nl = tid & 63, kl = tid >> 6, n = n0 + nl;
        int src = -1; if (n < nvalid) src = remap ? oldcol(n) : n;
        const float scl = (remap && n < 512) ? C2 : 1.f;
        for (int kk = kl; kk < 64; kk += 8) tile[kk * 65 + nl] = (src >= 0) ? W[(size_t)(k0 + kk) * ldw + src] * scl : 0.f;
    }
    __syncthreads();
    {
        const int kl = tid & 63, nl = tid >> 6;
        for (int nn = nl; nn < 64; nn += 8) WT[(size_t)(n0 + nn) * K + k0 + kl] = (h16)tile[kl * 65 + nn];
    }
    __syncthreads();
}

__device__ __forceinline__ void phase_prep(const Params& p, char* lds) {
    float* tile = (float*)lds;
    h16* WTin = (h16*)(p.ws + WS_WTIN); h16* WTout = (h16*)(p.ws + WS_WTOUT);
    constexpr int I_IN = (NPAD / 64) * (D / 64), I_OUT = (D / 64) * (D / 64);
    for (int it = blockIdx.x; it < I_IN + I_OUT; it += gridDim.x) {
        if (it < I_IN) transpose_item(p.w_in, NCOL, NCOL, true, WTin, D, it, tile);
        else transpose_item(p.w_out, D, D, false, WTout, D, it - I_IN, tile);
    }
    h16* HN = (h16*)(p.ws + WS_X);
    const int lane = threadIdx.x & 63, wave = threadIdx.x >> 6;
    for (int row = blockIdx.x * 8 + wave; row < MPAD; row += gridDim.x * 8) {
        h16* o = HN + (size_t)row * D;
        if (row >= MROWS) {
            for (int j = 0; j < 4; ++j) { h16x4 z = {(h16)0.f, (h16)0.f, (h16)0.f, (h16)0.f}; *(h16x4*)(o + (lane + 64 * j) * 4) = z; }
            continue;
        }
        const float* src = row < MREAL ? p.x + (size_t)row * D : p.meta + (size_t)(row - MREAL) * D;
        f32x4 v[4]; float ss = 0.f;
        for (int j = 0; j < 4; ++j) { v[j] = *(const f32x4*)(src + (lane + 64 * j) * 4); ss += v[j].x * v[j].x + v[j].y * v[j].y + v[j].z * v[j].z + v[j].w * v[j].w; }
        const float rs = rsqrtf(wave_sum(ss) * (1.f / D) + 1e-6f);
        for (int j = 0; j < 4; ++j) {
            const f32x4 g = *(const f32x4*)(p.mix_norm + (lane + 64 * j) * 4);
            h16x4 hv = {(h16)(v[j].x * rs * g.x), (h16)(v[j].y * rs * g.y), (h16)(v[j].z * rs * g.z), (h16)(v[j].w * rs * g.w)};
            *(h16x4*)(o + (lane + 64 * j) * 4) = hv;
        }
    }
    {
        h16* KB = (h16*)(p.ws + WS_KB); h16* VB = (h16*)(p.ws + WS_VB);
        for (int idx = blockIdx.x * NT + threadIdx.x; idx < NB * 112 * 64; idx += gridDim.x * NT) {
            const int c = idx & 63, rr = (idx >> 6) % 112, b = idx / (112 * 64);
            const int row = b * KVROWS + (rr < 48 ? 16 + rr : 8256 + (rr - 48));
            const h16x8 z = {(h16)0.f, (h16)0.f, (h16)0.f, (h16)0.f, (h16)0.f, (h16)0.f, (h16)0.f, (h16)0.f};
            *(h16x8*)(KB + (size_t)row * 512 + c * 8) = z; *(h16x8*)(VB + (size_t)row * 512 + c * 8) = z;
        }
    }
    float* ROPE = (float*)(p.ws + WS_ROPE);
    const double inv[8] = {1.0, 0.1939227432012558, 0.03760603070259094, 0.007292664609849453, 0.0014142135623842478, 0.00027424818836152554, 5.3182957344688475e-05, 1.0313385246263351e-05};
    for (int idx = blockIdx.x * NT + threadIdx.x; idx < (S + NMETA) * 8; idx += gridDim.x * NT) {
        const int t = idx >> 3, i = idx & 7;
        double iv = inv[0];
        if (i == 1) iv = inv[1]; else if (i == 2) iv = inv[2]; else if (i == 3) iv = inv[3]; else if (i == 4) iv = inv[4]; else if (i == 5) iv = inv[5]; else if (i == 6) iv = inv[6]; else if (i == 7) iv = inv[7];
        const double rev = (double)t * iv * 0.15915494309189535;
        const float fr = (float)(rev - __builtin_rint(rev));
        ROPE[idx * 2] = __builtin_amdgcn_cosf(fr); ROPE[idx * 2 + 1] = __builtin_amdgcn_sinf(fr);
    }
}

template <int EPI>
__device__ __forceinline__ void gemm_tile(const Params& p, const h16* __restrict__ A, int lda, const h16* __restrict__ Bt, int ldb, int K, int pm, int pn, char* lds) {
    h16* As = (h16*)lds;
    h16* Bs = As + 128 * 40;
    const int tid = threadIdx.x, lane = tid & 63, wave = tid >> 6, wr = wave >> 2, wc = wave & 3;
    const int arow = tid >> 2, apart = tid & 3;
    const h16* ag = A + (size_t)(pm * 128 + arow) * lda + apart * 8;
    const h16* bg0 = Bt + (size_t)(pn * 256 + (tid >> 2)) * ldb + apart * 8;
    const h16* bg1 = Bt + (size_t)(pn * 256 + 128 + (tid >> 2)) * ldb + apart * 8;
    f32x4 acc[4][4];
#pragma unroll
    for (int m = 0; m < 4; ++m)
#pragma unroll
        for (int n = 0; n < 4; ++n) acc[m][n] = (f32x4){0.f, 0.f, 0.f, 0.f};
    h16x8 ra = *(const h16x8*)ag, rb0 = *(const h16x8*)bg0, rb1 = *(const h16x8*)bg1;
    const int nk = K / 32;
    for (int kt = 0; kt < nk; ++kt) {
        *(h16x8*)(As + arow * 40 + apart * 8) = ra;
        *(h16x8*)(Bs + (tid >> 2) * 40 + apart * 8) = rb0;
        *(h16x8*)(Bs + (128 + (tid >> 2)) * 40 + apart * 8) = rb1;
        __syncthreads();
        if (kt + 1 < nk) { ra = *(const h16x8*)(ag + (kt + 1) * 32); rb0 = *(const h16x8*)(bg0 + (kt + 1) * 32); rb1 = *(const h16x8*)(bg1 + (kt + 1) * 32); }
        h16x8 af[4], bf[4];
#pragma unroll
        for (int m = 0; m < 4; ++m) af[m] = *(const h16x8*)(As + (wr * 64 + m * 16 + (lane & 15)) * 40 + (lane >> 4) * 8);
#pragma unroll
        for (int n = 0; n < 4; ++n) bf[n] = *(const h16x8*)(Bs + (wc * 64 + n * 16 + (lane & 15)) * 40 + (lane >> 4) * 8);
#pragma unroll
        for (int m = 0; m < 4; ++m)
#pragma unroll
            for (int n = 0; n < 4; ++n) acc[m][n] = __builtin_amdgcn_mfma_f32_16x16x32_f16(af[m], bf[n], acc[m][n], 0, 0, 0);
        __syncthreads();
    }
#pragma unroll
    for (int m = 0; m < 4; ++m)
#pragma unroll
        for (int n = 0; n < 4; ++n)
#pragma unroll
            for (int r = 0; r < 4; ++r) {
                const int grow = pm * 128 + wr * 64 + m * 16 + (lane >> 4) * 4 + r, gcol = pn * 256 + wc * 64 + n * 16 + (lane & 15);
                const float v = acc[m][n][r];
                if (EPI == 0) {
                    if (gcol < 512) { if (grow < MREAL) ((h16*)(p.ws + WS_QB))[(size_t)grow * 512 + gcol] = (h16)v; }
                    else if (gcol < 1536) {
                        h16* dst = (h16*)(p.ws + (gcol < 1024 ? WS_KB : WS_VB)); const int cc = (gcol - 512) & 511;
                        if (grow < MREAL) dst[((size_t)(grow >> 13) * KVROWS + 64 + (grow & (S - 1))) * 512 + cc] = (h16)v;
                        else if (grow < MROWS) { dst[(size_t)(grow - MREAL) * 512 + cc] = (h16)v; dst[((size_t)KVROWS + (grow - MREAL)) * 512 + cc] = (h16)v; }
                    } else {
                        ((h16*)(p.ws + WS_P))[(size_t)grow * NP2 + (gcol - 1536)] = (h16)v;
                        if (gcol >= G_IK && gcol < G_IK + 128) ((float*)(p.ws + WS_E))[(size_t)grow * 128 + (gcol - G_IK)] = v;
                    }
                } else {
                    p.out[(size_t)grow * D + gcol] = p.x[(size_t)grow * D + gcol] + v;
                }
            }
}

__device__ __forceinline__ void phase_gemm_in(const Params& p, char* lds) {
    constexpr int NM = MPAD / 128, NN = NPAD / 256;
    for (int t = blockIdx.x; t < NM * NN; t += gridDim.x)
        gemm_tile<0>(p, (const h16*)(p.ws + WS_X), D, (const h16*)(p.ws + WS_WTIN), D, D, t / NN, t % NN, lds);
}
__device__ __forceinline__ void phase_gemm_out(const Params& p, char* lds) {
    constexpr int NM = MREAL / 128, NN = D / 256;
    for (int t = blockIdx.x; t < NM * NN; t += gridDim.x)
        gemm_tile<1>(p, (const h16*)(p.ws + WS_X), D, (const h16*)(p.ws + WS_WTOUT), D, D, t / NN, t % NN, lds);
}

__device__ __forceinline__ void phase_post(const Params& p) {
    h16* P = (h16*)(p.ws + WS_P); const float* E = (const float*)(p.ws + WS_E); h16* KI = (h16*)(p.ws + WS_KI); const float* ROPE = (const float*)(p.ws + WS_ROPE);
    h16* QBf = (h16*)(p.ws + WS_QB); h16* KBf = (h16*)(p.ws + WS_KB);
    const int lane = threadIdx.x & 63, wave = threadIdx.x >> 6;
    for (int row = blockIdx.x * 8 + wave; row < MROWS; row += gridDim.x * 8) {
        const int t = row < MREAL ? NMETA + (row & (S - 1)) : row - MREAL;
        {
            const int head = lane >> 3, i = lane & 7;
            const float c = ROPE[(t * 8 + i) * 2], s = ROPE[(t * 8 + i) * 2 + 1];
            auto rope2 = [&](h16* base) { h16* pr = base + head * 64; const float x1 = (float)pr[i], x2 = (float)pr[i + 8]; pr[i] = (h16)(x1 * c - x2 * s); pr[i + 8] = (h16)(x2 * c + x1 * s); };
            if (row < MREAL) { rope2(QBf + (size_t)row * 512); rope2(P + (size_t)row * NP2 + C_IQ); rope2(KBf + ((size_t)(row >> 13) * KVROWS + 64 + (row & (S - 1))) * 512); }
            else { rope2(KBf + (size_t)(row - MREAL) * 512); rope2(KBf + ((size_t)KVROWS + (row - MREAL)) * 512); }
        }
        const float v = E[(size_t)row * 128 + lane];
        const float mean = wave_sum(v) * (1.f / 64.f); const float d = v - mean;
        const float var = wave_sum(d * d) * (1.f / 64.f);
        float y = d * rsqrtf(var + 1e-6f) * p.idx_g[lane] + p.idx_b[lane];
        const float other = __shfl_xor(y, 8);
        if (lane < 16) {
            const int i = lane & 7; const float c = ROPE[(t * 8 + i) * 2], s = ROPE[(t * 8 + i) * 2 + 1];
            y = lane < 8 ? (y * c - other * s) : (y * c + other * s);
        }
        KI[(size_t)row * 64 + lane] = (h16)y;
    }
}

constexpr int NMI = 130;
constexpr int QB = 32, CAP = 128;
constexpr int IX_KB = 0, IX_HIST = 32768, IX_MASK = 32768  , IX_CAND = 98304, IX_CANDI = 114688, IX_ST = 131072, IX_FLAG = 132096;
constexpr int HROW = 512;
typedef float f32x16 __attribute__((ext_vector_type(16)));
#define ST_LO 0
#define ST_HI 1
#define ST_NEED 2
#define ST_CNT 3
#define ST_FLAGS 4
#define ST_NCAND 5
#define ST_SH 6
#define ST_RUN 7
#define FL_ACTIVE 1u
#define FL_TIE 2u

__device__ __forceinline__ float relu_(float x) { return __builtin_amdgcn_fmed3f(x, 0.f, __builtin_inff()); }
__device__ __forceinline__ unsigned skey_c(float x) { const unsigned u = __float_as_uint(x); return u ^ (((unsigned)((int)u >> 31)) | 0x80000000u); }
__device__ __forceinline__ int custom_bin(unsigned key) {
    const int k14 = (int)(key >> 18); const int a = k14 - 11488, bb = k14 - 3873;
    const int lowpart = min(max(bb, 0), 511);
    return max(min(a, 1023), lowpart);
}

__device__ __forceinline__ void glds16(const void* gsrc, unsigned lds_dst) { unsigned keep;
    asm volatile("s_mov_b32 %0, m0\n\ts_mov_b32 m0, %2\n\ts_nop 0\n\tglobal_load_lds_dwordx4 %1, off\n\ts_mov_b32 m0, %0" : "=&s"(keep) : "v"(gsrc), "s"(lds_dst) : "memory"); }

struct IdxLane { unsigned loA, hiA, loB, hiB, flA, flB, shA, shB, needA, needB, runA, runB; int qA, qB, rA, rB; bool anyTie; };

template <int MODE, bool DIAG>
__device__ __forceinline__ void idx_tile(char* lds, const char* kb, int t, const h16x8 (&afrag)[4], const float (&wreg)[16], IdxLane& L) {
    unsigned* HIST = (unsigned*)(lds + IX_HIST); unsigned* MASK = (unsigned*)(lds + IX_MASK); unsigned* CAND = (unsigned*)(lds + IX_CAND); unsigned* CANDI = (unsigned*)(lds + IX_CANDI); unsigned* ST = (unsigned*)(lds + IX_ST);
    const int lane = threadIdx.x & 63, w = threadIdx.x >> 6, hl = lane >> 5, cc = lane & 31;
    h16x8 bf[2][4];
#pragma unroll
    for (int kh = 0; kh < 2; ++kh)
#pragma unroll
        for (int ks = 0; ks < 4; ++ks) { const int ki = 32 * kh + cc; bf[kh][ks] = *(const h16x8*)(kb + ki * 128 + (((2 * ks + hl) ^ ((ki >> 1) & 7)) << 4)); }
    f32x16 accs[2];
    accs[0] = (f32x16){0.f, 0.f, 0.f, 0.f, 0.f, 0.f, 0.f, 0.f, 0.f, 0.f, 0.f, 0.f, 0.f, 0.f, 0.f, 0.f}; accs[1] = accs[0];
#pragma unroll
    for (int ks = 0; ks < 4; ++ks) { accs[0] = __builtin_amdgcn_mfma_f32_32x32x16_f16(afrag[ks], bf[0][ks], accs[0], 0, 0, 0); accs[1] = __builtin_amdgcn_mfma_f32_32x32x16_f16(afrag[ks], bf[1][ks], accs[1], 0, 0, 0); }
#pragma unroll
    for (int kh = 0; kh < 2; ++kh) {
        const f32x16 acc = accs[kh];
        float pq[4];
#pragma unroll
        for (int q4 = 0; q4 < 4; ++q4)
            pq[q4] = __builtin_fmaf(wreg[4 * q4 + 3], relu_(acc[4 * q4 + 3]), __builtin_fmaf(wreg[4 * q4 + 2], relu_(acc[4 * q4 + 2]), __builtin_fmaf(wreg[4 * q4 + 1], relu_(acc[4 * q4 + 1]), __builtin_fmaf(wreg[4 * q4], relu_(acc[4 * q4]), 0.f))));
        const auto r01 = __builtin_amdgcn_permlane32_swap(__float_as_uint(pq[0]), __float_as_uint(pq[1]), false, false);
        const auto r23 = __builtin_amdgcn_permlane32_swap(__float_as_uint(pq[2]), __float_as_uint(pq[3]), false, false);
        const float sA = __uint_as_float(r01[0]) + __uint_as_float(r01[1]);
        const float sB = __uint_as_float(r23[0]) + __uint_as_float(r23[1]);
        const int sidx = 64 * t + 32 * kh + cc;
        const bool vA = DIAG ? (sidx <= L.rA) : true, vB = DIAG ? (sidx <= L.rB) : true;
        const unsigned kA = skey_c(sA), kB = skey_c(sB);
        if (MODE == 0) {
            const int bA = custom_bin(kA), bB = custom_bin(kB);
            if (vA) atomicAdd(&HIST[L.qA * HROW + (bA >> 1)], 1u << (16 * (bA & 1)));
            if (vB) atomicAdd(&HIST[L.qB * HROW + (bB >> 1)], 1u << (16 * (bB & 1)));
        } else if (MODE == 1) {
            if (vA && (L.flA & FL_ACTIVE) && (kA - L.loA) <= (L.hiA - L.loA)) { const unsigned sb = (kA - L.loA) >> L.shA; atomicAdd(&HIST[L.qA * HROW + (sb >> 1)], 1u << (16 * (sb & 1))); }
            if (vB && (L.flB & FL_ACTIVE) && (kB - L.loB) <= (L.hiB - L.loB)) { const unsigned sb = (kB - L.loB) >> L.shB; atomicAdd(&HIST[L.qB * HROW + (sb >> 1)], 1u << (16 * (sb & 1))); }
        } else {
            bool selA = vA && kA > L.hiA, selB = vB && kB > L.hiB;
            const bool inA = vA && (kA - L.loA) <= (L.hiA - L.loA), inB = vB && (kB - L.loB) <= (L.hiB - L.loB);
            if (L.anyTie) {
                const unsigned long long eA = __ballot(inA && (L.flA & FL_TIE)), eB = __ballot(inB && (L.flB & FL_TIE));
                const unsigned pA = hl ? (unsigned)(eA >> 32) : (unsigned)eA, pB = hl ? (unsigned)(eB >> 32) : (unsigned)eB;
                const unsigned below = (1u << cc) - 1u;
                if (inA && (L.flA & FL_TIE) && L.runA + __popc(pA & below) < L.needA) selA = true;
                if (inB && (L.flB & FL_TIE) && L.runB + __popc(pB & below) < L.needB) selB = true;
                L.runA += __popc(pA); L.runB += __popc(pB);
            }
            if (inA && !(L.flA & FL_TIE)) { const unsigned pos = atomicAdd(&ST[L.qA * 8 + ST_NCAND], 1u); if (pos < CAP) { CAND[L.qA * CAP + pos] = kA; CANDI[L.qA * CAP + pos] = (unsigned)sidx; } }
            if (inB && !(L.flB & FL_TIE)) { const unsigned pos = atomicAdd(&ST[L.qB * 8 + ST_NCAND], 1u); if (pos < CAP) { CAND[L.qB * CAP + pos] = kB; CANDI[L.qB * CAP + pos] = (unsigned)sidx; } }
            const unsigned long long mA = __ballot(selA), mB = __ballot(selB);
            const unsigned val = lane == 0 ? (unsigned)mA : (lane == 1 ? (unsigned)(mA >> 32) : (lane == 2 ? (unsigned)mB : (unsigned)(mB >> 32)));
            if (lane < 4) MASK[(4 * w + lane) * 260 + (t + 1) * 2 + kh] = val;
        }
    }
}

template <int MODE>
__device__ __forceinline__ void idx_pass(const Params& p, int b, int u, char* lds, const h16x8 (&afrag)[4], const float (&wreg)[16]) {
    const h16* KI = (const h16*)(p.ws + WS_KI) + (size_t)b * S * 64;
    unsigned* ST = (unsigned*)(lds + IX_ST);
    const int tid = threadIdx.x, lane = tid & 63, hl = lane >> 5; const int w = __builtin_amdgcn_readfirstlane(tid >> 6);
    const int tq = u >> 1;
    IdxLane L{};
    L.qA = 4 * w + hl; L.qB = 4 * w + 2 + hl; L.rA = 32 * u + L.qA; L.rB = 32 * u + L.qB;
    if (MODE != 0) { L.loA = ST[L.qA * 8 + ST_LO]; L.hiA = ST[L.qA * 8 + ST_HI]; L.flA = ST[L.qA * 8 + ST_FLAGS]; L.shA = ST[L.qA * 8 + ST_SH]; L.needA = ST[L.qA * 8 + ST_NEED];
                     L.loB = ST[L.qB * 8 + ST_LO]; L.hiB = ST[L.qB * 8 + ST_HI]; L.flB = ST[L.qB * 8 + ST_FLAGS]; L.shB = ST[L.qB * 8 + ST_SH]; L.needB = ST[L.qB * 8 + ST_NEED]; }
    L.anyTie = (MODE == 2) && (__ballot((L.flA | L.flB) & FL_TIE) != 0ull);
    const int si = 8 * w + (lane >> 3);
    const h16* ksrc = KI + (size_t)si * 64 + (((lane & 7) ^ ((si >> 1) & 7)) << 3);
    const unsigned lds0 = (unsigned)(uintptr_t)lds + IX_KB + (unsigned)w * 1024u;
#define IDX_DMA(tt) glds16(ksrc + (size_t)(tt) * 64 * 64, (unsigned)__builtin_amdgcn_readfirstlane(lds0 + (unsigned)((tt) & 3) * 8192u))
#define IDX_WAIT(N) asm volatile("s_waitcnt vmcnt(" #N ") lgkmcnt(0)\n\ts_barrier" ::: "memory")
    IDX_DMA(0); if (tq >= 1) IDX_DMA(1); if (tq >= 2) IDX_DMA(2);
    if (tq >= 2) IDX_WAIT(2); else if (tq == 1) IDX_WAIT(1); else IDX_WAIT(0);
    for (int t = 0; t < tq; ++t) {
        if (t + 3 <= tq) IDX_DMA(t + 3);
        idx_tile<MODE, false>(lds, lds + IX_KB + (t & 3) * 8192, t, afrag, wreg, L);
        if (t + 3 <= tq) IDX_WAIT(2); else if (t + 2 <= tq) IDX_WAIT(1); else IDX_WAIT(0);
    }
    idx_tile<MODE, true>(lds, lds + IX_KB + (tq & 3) * 8192, tq, afrag, wreg, L);
    IDX_WAIT(0);
#undef IDX_DMA
#undef IDX_WAIT
}

template <int MODE>
__device__ __forceinline__ void idx_scan(char* lds) {
    unsigned* HIST = (unsigned*)(lds + IX_HIST); unsigned* ST = (unsigned*)(lds + IX_ST); unsigned* FLAG = (unsigned*)(lds + IX_FLAG);
    const int lane = threadIdx.x & 63, w = threadIdx.x >> 6;
    for (int q4 = 0; q4 < 4; ++q4) {
        const int q = 4 * w + q4;
        const unsigned fl = ST[q * 8 + ST_FLAGS];
        if (MODE == 1 && !(fl & FL_ACTIVE)) continue;
        const unsigned need = ST[q * 8 + ST_NEED], lo = ST[q * 8 + ST_LO], hi = ST[q * 8 + ST_HI], sh = ST[q * 8 + ST_SH];
        unsigned c[16];
#pragma unroll
        for (int j = 0; j < 8; ++j) { const unsigned d = HIST[q * HROW + 8 * lane + j]; c[2 * j] = d & 0xFFFFu; c[2 * j + 1] = d >> 16; HIST[q * HROW + 8 * lane + j] = 0u; }
        unsigned tl = 0;
#pragma unroll
        for (int k = 0; k < 16; ++k) tl += c[k];
        unsigned Ssum = tl;
#pragma unroll
        for (int o = 1; o < 64; o <<= 1) { const unsigned v = __shfl_down(Ssum, o); if (lane + o < 64) Ssum += v; }
        const unsigned above = Ssum - tl;
        if (above < need && need <= Ssum) {
            unsigned cum = above; int bstar = 16 * lane; unsigned cnt = 0; bool found = false;
#pragma unroll
            for (int k = 15; k >= 0; --k) { if (!found) { if (cum + c[k] >= need) { bstar = 16 * lane + k; cnt = c[k]; found = true; } else cum += c[k]; } }
            const unsigned nneed = need - cum;
            unsigned nlo, nhi;
            if (MODE == 0) {
                if (bstar >= 512) { nlo = (unsigned)(bstar + 11488) << 18; nhi = bstar == 1023 ? 0xFFFFFFFFu : (nlo | 0x3FFFFu); }
                else if (bstar == 511) { nlo = 4384u << 18; nhi = (11999u << 18) | 0x3FFFFu; }
                else { nhi = ((unsigned)(bstar + 3873) << 18) | 0x3FFFFu; nlo = bstar == 0 ? 0u : ((unsigned)(bstar + 3873) << 18); }
            } else {
                nlo = lo + ((unsigned)bstar << sh); const unsigned top = nlo + ((1u << sh) - 1u); nhi = top < hi ? top : hi; if (top < nlo) nhi = hi;
            }
            const unsigned range = nhi - nlo;
            unsigned nfl = 0, nsh = 0;
            if (nlo < nhi && cnt > CAP) { nfl = FL_ACTIVE; const int bits = 32 - __clz(range); nsh = bits > 10 ? (unsigned)(bits - 10) : 0u; *FLAG = 1u; }
            else if (cnt > CAP) nfl = FL_TIE;
            ST[q * 8 + ST_LO] = nlo; ST[q * 8 + ST_HI] = nhi; ST[q * 8 + ST_NEED] = nneed; ST[q * 8 + ST_CNT] = cnt; ST[q * 8 + ST_FLAGS] = nfl; ST[q * 8 + ST_SH] = nsh;
        }
    }
}

__device__ __forceinline__ void idx_unit(const Params& p, int b, int u, char* lds, int dry = 0) {
    const h16* P = (const h16*)(p.ws + WS_P); const float* E = (const float*)(p.ws + WS_E);
    unsigned long long* Mk = (unsigned long long*)p.out + (dry ? (size_t)(36u << 20) / 8 : 0);
    unsigned* HIST = (unsigned*)(lds + IX_HIST); unsigned* MASK = (unsigned*)(lds + IX_MASK); unsigned* CAND = (unsigned*)(lds + IX_CAND); unsigned* ST = (unsigned*)(lds + IX_ST); unsigned* FLAG = (unsigned*)(lds + IX_FLAG);
    const int tid = threadIdx.x, lane = tid & 63, w = tid >> 6, hl = lane >> 5, cc = lane & 31;
    const int qb = u >> 3, nwords = 4 * qb + 6;
    if (32 * u + 31 < 256) {
        for (int idx = tid; idx < 32 * nwords; idx += NT) {
            const int q = idx & 31, i = idx >> 5, r = 32 * u + q;
            unsigned long long wv;
            if (i == 0) wv = 0xFFFFull; else { const int nv = r - 64 * (i - 1) + 1; wv = nv <= 0 ? 0ull : (nv >= 64 ? ~0ull : ((1ull << nv) - 1ull)); }
            Mk[((size_t)b * NMI + i) * S + r] = wv;
        }
        return;
    }
    for (int i = tid; i < 32 * HROW; i += NT) HIST[i] = 0u;
    if (tid < 32) { ST[tid * 8 + ST_LO] = 0u; ST[tid * 8 + ST_HI] = 0xFFFFFFFFu; ST[tid * 8 + ST_NEED] = 256u; ST[tid * 8 + ST_CNT] = 0u; ST[tid * 8 + ST_FLAGS] = 0u; ST[tid * 8 + ST_NCAND] = 0u; ST[tid * 8 + ST_SH] = 0u; ST[tid * 8 + ST_RUN] = 0u; }
    if (tid == 0) *FLAG = 0u;
    h16x8 afrag[4]; float wreg[16];
    {
        const int qq = cc >> 3, head = cc & 7;
        const size_t row = (size_t)b * S + 32 * u + 4 * w + qq;
#pragma unroll
        for (int ks = 0; ks < 4; ++ks) afrag[ks] = *(const h16x8*)(P + row * NP2 + C_IQ + head * 64 + 16 * ks + 8 * hl);
#pragma unroll
        for (int q4 = 0; q4 < 4; ++q4) { const f32x4 wv = *(const f32x4*)(E + ((size_t)b * S + 32 * u + 4 * w + q4) * 128 + 64 + 4 * hl); wreg[4 * q4] = wv.x; wreg[4 * q4 + 1] = wv.y; wreg[4 * q4 + 2] = wv.z; wreg[4 * q4 + 3] = wv.w; }
    }
#pragma unroll
    for (int ks = 0; ks < 4; ++ks) asm volatile("" : "+v"(afrag[ks]));
#pragma unroll
    for (int i = 0; i < 16; ++i) asm volatile("" : "+v"(wreg[i]));
    __syncthreads();
#if PROBE == 9
    idx_pass<0>(p, b, u, lds, afrag, wreg);
    for (int i = tid; i < 32 * HROW; i += NT) HIST[i] = 0u;
    __syncthreads();
#endif
    if (!dry) idx_pass<0>(p, b, u, lds, afrag, wreg);
    idx_scan<0>(lds);
    __syncthreads();
    for (int iter = 0; iter < 8; ++iter) {
        if (*FLAG == 0u || PROBE == 14) break;
        __syncthreads();
        if (tid == 0) *FLAG = 0u;
        __syncthreads();
        if (!dry) idx_pass<1>(p, b, u, lds, afrag, wreg);
        idx_scan<1>(lds);
        __syncthreads();
    }
    for (int i = tid; i < 32 * 260; i += NT) MASK[i] = 0u;
    __syncthreads();
    if (!dry) idx_pass<2>(p, b, u, lds, afrag, wreg);
#if PROBE == 8
    if (tid < 32) ST[tid * 8 + ST_NCAND] = 0u;
    __syncthreads();
    idx_pass<2>(p, b, u, lds, afrag, wreg);
#endif
    for (int rrep = 0; rrep < (PROBE == 13 ? 2 : 1); ++rrep)
    for (int q4 = 0; q4 < 4; ++q4) {
        const int q = 4 * w + q4;
        const unsigned fl = ST[q * 8 + ST_FLAGS]; if (fl & FL_TIE) continue;
        unsigned nc = ST[q * 8 + ST_NCAND]; if (nc > CAP) nc = CAP;
        const unsigned need = ST[q * 8 + ST_NEED], lo = ST[q * 8 + ST_LO];
        (void)lo;
        const unsigned* CANDI = (const unsigned*)(lds + IX_CANDI);
        const unsigned k0 = lane < nc ? CAND[q * CAP + lane] : 0u, k1 = lane + 64 < nc ? CAND[q * CAP + lane + 64] : 0u;
        const unsigned i0 = lane < nc ? CANDI[q * CAP + lane] : 0u, i1 = lane + 64 < nc ? CANDI[q * CAP + lane + 64] : 0u;
        unsigned r0 = 0, r1 = 0;
        for (unsigned j = 0; j < nc; ++j) { const unsigned kj = CAND[q * CAP + j], ij = CANDI[q * CAP + j];
            r0 += (kj > k0 || (kj == k0 && ij < i0)) ? 1u : 0u; r1 += (kj > k1 || (kj == k1 && ij < i1)) ? 1u : 0u; }
        if (lane < nc && r0 < need) { const int s = (int)i0; atomicOr(&MASK[q * 260 + ((s >> 6) + 1) * 2 + ((s >> 5) & 1)], 1u << (s & 31)); }
        if (lane + 64 < nc && r1 < need) { const int s = (int)i1; atomicOr(&MASK[q * 260 + ((s >> 6) + 1) * 2 + ((s >> 5) & 1)], 1u << (s & 31)); }
    }
    __syncthreads();
    for (int idx = tid; idx < 32 * nwords; idx += NT) {
        const int q = idx & 31, i = idx >> 5, r = 32 * u + q;
        const unsigned long long wv = i == 0 ? 0xFFFFull : ((unsigned long long)MASK[q * 260 + 2 * i] | ((unsigned long long)MASK[q * 260 + 2 * i + 1] << 32));
        Mk[((size_t)b * NMI + i) * S + r] = wv;
    }
    __syncthreads();
}

namespace attn_body {
using bf16=_Float16;
typedef _Float16 fh16x8 __attribute__((ext_vector_type(8)));
typedef unsigned u32x2 __attribute__((ext_vector_type(2)));
#define MFH(a,b,c,x,y,z) __builtin_amdgcn_mfma_f32_32x32x16_f16(__builtin_bit_cast(fh16x8,(a)),__builtin_bit_cast(fh16x8,(b)),(c),0,0,0)
using bf16x8=__attribute__((ext_vector_type(8)))short;
using s16x4=__attribute__((ext_vector_type(4)))short;
using f32x16=__attribute__((ext_vector_type(16)))float;
using u32x4=__attribute__((ext_vector_type(4)))unsigned;
constexpr int BATCH=2,NHEAD=8,SEQ=8192,D=64,DM=NHEAD*D,KVROWS=8320,NMI_=130;
constexpr int NW=8,QBLK=32,QB=QBLK*NW,KVBLK=64,NQB=SEQ/QB;
constexpr int ATTN_PITCH=DM, ATTN_UNIT_ROWS=QB;
__device__ __forceinline__ int crow(int r,int hi){return (r&3)+8*(r>>2)+4*hi;}
#define SBAR() __builtin_amdgcn_sched_barrier(0)
__device__ __forceinline__ float msel(int m,int pos,float keepv){ const int t=__builtin_amdgcn_sbfe(m,pos,1); float d; asm("v_bfi_b32 %0, %1, %2, %3":"=v"(d):"v"(t),"v"(keepv),"s"(0xFF800000u)); return d; }
__device__ __forceinline__ void cinit(f32x16&p0,f32x16&p1,const u32x2&m,int hi,float nmh){
  const int m0=(int)(m[0]>>(4*hi)), m1=(int)(m[1]>>(4*hi));
  #pragma unroll
  for(int r=0;r<16;++r){ const int pos=(r&3)+8*(r>>2); p0[r]=msel(m0,pos,nmh); p1[r]=msel(m1,pos,nmh); }
  asm volatile("s_nop 1":"+v"(p0),"+v"(p1));
}
__device__ __forceinline__ void mload(u32x2&m,const unsigned long long*p){ asm volatile("global_load_dwordx2 %0, %1, off":"=v"(m):"v"(p):"memory"); }
constexpr int NSLOT=3, SLOTB=8192;
constexpr int LDS_K=0, LDS_V=NSLOT*SLOTB, LDS_WS=2*NSLOT*SLOTB, LDS_OST=LDS_WS+NW*64*4, LDS_BYTES=LDS_OST+NW*4096;
constexpr float C2=0.125f*1.4426950408889634f;
__device__ __forceinline__ void glds16(const void*gsrc,unsigned lds_dst){unsigned keep;
  asm volatile("s_mov_b32 %0, m0\n\ts_mov_b32 m0, %2\n\ts_nop 0\n\tglobal_load_lds_dwordx4 %1, off\n\ts_mov_b32 m0, %0":"=&s"(keep):"v"(gsrc),"s"(lds_dst):"memory");}
__device__ __forceinline__ float max3f(float a,float b,float c){float r;asm("v_max3_f32 %0, %1, %2, %3":"=v"(r):"v"(a),"v"(b),"v"(c));return r;}
__device__ __forceinline__ float max2f(float a,float b){float r;asm("v_max_f32_e32 %0, %1, %2":"=v"(r):"v"(a),"v"(b));return r;}
__device__ __forceinline__ float fadd_s(float a,float b){float r;asm("v_add_f32_e32 %0, %1, %2":"=v"(r):"v"(a),"v"(b));return r;}
__device__ __forceinline__ float fsub_s(float a,float b){float r;asm("v_sub_f32_e32 %0, %1, %2":"=v"(r):"v"(a),"v"(b));return r;}
typedef float f32x2_t __attribute__((ext_vector_type(2))); typedef _Float16 bf16x2_t __attribute__((ext_vector_type(2)));
__device__ __forceinline__ unsigned cvtpk_s(float lo,float hi){f32x2_t v={lo,hi};bf16x2_t b=__builtin_convertvector(v,bf16x2_t);return __builtin_bit_cast(unsigned,b);}
#define WAIT_BAR(N) asm volatile("s_waitcnt vmcnt(" #N ") lgkmcnt(0)\n\ts_barrier":::"memory")
#define WAIT_BAR_M(N,M) do{ asm volatile("s_waitcnt vmcnt(" #N ") lgkmcnt(0)\n\ts_barrier":::"memory"); __builtin_amdgcn_sched_barrier(0); asm volatile("":"+v"(M)); }while(0)
#define WAIT_BAR_M2(N,M,M2) do{ asm volatile("s_waitcnt vmcnt(" #N ") lgkmcnt(0)\n\ts_barrier":::"memory"); __builtin_amdgcn_sched_barrier(0); asm volatile("":"+v"(M),"+v"(M2)); }while(0)

__device__ __forceinline__ void qkt(f32x16&p0,f32x16&p1,const char*Kslot,const bf16x8*qr,int r32,int hi){
  const char*kb=Kslot+hi*1024+r32*16;
  #pragma unroll
  for(int d0=0;d0<4;++d0){
    const bf16x8 b0=*reinterpret_cast<const bf16x8*>(kb+d0*2048);
    const bf16x8 b1=*reinterpret_cast<const bf16x8*>(kb+d0*2048+512);
    p0=MFH(b0,qr[d0],p0,0,0,0);p1=MFH(b1,qr[d0],p1,0,0,0);}
}
typedef __attribute__((address_space(3))) const char* lds_cptr;
typedef short v4i16_t __attribute__((ext_vector_type(4)));
__device__ __forceinline__ void kload8(bf16x8*kf,lds_cptr kp){
  kf[0]=*(const __attribute__((address_space(3))) bf16x8*)(kp);      kf[1]=*(const __attribute__((address_space(3))) bf16x8*)(kp+512);
  kf[2]=*(const __attribute__((address_space(3))) bf16x8*)(kp+2048); kf[3]=*(const __attribute__((address_space(3))) bf16x8*)(kp+2560);
  kf[4]=*(const __attribute__((address_space(3))) bf16x8*)(kp+4096); kf[5]=*(const __attribute__((address_space(3))) bf16x8*)(kp+4608);
  kf[6]=*(const __attribute__((address_space(3))) bf16x8*)(kp+6144); kf[7]=*(const __attribute__((address_space(3))) bf16x8*)(kp+6656);
}
__device__ __forceinline__ void kload2(bf16x8*kf,lds_cptr kp,int j){ kf[2*j]=*(const __attribute__((address_space(3))) bf16x8*)(kp+j*2048); kf[2*j+1]=*(const __attribute__((address_space(3))) bf16x8*)(kp+j*2048+512); }
__device__ __forceinline__ s16x4 vtr(lds_cptr p){ return __builtin_bit_cast(s16x4,__builtin_amdgcn_ds_read_tr16_b64_v4i16((__attribute__((address_space(3))) v4i16_t*)p)); }
__device__ __forceinline__ float rowmax(const f32x16&p0,const f32x16&p1){
  float a=max3f(p0[0],p0[1],p1[0]),b=max3f(p0[2],p0[3],p1[1]);a=max3f(a,p1[2],p1[3]);
  #pragma unroll
  for(int r=4;r<16;r+=4){a=max3f(a,p0[r],p0[r+1]);b=max3f(b,p0[r+2],p0[r+3]);a=max3f(a,p1[r],p1[r+1]);b=max3f(b,p1[r+2],p1[r+3]);}
  const float m=max2f(a,b);
  auto rr=__builtin_amdgcn_permlane32_swap(__float_as_uint(m),__float_as_uint(m),false,false);
  return max2f(__uint_as_float(rr[0]),__uint_as_float(rr[1]));
}
__device__ __forceinline__ void pv(f32x16*o,int vb,bf16x8 pa0,bf16x8 pa1,bf16x8 pa2,bf16x8 pa3){
  #pragma unroll
  for(int d0=0;d0<2;++d0){s16x4 lo[4],hi[4];
    #pragma unroll
    for(int ks=0;ks<4;++ks){
      asm volatile("ds_read_b64_tr_b16 %0,%1 offset:%c2":"=&v"(lo[ks]):"v"(vb),"i"(d0*4096+ks*1024):"memory");
      asm volatile("ds_read_b64_tr_b16 %0,%1 offset:%c2":"=&v"(hi[ks]):"v"(vb),"i"(d0*4096+ks*1024+512):"memory");}
    asm volatile("s_waitcnt lgkmcnt(0)":::"memory");SBAR();
    #define PK(k) (bf16x8){lo[k][0],lo[k][1],lo[k][2],lo[k][3],hi[k][0],hi[k][1],hi[k][2],hi[k][3]}
    o[d0]=MFH(pa0,PK(0),o[d0],0,0,0);
    o[d0]=MFH(pa1,PK(1),o[d0],0,0,0);
    o[d0]=MFH(pa2,PK(2),o[d0],0,0,0);
    o[d0]=MFH(pa3,PK(3),o[d0],0,0,0);
    #undef PK
  }
}

#ifndef ATTN_STORE16
#define ATTN_STORE16(p,v) (*(u32x4*)(p)=(v))
#endif
template<int THRL> __device__ __forceinline__ void attn_unit(int b,int h,int qb,const bf16*Q,const bf16*__restrict__ K,const bf16*__restrict__ V,bf16*O,const unsigned long long*__restrict__ Mk,char*shm){
  const int tid=threadIdx.x,lane=tid&63,r32=lane&31,hi=lane>>5; const int wid=__builtin_amdgcn_readfirstlane(tid>>6);
  const long rowbase=(long)b*SEQ, kvbase=(long)b*KVROWS; const int q0=qb*QB;
  const bf16*Qw=Q+(rowbase+q0+wid*QBLK)*DM+h*D;
  const bf16*Kh=K+kvbase*DM+h*D,*Vh=V+kvbase*DM+h*D;
  const unsigned long long*mrow=Mk+(long)b*NMI_*SEQ+(q0+wid*QBLK+r32);
  u32x2 mA,mB; mload(mA,mrow); mload(mB,mrow+SEQ);
  const unsigned lds0=(unsigned)(uintptr_t)shm;
  float*wsf=(float*)(shm+LDS_WS)+wid*64;
  const bf16*ksrc=Kh+(long)lane*DM+wid*8;
  const bf16*vsrc=Vh+(long)(16*(wid&3)+(lane>>2))*DM+(wid>>2)*32+(lane&3)*8;
  const unsigned kdst=lds0+LDS_K+wid*1024, vdst=lds0+LDS_V+wid*1024;
  #define DMA_K(t,slot) glds16(ksrc+(long)(t)*KVBLK*DM,(unsigned)__builtin_amdgcn_readfirstlane(kdst+(slot)))
  #define DMA_V(t,slot) glds16(vsrc+(long)(t)*KVBLK*DM,(unsigned)__builtin_amdgcn_readfirstlane(vdst+(slot)))
  const int vb0=(int)(lds0+LDS_V)+((lane>>4)&1)*32+(lane&3)*8+(4*hi+((lane&15)>>2))*64;
  const char*Kbase=shm+LDS_K; bf16x8 kf[8];
  const lds_cptr shm3=(lds_cptr)shm; const lds_cptr kp0=shm3+LDS_K+hi*1024+r32*16; const lds_cptr vp0=shm3+LDS_V+((lane>>4)&1)*32+(lane&3)*8+(4*hi+((lane&15)>>2))*64;
  const int NT=(q0+QB)/KVBLK+2;
  DMA_K(0,0);DMA_V(0,0);DMA_K(1,SLOTB);
  bf16x8 qr[4];
  #pragma unroll
  for(int d0=0;d0<4;++d0)qr[d0]=*reinterpret_cast<const bf16x8*>(&Qw[(long)r32*DM+d0*16+hi*8]);
  float mhat=0.f,l_reg=0.f;f32x16 o[2];o[0]=f32x16{};o[1]=f32x16{};
  const int qrel=wid*QBLK+r32;
  bool resc=false;
  #define START(P0,P1) do{ const float rm=rowmax(P0,P1); resc=false; \
    { const float dl=rm; mhat=fadd_s(mhat,dl); \
      _Pragma("unroll") for(int r=0;r<16;++r){P0[r]=fsub_s(P0[r],dl);P1[r]=fsub_s(P1[r],dl);} \
      } \
    _Pragma("unroll") for(int r=0;r<16;++r)P0[r]=__builtin_amdgcn_exp2f(P0[r]); }while(0)
  #define RESC() do{ if(resc){ asm volatile("s_waitcnt lgkmcnt(0)":::"memory"); \
      _Pragma("unroll") for(int d_=0;d_<2;++d_) _Pragma("unroll") for(int r=0;r<16;++r)o[d_][r]*=wsf[crow(r,hi)]; } }while(0)
  f32x16 pA0,pA1,pB0,pB1;
  int sl_prev=0,sl_cur=0,sl_next=SLOTB;
  #define ROT() do{sl_prev=sl_cur;sl_cur=sl_next;sl_next=(sl_next==(NSLOT-1)*SLOTB)?0:sl_next+SLOTB;}while(0)
  DMA_K(2,2*SLOTB);
  WAIT_BAR_M2(3,mA,mB);
  cinit(pA0,pA1,mA,hi,0.f);qkt(pA0,pA1,Kbase,qr,r32,hi);asm volatile("s_nop 15\n\ts_nop 7":"+v"(pA0),"+v"(pA1));
  START(pA0,pA1);
  _Pragma("unroll") for(int r=0;r<16;++r)pA1[r]=__builtin_amdgcn_exp2f(pA1[r]);
  WAIT_BAR(0);
  DMA_K(3,0);DMA_V(1,SLOTB);
  ROT();
  kload8(kf,kp0+sl_cur);
  WAIT_BAR(2);
  s16x4 vlo[8],vhi[8]; u32x4 pw0,pw1,pw2,pw3;
  #define PKW(P,B) cvtpk_s(P[B],P[B+1])
  #define PAF(k) __builtin_bit_cast(bf16x8,pw##k)
  #define VFR(i) (bf16x8){vlo[i][0],vlo[i][1],vlo[i][2],vlo[i][3],vhi[i][0],vhi[i][1],vhi[i][2],vhi[i][3]}
  #define PIN(x) asm volatile("":"+v"(x))
  #define MX3(a,b,c) __builtin_fmaxf(__builtin_fmaxf((a),(b)),(c))
  #define GAPA(MF,A0,A1,A2,A3,W0,W1,PW) do{ MF; sacc+=A0; sacc+=A1; sacc+=A2; sacc+=A3; PIN(sacc); W0; W1; PIN(PW); SBAR(); }while(0)
  #define EX(v) __builtin_amdgcn_exp2f(v)
  #define GAPB(MF,X,B) do{ MF; X[B]=EX(X[B]); X[B+1]=EX(X[B+1]); X[B+2]=EX(X[B+2]); X[B+3]=EX(X[B+3]); PIN(X); SBAR(); }while(0)
  #define VRD(i) do{ vlo[i]=vtr(vp_+(((i)>>2)*4096+((i)&3)*1024)); vhi[i]=vtr(vp_+(((i)>>2)*4096+((i)&3)*1024+512)); }while(0)
  #define KRD(G,j) do{ if(G){ kload2(kf,kp0+sl_next,j); SBAR(); } }while(0)
  #define STEP(C0,C1,P0,P1,t,GK,GV,GL,MC,MN,GM) do{ SBAR(); \
    if(GM){mload(MN,mrow+(long)((t)+1)*SEQ);} \
    cinit(C0,C1,MC,hi,-mhat); SBAR(); \
    const lds_cptr vp_=vp0+sl_prev; \
    VRD(0); SBAR(); float sacc=(P0[0]+P0[1]); \
    GAPA(C0=MFH(kf[0],qr[0],C0,0,0,0), P0[2],P0[3],P0[4],P0[5],     pw0[0]=PKW(P0,0), pw0[1]=PKW(P0,2), pw0); \
    VRD(4); SBAR(); GAPA(C1=MFH(kf[1],qr[0],C1,0,0,0), P0[6],P0[7],P0[8],P0[9],     pw0[2]=PKW(P0,4), pw0[3]=PKW(P0,6), pw0); \
    VRD(1); SBAR(); GAPA(C0=MFH(kf[2],qr[1],C0,0,0,0),   P0[10],P0[11],P0[12],P0[13], pw1[0]=PKW(P0,8), pw1[1]=PKW(P0,10), pw1); \
    VRD(5); SBAR(); GAPA(C1=MFH(kf[3],qr[1],C1,0,0,0),   P0[14],P0[15],P1[0],P1[1],   pw1[2]=PKW(P0,12),pw1[3]=PKW(P0,14), pw1); \
    VRD(2); SBAR(); GAPA(C0=MFH(kf[4],qr[2],C0,0,0,0),   P1[2],P1[3],P1[4],P1[5],     pw2[0]=PKW(P1,0), pw2[1]=PKW(P1,2), pw2); \
    VRD(6); SBAR(); GAPA(C1=MFH(kf[5],qr[2],C1,0,0,0),   P1[6],P1[7],P1[8],P1[9],     pw2[2]=PKW(P1,4), pw2[3]=PKW(P1,6), pw2); \
    VRD(3); SBAR(); GAPA(C0=MFH(kf[6],qr[3],C0,0,0,0),   P1[10],P1[11],P1[12],P1[13], pw3[0]=PKW(P1,8), pw3[1]=PKW(P1,10), pw3); \
    VRD(7); SBAR(); GAPA(C1=MFH(kf[7],qr[3],C1,0,0,0),   P1[14],P1[15],0.f,0.f,       pw3[2]=PKW(P1,12),pw3[3]=PKW(P1,14), pw3); \
    l_reg+=sacc; \
    if(GK){DMA_K((t)+3,sl_cur);} if(GV){DMA_V((t)+1,sl_next);} \
    { float a=MX3(C0[0],C0[1],C1[0]),b=MX3(C0[2],C0[3],C1[1]); a=MX3(a,C1[2],C1[3]); \
      _Pragma("unroll") for(int r=4;r<16;r+=4){a=MX3(a,C0[r],C0[r+1]);b=MX3(b,C0[r+2],C0[r+3]);a=MX3(a,C1[r],C1[r+1]);b=MX3(b,C1[r+2],C1[r+3]);} \
      float rm=__builtin_fmaxf(a,b); { auto rr=__builtin_amdgcn_permlane32_swap(__float_as_uint(rm),__float_as_uint(rm),false,false); rm=__builtin_fmaxf(__uint_as_float(rr[0]),__uint_as_float(rr[1])); } \
      resc=false; \
      if(__builtin_expect(__any(rm>(float)THRL),0)){ const float dl=__builtin_fmaxf(rm,0.f); mhat+=dl; \
        _Pragma("unroll") for(int r=0;r<16;++r){C0[r]-=dl;C1[r]-=dl;} \
        const float f=__builtin_amdgcn_exp2f(-dl); l_reg*=f; if(hi==0)wsf[r32]=f; resc=true; } } \
    SBAR(); \
    GAPB(o[0]=MFH(PAF(0),VFR(0),o[0],0,0,0), C0,0); \
    GAPB(o[1]=MFH(PAF(0),VFR(4),o[1],0,0,0), C0,4); \
    KRD(GL,0); GAPB(o[0]=MFH(PAF(1),VFR(1),o[0],0,0,0), C0,8); \
    KRD(GL,1); GAPB(o[1]=MFH(PAF(1),VFR(5),o[1],0,0,0), C0,12); \
    KRD(GL,2); GAPB(o[0]=MFH(PAF(2),VFR(2),o[0],0,0,0), C1,0); \
    KRD(GL,3); GAPB(o[1]=MFH(PAF(2),VFR(6),o[1],0,0,0), C1,4); \
    GAPB(o[0]=MFH(PAF(3),VFR(3),o[0],0,0,0), C1,8); \
    GAPB(o[1]=MFH(PAF(3),VFR(7),o[1],0,0,0), C1,12); \
    }while(0)
  int t=1;
  for(;t+5<NT;t+=2){
    STEP(pB0,pB1,pA0,pA1,t,true,true,true,mB,mA,true);     WAIT_BAR_M(2,mA); RESC(); ROT();
    STEP(pA0,pA1,pB0,pB1,t+1,true,true,true,mA,mB,true);   WAIT_BAR_M(2,mB); RESC(); ROT();
  }
  #define ENDW(tt,M) do{ if((tt)+3<NT){WAIT_BAR_M(2,M);} else if((tt)+2<NT){WAIT_BAR_M(1,M);} else {WAIT_BAR_M(0,M);} }while(0)
  for(;t+1<NT;t+=2){
    STEP(pB0,pB1,pA0,pA1,t,(t+3<NT),(t+1<NT),(t+1<NT),mB,mA,(t+1<NT));       ENDW(t,mA);   RESC(); ROT();
    STEP(pA0,pA1,pB0,pB1,t+1,(t+4<NT),(t+2<NT),(t+2<NT),mA,mB,(t+2<NT));     ENDW(t+1,mB); RESC(); ROT();
  }
  STEP(pB0,pB1,pA0,pA1,NT-1,false,false,false,mB,mA,false); RESC();
  { float sacc=pB0[0]+pB0[1]; _Pragma("unroll") for(int r=2;r<16;++r)sacc+=pB0[r]; _Pragma("unroll") for(int r=0;r<16;++r)sacc+=pB1[r]; l_reg+=sacc;
    pw0=(u32x4){PKW(pB0,0),PKW(pB0,2),PKW(pB0,4),PKW(pB0,6)};pw1=(u32x4){PKW(pB0,8),PKW(pB0,10),PKW(pB0,12),PKW(pB0,14)};pw2=(u32x4){PKW(pB1,0),PKW(pB1,2),PKW(pB1,4),PKW(pB1,6)};pw3=(u32x4){PKW(pB1,8),PKW(pB1,10),PKW(pB1,12),PKW(pB1,14)};
    SBAR(); pv(o,vb0+sl_cur,PAF(0),PAF(1),PAF(2),PAF(3)); }
  #undef PKW
  #undef PAF
  #undef VFR
  #undef PIN
  #undef MX3
  #undef GAPA
  #undef GAPB
  #undef EX
  #undef VRD
  #undef KRD
  #undef STEP
  #undef ENDW
  {auto rr=__builtin_amdgcn_permlane32_swap(__float_as_uint(l_reg),__float_as_uint(l_reg),false,false);l_reg=__uint_as_float(rr[0])+__uint_as_float(rr[1]);}
  if(hi==0)wsf[32+r32]=l_reg;asm volatile("s_waitcnt lgkmcnt(0)":::"memory");
  float rli[16];
  #pragma unroll
  for(int r=0;r<16;++r)rli[r]=__builtin_amdgcn_rcpf(wsf[32+crow(r,hi)]);
  bf16*Ow=O+(rowbase+q0+wid*QBLK)*DM+h*D;
  { bf16*stg=(bf16*)(shm+LDS_OST)+wid*2048;
    #pragma unroll
    for(int r=0;r<16;++r){const int orow=crow(r,hi);
      #pragma unroll
      for(int d0=0;d0<2;++d0)stg[orow*64+d0*32+r32]=(bf16)(o[d0][r]*rli[r]);}
    asm volatile("s_waitcnt lgkmcnt(0)":::"memory");
    #pragma unroll
    for(int i=0;i<4;++i){const int row=i*8+(lane>>3),ch=lane&7; const u32x4 v=*(const u32x4*)(stg+row*64+ch*8); ATTN_STORE16(Ow+(long)row*DM+ch*8,v);} }
  asm volatile("s_waitcnt lgkmcnt(0)\n\ts_barrier":::"memory");
  #undef DMA_K
  #undef DMA_V
  #undef START
  #undef RESC
  #undef ROT
}
constexpr int ATTN_LDS_BYTES=LDS_BYTES;
struct AttnTensors { const bf16* Q; const bf16* K; const bf16* V; bf16* O; const unsigned long long* Mk; };
struct AttnUnit { int bh; int qb; };
struct StaticOrder {
  int vcu,G;
  __device__ __forceinline__ explicit StaticOrder(int grid,int block):vcu((grid%8==0)?((block%8)*(grid/8)+block/8):block),G(grid){}
  __device__ __forceinline__ bool next(int i,AttnUnit&u)const{ const int v=vcu+G*(i>>1); if(v>=256)return false; const int s=v&15; u.bh=v>>4; u.qb=(i&1)?s:31-s; return true; }
};
template<class Sched,int THRL=8> __device__ __forceinline__ void attn_phase(char*lds,const AttnTensors&T,const Sched&S){
  AttnUnit u;
  for(int i=0;S.next(i,u);++i){ attn_unit<THRL>(u.bh/NHEAD,u.bh%NHEAD,u.qb,T.Q,T.K,T.V,T.O,T.Mk,lds); }
}
#undef SBAR
#undef WAIT_BAR
#undef WAIT_BAR_M
#undef WAIT_BAR_M2
#undef MFH
}

__device__ __forceinline__ float hgrn_lb(const Params& p, int idx) { const float l0 = p.lb_logits[idx], l1 = p.lb_logits[512 + idx]; return 1.f / (1.f + __expf(l1 - l0)); }

__device__ __forceinline__ void hgrn_stepA(const Params& p, int item, char* lds) {
    float* kd = (float*)lds;
    float* kk = kd + 64 * 128;
    float* vv = kk + 64 * 128;
    const h16* P = (const h16*)(p.ws + WS_P); float* ST = (float*)(p.ws + WS_X); float* G = (float*)(p.ws + WS_G);
    const int tid = threadIdx.x;
    const int c = item % NCH, bh = item / NCH, h = bh & 3, b = bh >> 2;
    const int L = c == 0 ? 16 : 64; const size_t rowbase = c == 0 ? (size_t)MREAL : (size_t)(b * S + (c - 1) * 64);
    for (int i = tid; i < L * 128; i += NT) { const int t = i >> 7, v = i & 127; vv[t * 128 + v] = (float)P[(rowbase + t) * NP2 + C_HI + h * 128 + v]; }
    if (tid < 128) {
        const int d = tid; const float lb = hgrn_lb(p, h * 128 + d);
        float bc = 0.f;
        for (int t = 0; t < L; ++t) {
            const float hf = (float)P[(rowbase + t) * NP2 + C_HF + h * 128 + d];
            const float f = lb + (1.f - lb) * sigmoidf_(hf);
            bc += logf(f); kd[t * 128 + d] = bc; kk[t * 128 + d] = 1.f - f;
        }
        for (int t = 0; t < L; ++t) kd[t * 128 + d] = kk[t * 128 + d] * __expf(bc - kd[t * 128 + d]);
        G[(size_t)item * 128 + d] = __expf(bc);
    }
    __syncthreads();
    const int d = tid & 127, vg = tid >> 7;
    float acc[32];
#pragma unroll
    for (int j = 0; j < 32; ++j) acc[j] = 0.f;
    for (int s = 0; s < L; ++s) {
        const float kv = kd[s * 128 + d];
#pragma unroll
        for (int j = 0; j < 32; j += 4) { const f32x4 v4 = *(const f32x4*)(vv + s * 128 + vg * 32 + j); acc[j] += kv * v4.x; acc[j + 1] += kv * v4.y; acc[j + 2] += kv * v4.z; acc[j + 3] += kv * v4.w; }
    }
    float* o = ST + (size_t)item * 16384 + d * 128 + vg * 32;
#pragma unroll
    for (int j = 0; j < 32; j += 4) *(f32x4*)(o + j) = (f32x4){acc[j], acc[j + 1], acc[j + 2], acc[j + 3]};
    __syncthreads();
}

__device__ __forceinline__ void hgrn_scan(const Params& p) {
    float* ST = (float*)(p.ws + WS_X); const float* G = (const float*)(p.ws + WS_G);
    for (int idx = blockIdx.x * NT + threadIdx.x; idx < NB * 4 * 16384; idx += gridDim.x * NT) {
        const int bh = idx >> 14, e = idx & 16383, d = e >> 7;
        float Sv = 0.f;
        for (int c = 0; c < NCH; ++c) {
            const size_t off = (size_t)(bh * NCH + c) * 16384 + e;
            const float u = ST[off]; const float g = G[(size_t)(bh * NCH + c) * 128 + d];
            ST[off] = Sv; Sv = g * Sv + u;
        }
    }
}

__device__ __forceinline__ void hgrn_stepC(const Params& p, int item, char* lds) {
    float* bq = (float*)lds;
    float* qq = bq + 64 * 65;
    float* kk = qq + 64 * 65;
    float* Am = kk + 64 * 65;
    float* qe = Am + 64 * 65;
    float* vv = qe + 64 * 128;
    h16* P = (h16*)(p.ws + WS_P); const float* ST = (const float*)(p.ws + WS_X);
    const int tid = threadIdx.x;
    const int c = 1 + item % 128, bh = item / 128, h = bh & 3, b = bh >> 2;
    const size_t rowbase = (size_t)(b * S + (c - 1) * 64);
    for (int i = tid; i < 64 * 128; i += NT) { const int t = i >> 7, v = i & 127; vv[t * 128 + v] = (float)P[(rowbase + t) * NP2 + C_HI + h * 128 + v]; }
    float aacc[8];
#pragma unroll
    for (int i = 0; i < 8; ++i) aacc[i] = 0.f;
    for (int half = 0; half < 2; ++half) {
        if (tid < 64) {
            const int d = half * 64 + tid; const float lb = hgrn_lb(p, h * 128 + d);
            float bc = 0.f;
            for (int t = 0; t < 64; ++t) {
                const float hf = (float)P[(rowbase + t) * NP2 + C_HF + h * 128 + d];
                const float f = lb + (1.f - lb) * sigmoidf_(hf);
                bc += logf(f); bq[t * 65 + tid] = bc; kk[t * 65 + tid] = 1.f - f;
            }
        }
        for (int i = tid; i < 64 * 64; i += NT) { const int t = i >> 6, dl = i & 63; qq[t * 65 + dl] = siluf_((float)P[(rowbase + t) * NP2 + C_HQ + h * 128 + half * 64 + dl]); }
        __syncthreads();
#pragma unroll
        for (int i = 0; i < 8; ++i) {
            const int pr = tid + NT * i, t = pr >> 6, s = pr & 63;
            if (s <= t) { float sum = 0.f;
                for (int dl = 0; dl < 64; ++dl) sum += qq[t * 65 + dl] * kk[s * 65 + dl] * __expf(bq[t * 65 + dl] - bq[s * 65 + dl]);
                aacc[i] += sum; }
        }
        for (int i = tid; i < 64 * 64; i += NT) { const int t = i >> 6, dl = i & 63; qe[t * 128 + half * 64 + dl] = qq[t * 65 + dl] * __expf(bq[t * 65 + dl]); }
        __syncthreads();
    }
#pragma unroll
    for (int i = 0; i < 8; ++i) { const int pr = tid + NT * i, t = pr >> 6, s = pr & 63; Am[t * 65 + s] = aacc[i]; }
    __syncthreads();
    const int v = tid & 127, tg = tid >> 7;
    float acc[16];
#pragma unroll
    for (int i = 0; i < 16; ++i) acc[i] = 0.f;
    for (int s = 0; s < 64; ++s) { const float vval = vv[s * 128 + v];
#pragma unroll
        for (int i = 0; i < 16; ++i) acc[i] += Am[(tg * 16 + i) * 65 + s] * vval; }
    const float* sp = ST + (size_t)(bh * NCH + c) * 16384 + v;
    for (int d = 0; d < 128; ++d) { const float sv = sp[d * 128];
#pragma unroll
        for (int i = 0; i < 16; ++i) acc[i] += qe[(tg * 16 + i) * 128 + d] * sv; }
#pragma unroll
    for (int i = 0; i < 16; ++i) P[(rowbase + tg * 16 + i) * NP2 + C_HQ + h * 128 + v] = (h16)acc[i];
    __syncthreads();
}

__device__ __forceinline__ void phase_mix(const Params& p) {
    const h16* P = (const h16*)(p.ws + WS_P); h16* MIX = (h16*)(p.ws + WS_X);
    const int lane = threadIdx.x & 63, wave = threadIdx.x >> 6;
    for (int row = blockIdx.x * 8 + wave; row < MREAL; row += gridDim.x * 8) {
        const h16* pr = P + (size_t)row * NP2; h16* o = MIX + (size_t)row * D; const h16* qo = (const h16*)(p.ws + WS_QB) + (size_t)row * 512;
        { const h16x8 a = *(const h16x8*)(qo + lane * 8); const h16x8 g = *(const h16x8*)(pr + C_AG + lane * 8);
          float ss = 0.f;
#pragma unroll
          for (int j = 0; j < 8; ++j) ss += (float)a[j] * (float)a[j];
          const float rs = rsqrtf(wave_sum(ss) * (1.f / 512.f) + 1e-6f);
          h16x8 ov;
#pragma unroll
          for (int j = 0; j < 8; ++j) ov[j] = (h16)((float)a[j] * rs * p.attn_norm[lane * 8 + j] * siluf_((float)g[j]));
          *(h16x8*)(o + lane * 8) = ov; }
        { const h16x8 a = *(const h16x8*)(pr + C_HQ + lane * 8); const h16x8 g = *(const h16x8*)(pr + C_HG + lane * 8);
          float ss = 0.f;
#pragma unroll
          for (int j = 0; j < 8; ++j) ss += (float)a[j] * (float)a[j];
#pragma unroll
          for (int o2 = 1; o2 < 16; o2 <<= 1) ss += __shfl_xor(ss, o2);
          const float rs = rsqrtf(ss * (1.f / 128.f) + 1e-6f);
          h16x8 ov;
#pragma unroll
          for (int j = 0; j < 8; ++j) ov[j] = (h16)((float)a[j] * rs * p.hgrn_norm[(lane & 15) * 8 + j] * siluf_((float)g[j]));
          *(h16x8*)(o + 512 + lane * 8) = ov; }
    }
}

__device__ __forceinline__ void phase_final(const Params& p) {
    const int lane = threadIdx.x & 63, wave = threadIdx.x >> 6;
    for (int row = blockIdx.x * 8 + wave; row < MREAL; row += gridDim.x * 8) {
        float* o = p.out + (size_t)row * D;
        f32x4 v[4]; float ss = 0.f;
        for (int j = 0; j < 4; ++j) { v[j] = *(const f32x4*)(o + (lane + 64 * j) * 4); ss += v[j].x * v[j].x + v[j].y * v[j].y + v[j].z * v[j].z + v[j].w * v[j].w; }
        const float rs = rsqrtf(wave_sum(ss) * (1.f / D) + 1e-6f);
        for (int j = 0; j < 4; ++j) { const f32x4 g = *(const f32x4*)(p.final_norm + (lane + 64 * j) * 4);
            *(f32x4*)(o + (lane + 64 * j) * 4) = (f32x4){v[j].x * rs * g.x, v[j].y * rs * g.y, v[j].z * rs * g.z, v[j].w * rs * g.w}; }
    }
}

#define LAS __attribute__((address_space(3)))
#define XB_TMO      128
#define XB_XCNT(j)  (256  + 64 * (j))
#define XB_XSUB(j)  (1280 + 64 * (j))
#define XB_XGEN(j)  (2304 + 64 * (j))
#define XB_TOP      3328
#define XB_TOPGEN   3392
#define XCD_BAR_WORDS 3456
#define XB_SPIN_CAP (1u << 18)

__device__ __forceinline__ unsigned xb_ld(unsigned* p)              { return __hip_atomic_load(p, __ATOMIC_RELAXED, __HIP_MEMORY_SCOPE_AGENT); }
__device__ __forceinline__ unsigned xb_add(unsigned* p, unsigned v) { return __hip_atomic_fetch_add(p, v, __ATOMIC_RELAXED, __HIP_MEMORY_SCOPE_AGENT); }
__device__ __forceinline__ unsigned xb_xcc_id() { return (unsigned)__builtin_amdgcn_s_getreg((3 << 11) | 20) & 0xFu; }
#define XB_SPIN(cond, bar) do { unsigned _sp = 0; while (cond) { __builtin_amdgcn_s_sleep(1); \
    if ((++_sp & 255u) == 0u) { if (xb_ld(&(bar)[XB_TMO])) break; if (_sp > XB_SPIN_CAP) { atomicAdd(&(bar)[XB_TMO], 1u); break; } } } } while (0)

struct XcdBarrier {
    unsigned* bar; unsigned x;
    volatile LAS unsigned* st;
};

__device__ __forceinline__ XcdBarrier xcd_barrier_post(unsigned* bar, volatile LAS unsigned* st) {
    XcdBarrier b; b.bar = bar; b.x = xb_xcc_id(); b.st = st;
    if (threadIdx.x == 0) (void)xb_add(&bar[XB_XCNT(b.x)], 1u);
    return b;
}
__device__ __forceinline__ void xcd_barrier_complete(unsigned* bar, unsigned x, unsigned& nloc, unsigned& nx) {
    const unsigned G = gridDim.x * gridDim.y * gridDim.z;
    unsigned sum, cnt, mine, sp = 0u;
    for (;;) {
        sum = 0u; cnt = 0u; mine = 0u;
#pragma unroll
        for (unsigned j = 0; j < 16; ++j) { const unsigned c = xb_ld(&bar[XB_XCNT(j)]); sum += c; cnt += (c > 0u) ? 1u : 0u; mine = (j == x) ? c : mine; }
        if (sum == G) break;
        __builtin_amdgcn_s_sleep(1);
        if ((++sp & 255u) == 0u) { if (xb_ld(&bar[XB_TMO])) break; if (sp > XB_SPIN_CAP) { atomicAdd(&bar[XB_TMO], 1u); break; } }
    }
    nloc = mine > 0u ? mine : 1u; nx = cnt > 0u ? cnt : 1u;
}

__device__ __forceinline__ void xcd_barrier(const XcdBarrier& b) {
    asm volatile("s_waitcnt vmcnt(0)" ::: "memory");
    __syncthreads();
    if (threadIdx.x == 0) {
        unsigned* bar = b.bar;
        __builtin_amdgcn_s_waitcnt(0);
        unsigned nloc = b.st[0], nx = b.st[1];
        if (nloc == 0u) { xcd_barrier_complete(bar, b.x, nloc, nx); b.st[0] = nloc; b.st[1] = nx; }
        const unsigned old = xb_add(&bar[XB_XSUB(b.x)], 1u);
        const unsigned gen = old / nloc;
        if (old + 1u == (gen + 1u) * nloc) {
            __builtin_amdgcn_fence(__ATOMIC_RELEASE, "agent");
            asm volatile("s_waitcnt vmcnt(0)" ::: "memory");
            const unsigned og = xb_add(&bar[XB_TOP], 1u);
            const unsigned tg = og / nx;
            if (og + 1u == (tg + 1u) * nx) xb_add(&bar[XB_TOPGEN], 1u);
            else XB_SPIN(xb_ld(&bar[XB_TOPGEN]) == tg, bar);
            __builtin_amdgcn_fence(__ATOMIC_ACQUIRE, "agent");
            xb_add(&bar[XB_XGEN(b.x)], 1u);
            asm volatile("s_waitcnt vmcnt(0)" ::: "memory");
        } else {
            XB_SPIN(xb_ld(&bar[XB_XGEN(b.x)]) == gen, bar);
            __builtin_amdgcn_fence(__ATOMIC_ACQUIRE, "agent");
            asm volatile("s_waitcnt vmcnt(0)" ::: "memory");
        }
    }
    __syncthreads();
}


constexpr int NPHASE = 9;
__global__ void __launch_bounds__(NT, 2) mega(Params p, int ph_lo, int ph_hi) {
    extern __shared__ __attribute__((aligned(16))) char lds[];
    cg::grid_group grid = cg::this_grid();
    volatile LAS unsigned* xst = (volatile LAS unsigned*)(LAS char*)(lds + LDS_BYTES - 16);
    if (threadIdx.x < 4) xst[threadIdx.x] = 0u;
    __syncthreads();
    XcdBarrier xbar = xcd_barrier_post((unsigned*)p.ws, xst);
#define IN(k) (ph_lo <= (k) && (k) < ph_hi)
#define SYNC(k) do { if ((k) + 1 < ph_hi) { if ((k) == 0) grid.sync(); else xcd_barrier(xbar); } } while (0)
    if (IN(0)) { phase_prep(p, lds); if (PROBE == 4) phase_prep(p, lds); SYNC(0); }
    if (PROBE == 2) { for (int i = 0; i < 8; ++i) xcd_barrier(xbar); }
    if (IN(1)) { phase_gemm_in(p, lds); if (PROBE == 1) phase_gemm_in(p, lds); SYNC(1); }
    if (IN(2)) { phase_post(p); SYNC(2); }
    if (IN(3)) {
        constexpr int NA = NB * 4 * NCH;
        for (int rep = 0; rep < ((PROBE == 3 || PROBE == 12) ? 2 : 1); ++rep)
        for (int it = blockIdx.x; it < 512; it += gridDim.x) { const int uu = it < 256 ? 255 - (it >> 1) : (it - 256) >> 1; idx_unit(p, it & 1, uu, lds, (PROBE == 12 && rep == 1) ? 1 : 0); }
        for (int rep = 0; rep < (PROBE == 5 ? 2 : 1); ++rep)
        for (int it = blockIdx.x; it < NA; it += gridDim.x) hgrn_stepA(p, it, lds);
        SYNC(3);
    }
    if (IN(4)) { hgrn_scan(p); SYNC(4); }
    if (IN(5)) {
        constexpr int NC = NB * 4 * 128;
        for (int it = blockIdx.x; it < NC; it += gridDim.x) hgrn_stepC(p, it, lds);
        {
            const attn_body::AttnTensors AT{(const h16*)(p.ws + WS_QB), (const h16*)(p.ws + WS_KB), (const h16*)(p.ws + WS_VB), (h16*)(p.ws + WS_QB), (const unsigned long long*)p.out};
            const attn_body::StaticOrder SO((int)gridDim.x, (int)blockIdx.x);
            attn_body::attn_phase<attn_body::StaticOrder>(lds, AT, SO);
        }
        SYNC(5);
    }
    if (IN(6)) { phase_mix(p); if (PROBE == 6) phase_mix(p); SYNC(6); }
    if (IN(7)) { phase_gemm_out(p, lds); if (PROBE == 7) phase_gemm_out(p, lds); SYNC(7); }
    if (IN(8)) { phase_final(p); }
#undef IN
#undef SYNC
}

extern "C" void kernel_launch(void* const* d_in, const int* in_sizes, int n_in, void* d_out, int out_size, void* d_ws, size_t ws_size, hipStream_t stream) {
    static int grid = 0;
    if (grid == 0) {
        if (n_in != 11 || ws_size < WS_END || out_size != MREAL * D) { fprintf(stderr, "kernel_launch: unexpected shapes n_in %d ws %zu out %d\n", n_in, ws_size, out_size); grid = -1; return; }
        int dev = 0, cus = 0, per_cu = 0;
        hipGetDevice(&dev); hipDeviceGetAttribute(&cus, hipDeviceAttributeMultiprocessorCount, dev);
        hipFuncSetAttribute((const void*)mega, hipFuncAttributeMaxDynamicSharedMemorySize, LDS_BYTES);
        hipOccupancyMaxActiveBlocksPerMultiprocessor(&per_cu, (const void*)mega, NT, LDS_BYTES);
        if (per_cu < 1) { fprintf(stderr, "kernel_launch: occupancy query says %d\n", per_cu); per_cu = 1; }
        grid = cus * 1;
        (void)hipGetLastError();
    }
    if (grid < 0) return;
    Params p{};
    p.x = (const float*)d_in[0]; p.meta = (const float*)d_in[1]; p.mix_norm = (const float*)d_in[2]; p.w_in = (const float*)d_in[3];
    p.idx_g = (const float*)d_in[4]; p.idx_b = (const float*)d_in[5]; p.attn_norm = (const float*)d_in[6]; p.lb_logits = (const float*)d_in[7];
    p.hgrn_norm = (const float*)d_in[8]; p.w_out = (const float*)d_in[9]; p.final_norm = (const float*)d_in[10];
    p.out = (float*)d_out; p.ws = (unsigned char*)d_ws;
    hipMemsetAsync(d_ws, 0, 16384, stream);
#if N_LAUNCH_MODE == 1
    int lo = 0, hi = NPHASE; void* args[] = {&p, &lo, &hi};
    hipError_t e = hipLaunchCooperativeKernel((const void*)mega, dim3(grid), dim3(NT), args, LDS_BYTES, stream);
    if (e != hipSuccess) fprintf(stderr, "cooperative launch failed: %s (grid %d)\n", hipGetErrorString(e), grid);
#else
    for (int ph = 0; ph < NPHASE; ++ph) hipLaunchKernelGGL(mega, dim3(grid), dim3(NT), LDS_BYTES, stream, p, ph, ph + 1);
#endif
}
```

```cpp
#include <hip/hip_runtime.h>
#include <hip/hip_cooperative_groups.h>
#include <cstdint>
#include <cstdio>
namespace cg = cooperative_groups;

typedef _Float16 h16;
typedef _Float16 h16x8 __attribute__((ext_vector_type(8)));
typedef _Float16 h16x4 __attribute__((ext_vector_type(4)));
typedef float f32x4 __attribute__((ext_vector_type(4)));

#ifndef PROBE
#define PROBE 0
#endif
#ifndef N_LAUNCH_MODE
#define N_LAUNCH_MODE 1
#endif

constexpr int NB = 2, S = 8192, NMETA = 16, D = 1024;
constexpr int MREAL = NB * S;
constexpr int MROWS = MREAL + NMETA;
constexpr int MPAD = 16640;
constexpr int NCOL = 4680, NPAD = 4864;
constexpr int G_IK = 4608;
constexpr int NP2 = 3328;
constexpr int C_AG = 0, C_IQ = 512, C_HQ = 1024, C_HF = 1536, C_HI = 2048, C_HG = 2560, C_IK = 3072, C_IW = 3136;
constexpr int KVROWS = 8320;
constexpr int NCH = 129;
constexpr int NT = 512;

constexpr size_t MiB = 1u << 20;
constexpr size_t WS_WTIN = 1 * MiB, WS_WTOUT = 11 * MiB, WS_ROPE = 13 * MiB, WS_E = 14 * MiB, WS_KI = 23 * MiB, WS_G = 26 * MiB, WS_P = 27 * MiB, WS_QB = 133 * MiB, WS_KB = 149 * MiB, WS_VB = 166 * MiB, WS_X = 190 * MiB, WS_END = 256 * MiB;
static_assert(WS_P + (size_t)MPAD * NP2 * 2 <= WS_QB && WS_QB + (size_t)MREAL * 512 * 2 <= WS_KB && WS_KB + (size_t)NB * KVROWS * 512 * 2 <= WS_VB && WS_VB + (size_t)NB * KVROWS * 512 * 2 <= WS_X, "ws map");
static_assert(WS_X + (size_t)NB * 4 * NCH * 16384 * 4 <= WS_END, "ST");

constexpr int LDS_BYTES = 140 * 1024;

struct Params {
    const float *x, *meta, *mix_norm, *w_in, *idx_g, *idx_b, *attn_norm, *lb_logits, *hgrn_norm, *w_out, *final_norm;
    float* out; unsigned char* ws;
};

__device__ __forceinline__ float wave_sum(float v) {
#pragma unroll
    for (int o = 1; o < 64; o <<= 1) v += __shfl_xor(v, o);
    return v;
}
__device__ __forceinline__ float wave_max(float v) {
#pragma unroll
    for (int o = 1; o < 64; o <<= 1) v = fmaxf(v, __shfl_xor(v, o));
    return v;
}
__device__ __forceinline__ float sigmoidf_(float x) { return 1.f / (1.f + __expf(-x)); }
__device__ __forceinline__ float siluf_(float x) { return x * sigmoidf_(x); }
__device__ __forceinline__ int oldcol(int n) { return n < 2560 ? n : (n < 4608 ? n + 72 : (n < 4672 ? 2560 + (n - 4608) : 2624 + (n - 4672))); }
__device__ __forceinline__ unsigned skey(float x) { if (x == 0.f) x = 0.f; unsigned u = __float_as_uint(x); return (u & 0x80000000u) ? ~u : (u | 0x80000000u); }

__device__ __forceinline__ void transpose_item(const float* __restrict__ W, int ldw, int nvalid, bool remap, h16* __restrict__ WT, int K, int item, float* tile) {
    constexpr float C2 = 0.125f * 1.4426950408889634f;
    const int nkt = K / 64, nb = item / nkt, kb = item % nkt, n0 = nb * 64, k0 = kb * 64, tid = threadIdx.x;
    {
        const int nl = tid & 63, kl = tid >> 6, n = n0 + nl;
        int src = -1; if (n < nvalid) src = remap ? oldcol(n) : n;
        const float scl = (remap && n < 512) ? C2 : 1.f;
        for (int kk = kl; kk < 64; kk += 8) tile[kk * 65 + nl] = (src >= 0) ? W[(size_t)(k0 + kk) * ldw + src] * scl : 0.f;
    }
    __syncthreads();
    {
        const int kl = tid & 63, nl = tid >> 6;
        for (int nn = nl; nn < 64; nn += 8) WT[(size_t)(n0 + nn) * K + k0 + kl] = (h16)tile[kl * 65 + nn];
    }
    __syncthreads();
}

__device__ __forceinline__ void phase_prep(const Params& p, char* lds) {
    float* tile = (float*)lds;
    h16* WTin = (h16*)(p.ws + WS_WTIN); h16* WTout = (h16*)(p.ws + WS_WTOUT);
    constexpr int I_IN = (NPAD / 64) * (D / 64), I_OUT = (D / 64) * (D / 64);
    for (int it = blockIdx.x; it < I_IN + I_OUT; it += gridDim.x) {
        if (it < I_IN) transpose_item(p.w_in, NCOL, NCOL, true, WTin, D, it, tile);
        else transpose_item(p.w_out, D, D, false, WTout, D, it - I_IN, tile);
    }
    h16* HN = (h16*)(p.ws + WS_X);
    const int lane = threadIdx.x & 63, wave = threadIdx.x >> 6;
    for (int row = blockIdx.x * 8 + wave; row < MPAD; row += gridDim.x * 8) {
        h16* o = HN + (size_t)row * D;
        if (row >= MROWS) {
            for (int j = 0; j < 4; ++j) { h16x4 z = {(h16)0.f, (h16)0.f, (h16)0.f, (h16)0.f}; *(h16x4*)(o + (lane + 64 * j) * 4) = z; }
            continue;
        }
        const float* src = row < MREAL ? p.x + (size_t)row * D : p.meta + (size_t)(row - MREAL) * D;
        f32x4 v[4]; float ss = 0.f;
        for (int j = 0; j < 4; ++j) { v[j] = *(const f32x4*)(src + (lane + 64 * j) * 4); ss += v[j].x * v[j].x + v[j].y * v[j].y + v[j].z * v[j].z + v[j].w * v[j].w; }
        const float rs = rsqrtf(wave_sum(ss) * (1.f / D) + 1e-6f);
        for (int j = 0; j < 4; ++j) {
            const f32x4 g = *(const f32x4*)(p.mix_norm + (lane + 64 * j) * 4);
            h16x4 hv = {(h16)(v[j].x * rs * g.x), (h16)(v[j].y * rs * g.y), (h16)(v[j].z * rs * g.z), (h16)(v[j].w * rs * g.w)};
            *(h16x4*)(o + (lane + 64 * j) * 4) = hv;
        }
    }
    {
        h16* KB = (h16*)(p.ws + WS_KB); h16* VB = (h16*)(p.ws + WS_VB);
        for (int idx = blockIdx.x * NT + threadIdx.x; idx < NB * 112 * 64; idx += gridDim.x * NT) {
            const int c = idx & 63, rr = (idx >> 6) % 112, b = idx / (112 * 64);
            const int row = b * KVROWS + (rr < 48 ? 16 + rr : 8256 + (rr - 48));
            const h16x8 z = {(h16)0.f, (h16)0.f, (h16)0.f, (h16)0.f, (h16)0.f, (h16)0.f, (h16)0.f, (h16)0.f};
            *(h16x8*)(KB + (size_t)row * 512 + c * 8) = z; *(h16x8*)(VB + (size_t)row * 512 + c * 8) = z;
        }
    }
    float* ROPE = (float*)(p.ws + WS_ROPE);
    const double inv[8] = {1.0, 0.1939227432012558, 0.03760603070259094, 0.007292664609849453, 0.0014142135623842478, 0.00027424818836152554, 5.3182957344688475e-05, 1.0313385246263351e-05};
    for (int idx = blockIdx.x * NT + threadIdx.x; idx < (S + NMETA) * 8; idx += gridDim.x * NT) {
        const int t = idx >> 3, i = idx & 7;
        double iv = inv[0];
        if (i == 1) iv = inv[1]; else if (i == 2) iv = inv[2]; else if (i == 3) iv = inv[3]; else if (i == 4) iv = inv[4]; else if (i == 5) iv = inv[5]; else if (i == 6) iv = inv[6]; else if (i == 7) iv = inv[7];
        const double rev = (double)t * iv * 0.15915494309189535;
        const float fr = (float)(rev - __builtin_rint(rev));
        ROPE[idx * 2] = __builtin_amdgcn_cosf(fr); ROPE[idx * 2 + 1] = __builtin_amdgcn_sinf(fr);
    }
}

namespace pg8 {
#define PG8_LAS __attribute__((address_space(3)))
typedef unsigned short bf16_t;
typedef short bf16x8 __attribute__((ext_vector_type(8)));
typedef unsigned u32x4 __attribute__((ext_vector_type(4)));
constexpr int BM = 256, BK = 64, HALF = 128, HTB = HALF * BK * 2  , STAGE_BYTES = 8 * HTB, NXCD = 8, WGM = 8;

__host__ __device__ __forceinline__ int lds_byte(int r, int c) { const int st = (r >> 4) * 2 + (c >> 5), rr = r & 15, cc = c & 31, ob = rr * 64 + cc * 2; return st * 1024 + (ob ^ (((ob >> 9) & 1) << 5)); }
__host__ __device__ __forceinline__ void stage_rc(int b, int& R, int& C) { const int st = b / 1024, sb = b % 1024, swz = sb ^ (((sb >> 9) & 1) << 5); R = (st >> 1) * 16 + swz / 64; C = (st & 1) * 32 + (swz % 64) / 2; }
__host__ __device__ __forceinline__ int perm32(int rho) { const int n = rho >> 4, i = rho & 15; return 8 * (i >> 2) + 4 * n + (i & 3); }

struct Unit { int pm, pn; };
struct Gemm { const bf16_t* A; const bf16_t* Bt; int M, N, K; };

struct StaticOrder {
    int nM, nN, nwg, G, c;
    __host__ __device__ void init(int M, int N, int G_, int c_) { nM = M / BM; nN = N / BM; nwg = nM * nN; G = G_; c = c_; }
    __host__ __device__ bool next(int i, Unit& u) const {
        const long L = (long)i * G + c; if (L >= nwg) return false;
        int wgid = (int)L; { const int q = nwg / NXCD, r = nwg % NXCD, xcd = wgid % NXCD, off = wgid / NXCD; wgid = (xcd < r ? xcd * (q + 1) : r * (q + 1) + (xcd - r) * q) + off; }
        const int nig = WGM * nN, gid = wgid / nig, fm = gid * WGM, gsz = (nM - fm) < WGM ? (nM - fm) : WGM;
        u.pm = fm + ((wgid % nig) % gsz); u.pn = (wgid % nig) / gsz; return true;
    }
    __device__ __forceinline__ void a_ready(const Unit&) const {}
    __device__ __forceinline__ void done(const Unit&) const {}
};


struct EpiProj {
    static constexpr bool PERM = true, AFTER_DRAIN = false;
    unsigned char* ws;
    __device__ __forceinline__ void operator()(const f32x4 (&acc)[2][2][4][2], const Unit& u, int wr, int wc, int fr, int fq) const {
        const int row0 = u.pm * BM + wr * 64 + fr, colt = u.pn * BM + wc * 32 + 8 * fq;
#pragma unroll
        for (int ai = 0; ai < 2; ++ai)
#pragma unroll
            for (int m = 0; m < 4; ++m) {
                const int grow = row0 + ai * HALF + m * 16;
#pragma unroll
                for (int bj = 0; bj < 2; ++bj) {
                    const int gcol = colt + bj * HALF;
                    const f32x4 v0 = acc[ai][bj][m][0], v1 = acc[ai][bj][m][1];
                    const h16x8 hv = {(h16)v0[0], (h16)v0[1], (h16)v0[2], (h16)v0[3], (h16)v1[0], (h16)v1[1], (h16)v1[2], (h16)v1[3]};
                    if (gcol < 512) { if (grow < MREAL) *(h16x8*)((h16*)(ws + WS_QB) + (size_t)grow * 512 + gcol) = hv; }
                    else if (gcol < 1536) {
                        h16* dst = (h16*)(ws + (gcol < 1024 ? WS_KB : WS_VB)); const int cc = (gcol - 512) & 511;
                        if (grow < MREAL) *(h16x8*)(dst + ((size_t)(grow >> 13) * KVROWS + 64 + (grow & (S - 1))) * 512 + cc) = hv;
                        else if (grow < MROWS) { *(h16x8*)(dst + (size_t)(grow - MREAL) * 512 + cc) = hv; *(h16x8*)(dst + ((size_t)KVROWS + (grow - MREAL)) * 512 + cc) = hv; }
                    } else {
                        *(h16x8*)((h16*)(ws + WS_P) + (size_t)grow * NP2 + (gcol - 1536)) = hv;
                        if (gcol >= G_IK && gcol < G_IK + 128) { float* e = (float*)(ws + WS_E) + (size_t)grow * 128 + (gcol - G_IK); *(f32x4*)e = v0; *(f32x4*)(e + 4) = v1; }
                    }
                }
            }
    }
};
struct EpiOut {
    static constexpr bool PERM = false, AFTER_DRAIN = false;
    const float* x; float* out;
    __device__ __forceinline__ void operator()(const f32x4 (&acc)[2][2][4][2], const Unit& u, int wr, int wc, int fr, int fq) const {
        const int row0 = u.pm * BM + wr * 64 + fr, col0 = u.pn * BM + wc * 32 + 4 * fq;
#pragma unroll
        for (int ai = 0; ai < 2; ++ai)
#pragma unroll
            for (int m = 0; m < 4; ++m) {
                const size_t off = (size_t)(row0 + ai * HALF + m * 16) * D + col0;
#pragma unroll
                for (int bj = 0; bj < 2; ++bj)
#pragma unroll
                    for (int n = 0; n < 2; ++n) { const f32x4 xv = *(const f32x4*)(x + off + bj * HALF + n * 16); *(f32x4*)(out + off + bj * HALF + n * 16) = xv + acc[ai][bj][m][n]; }
            }
    }
};
template <class Epi, class Sched, bool ALIGN_EPI = false, bool SP2 = false>
__device__ __forceinline__ void gemm_phase(PG8_LAS unsigned char* lds, const Gemm g, const Sched& S, const Epi& E) {
    const int tid = threadIdx.x, wid = __builtin_amdgcn_readfirstlane(tid >> 6), lane = tid & 63, wr = wid >> 2, wc = wid & 3, fr = lane & 15, fq = lane >> 4;
    const int K = g.K, nt = K / BK;
    unsigned voffA[2], voffB[2];
#pragma unroll
    for (int i = 0; i < 2; ++i) { int R, C; stage_rc(tid * 16 + i * 8192, R, C); const int Rb = Epi::PERM ? ((R & ~31) + perm32(R & 31)) : R;
        voffA[i] = (unsigned)(R * K + C) * 2u; voffB[i] = (unsigned)(Rb * K + C) * 2u; }
    const size_t kstep = (size_t)(BK * 2);
    const size_t hstep = (size_t)HALF * K * 2;
    const size_t tstep = 2 * hstep;
    const unsigned ldsw = (unsigned)wid * 1024u;
    const int aoff = lds_byte(wr * 64 + fr, fq * 8), boff = lds_byte(wc * 32 + fr, fq * 8);
#define PG8_SA(b, h) (((b) * 2 + (h)) * HTB)
#define PG8_SB(b, h) ((4 + (b) * 2 + (h)) * HTB)
#define PG8_STAGE(bufoff, gbase, voff) do { _Pragma("unroll") for (int _i = 0; _i < 2; ++_i) \
        __builtin_amdgcn_global_load_lds((const unsigned*)((const char*)(gbase) + (voff)[_i]), (PG8_LAS unsigned*)(lds + (bufoff) + ldsw + _i * 8192), 16, 0, 0); } while (0)
#define PG8_LDA(dst, b, h) do { _Pragma("unroll") for (int m = 0; m < 4; ++m) _Pragma("unroll") for (int k = 0; k < 2; ++k) dst[m][k] = *(const PG8_LAS bf16x8*)(lds + PG8_SA(b, h) + aoff + m * 2048 + k * 1024); } while (0)
#define PG8_LDB(dst, b, h) do { _Pragma("unroll") for (int n = 0; n < 2; ++n) _Pragma("unroll") for (int k = 0; k < 2; ++k) dst[n][k] = *(const PG8_LAS bf16x8*)(lds + PG8_SB(b, h) + boff + n * 2048 + k * 1024); } while (0)
#define PG8_MMA(ai, bj, At, Bt) do { __builtin_amdgcn_s_setprio(1); _Pragma("unroll") for (int m = 0; m < 4; ++m) _Pragma("unroll") for (int n = 0; n < 2; ++n) _Pragma("unroll") for (int k = 0; k < 2; ++k) \
        acc[ai][bj][m][n] = __builtin_amdgcn_mfma_f32_16x16x32_f16(__builtin_bit_cast(h16x8, Bt[n][k]), __builtin_bit_cast(h16x8, At[m][k]), acc[ai][bj][m][n], 0, 0, 0); __builtin_amdgcn_s_setprio(0); } while (0)
#define PG8_WAIT_V(n) asm volatile("s_waitcnt vmcnt(" #n ")" ::: "memory")
#define PG8_WAIT_L(n) asm volatile("s_waitcnt lgkmcnt(" #n ")" ::: "memory")
#define PG8_BAR __builtin_amdgcn_s_barrier()
#define PG8_SCHED __builtin_amdgcn_sched_barrier(0)
    Unit cur, nxt; int ui = 0;
    if (!S.next(0, cur)) return;
    f32x4 acc[2][2][4][2];
#pragma unroll
    for (int a = 0; a < 2; ++a)
#pragma unroll
        for (int b = 0; b < 2; ++b)
#pragma unroll
            for (int m = 0; m < 4; ++m)
#pragma unroll
                for (int n = 0; n < 2; ++n) acc[a][b][m][n] = (f32x4){0.f, 0.f, 0.f, 0.f};
    bf16x8 At[4][2], B0[2][2], B1[2][2];
    const char* cA = (const char*)g.A + (size_t)cur.pm * tstep; const char* cB = (const char*)g.Bt + (size_t)cur.pn * tstep;
    S.a_ready(cur);
    if constexpr (SP2) {
        PG8_STAGE(PG8_SB(0, 0), cB, voffB); PG8_STAGE(PG8_SB(0, 1), cB + hstep, voffB); PG8_STAGE(PG8_SA(0, 0), cA, voffA); PG8_STAGE(PG8_SA(0, 1), cA + hstep, voffA);
        if (wr == 1) PG8_BAR;
        PG8_WAIT_V(2); PG8_BAR;
        PG8_STAGE(PG8_SB(1, 0), cB + kstep, voffB); PG8_STAGE(PG8_SA(1, 0), cA + kstep, voffA); PG8_STAGE(PG8_SB(1, 1), cB + hstep + kstep, voffB);
        PG8_WAIT_V(6); PG8_BAR;
    } else {
        PG8_STAGE(PG8_SB(0, 0), cB, voffB); PG8_STAGE(PG8_SA(0, 0), cA, voffA); PG8_STAGE(PG8_SB(0, 1), cB + hstep, voffB); PG8_STAGE(PG8_SA(0, 1), cA + hstep, voffA);
        if (wr == 1) PG8_BAR;
        PG8_WAIT_V(4); PG8_BAR;
        PG8_STAGE(PG8_SB(1, 0), cB + kstep, voffB); PG8_STAGE(PG8_SA(1, 0), cA + kstep, voffA); PG8_STAGE(PG8_SB(1, 1), cB + hstep + kstep, voffB);
        PG8_WAIT_V(6); PG8_BAR;
    }
    for (;;) {
        const bool has_next = S.next(ui + 1, nxt);
        const char* nA = has_next ? (const char*)g.A + (size_t)nxt.pm * tstep : cA; const char* nB = has_next ? (const char*)g.Bt + (size_t)nxt.pn * tstep : cB;
        for (int t = 0; t < nt; t += 2) {
            const bool last = (t == nt - 2);
            const char* a1 = cA + (size_t)(t + 1) * kstep;
            const char* a2 = last ? nA : cA + (size_t)(t + 2) * kstep; const char* b2 = last ? nB : cB + (size_t)(t + 2) * kstep;
            const char* a3 = a2 + kstep; const char* b3 = b2 + kstep;
            if (last && has_next) S.a_ready(nxt);
            if constexpr (SP2) {
            PG8_LDB(B0, 0, 0); PG8_LDB(B1, 0, 1); PG8_SCHED; PG8_LDA(At, 0, 0); PG8_STAGE(PG8_SA(1, 1), a1 + hstep, voffA);
            PG8_WAIT_V(8); PG8_WAIT_L(0); PG8_BAR; PG8_MMA(0, 0, At, B0); PG8_MMA(0, 1, At, B1); PG8_BAR; PG8_SCHED;
            PG8_LDA(At, 0, 1); PG8_STAGE(PG8_SB(0, 0), b2, voffB); PG8_STAGE(PG8_SB(0, 1), b2 + hstep, voffB); PG8_STAGE(PG8_SA(0, 0), a2, voffA);
            PG8_WAIT_V(8); PG8_WAIT_L(0); PG8_BAR; PG8_MMA(1, 0, At, B0); PG8_MMA(1, 1, At, B1); PG8_BAR; PG8_SCHED;
            PG8_LDB(B0, 1, 0); PG8_LDB(B1, 1, 1); PG8_SCHED; PG8_LDA(At, 1, 0); PG8_STAGE(PG8_SA(0, 1), a2 + hstep, voffA);
            PG8_WAIT_V(8); PG8_WAIT_L(0); PG8_BAR; PG8_MMA(0, 0, At, B0); PG8_MMA(0, 1, At, B1); PG8_BAR; PG8_SCHED;
            PG8_LDA(At, 1, 1); PG8_STAGE(PG8_SB(1, 0), b3, voffB); PG8_STAGE(PG8_SB(1, 1), b3 + hstep, voffB); PG8_STAGE(PG8_SA(1, 0), a3, voffA);
            PG8_WAIT_V(8); PG8_WAIT_L(0); PG8_BAR; PG8_MMA(1, 0, At, B0); PG8_MMA(1, 1, At, B1); PG8_BAR; PG8_SCHED;
            } else {
            PG8_LDB(B0, 0, 0); PG8_SCHED; PG8_LDA(At, 0, 0); PG8_STAGE(PG8_SA(1, 1), a1 + hstep, voffA);
            PG8_WAIT_L(8); PG8_BAR; PG8_WAIT_L(0); PG8_MMA(0, 0, At, B0); PG8_BAR; PG8_SCHED;
            PG8_LDB(B1, 0, 1); PG8_STAGE(PG8_SB(0, 0), b2, voffB);
            PG8_BAR; PG8_WAIT_L(0); PG8_MMA(0, 1, At, B1); PG8_BAR;
            PG8_LDA(At, 0, 1); PG8_STAGE(PG8_SA(0, 0), a2, voffA);
            PG8_BAR; PG8_WAIT_L(0); PG8_MMA(1, 0, At, B0); PG8_BAR; PG8_SCHED;
            PG8_STAGE(PG8_SB(0, 1), b2 + hstep, voffB);
            PG8_WAIT_V(6); PG8_BAR; PG8_MMA(1, 1, At, B1); PG8_BAR;
            PG8_LDB(B0, 1, 0); PG8_SCHED; PG8_LDA(At, 1, 0); PG8_STAGE(PG8_SA(0, 1), a2 + hstep, voffA);
            PG8_WAIT_L(8); PG8_BAR; PG8_WAIT_L(0); PG8_MMA(0, 0, At, B0); PG8_BAR; PG8_SCHED;
            PG8_LDB(B1, 1, 1); PG8_STAGE(PG8_SB(1, 0), b3, voffB);
            PG8_BAR; PG8_WAIT_L(0); PG8_MMA(0, 1, At, B1); PG8_BAR;
            PG8_LDA(At, 1, 1); PG8_STAGE(PG8_SA(1, 0), a3, voffA);
            PG8_BAR; PG8_WAIT_L(0); PG8_MMA(1, 0, At, B0); PG8_BAR; PG8_SCHED;
            PG8_STAGE(PG8_SB(1, 1), b3 + hstep, voffB);
            PG8_WAIT_V(6); PG8_BAR; PG8_MMA(1, 1, At, B1); PG8_BAR;
            }
        }
        if constexpr (ALIGN_EPI) { if (wr == 0) PG8_BAR; }
        if constexpr (!Epi::AFTER_DRAIN) { E(acc, cur, wr, wc, fr, fq); S.done(cur); }
        if (!has_next) break;
#pragma unroll
        for (int a = 0; a < 2; ++a)
#pragma unroll
            for (int b = 0; b < 2; ++b)
#pragma unroll
                for (int m = 0; m < 4; ++m)
#pragma unroll
                    for (int n = 0; n < 2; ++n) acc[a][b][m][n] = (f32x4){0.f, 0.f, 0.f, 0.f};
        cur = nxt; cA = nA; cB = nB; ++ui;
        if constexpr (ALIGN_EPI) { if (wr == 1) PG8_BAR; }
    }
    PG8_WAIT_V(0);
    if constexpr (!ALIGN_EPI) { if (wr == 0) PG8_BAR; }
    PG8_BAR;
    if constexpr (Epi::AFTER_DRAIN) { E.fused(acc, cur, wr, wc, fr, fq, lds, wid, lane); S.done(cur); }
#undef PG8_SA
#undef PG8_SB
#undef PG8_STAGE
#undef PG8_LDA
#undef PG8_LDB
#undef PG8_MMA
#undef PG8_WAIT_V
#undef PG8_WAIT_L
#undef PG8_BAR
#undef PG8_SCHED
}
}

__device__ __forceinline__ void phase_gemm_in(const Params& p, char* lds) {
    pg8::Gemm g{(const pg8::bf16_t*)(p.ws + WS_X), (const pg8::bf16_t*)(p.ws + WS_WTIN), MPAD, NPAD, D};
    pg8::StaticOrder So; So.init(MPAD, NPAD, (int)gridDim.x, (int)blockIdx.x);
    pg8::EpiProj E{p.ws};
    pg8::gemm_phase<pg8::EpiProj, pg8::StaticOrder, true, true>((PG8_LAS unsigned char*)lds, g, So, E);
}
__device__ __forceinline__ void phase_gemm_out(const Params& p, char* lds) {
    pg8::Gemm g{(const pg8::bf16_t*)(p.ws + WS_X), (const pg8::bf16_t*)(p.ws + WS_WTOUT), MREAL, D, D};
    pg8::StaticOrder So; So.init(MREAL, D, (int)gridDim.x, (int)blockIdx.x);
    pg8::EpiOut E{p.x, p.out};
    pg8::gemm_phase<pg8::EpiOut, pg8::StaticOrder, true, true>((PG8_LAS unsigned char*)lds, g, So, E);
}

__device__ __forceinline__ void phase_post(const Params& p) {
    h16* P = (h16*)(p.ws + WS_P); const float* E = (const float*)(p.ws + WS_E); h16* KI = (h16*)(p.ws + WS_KI); const float* ROPE = (const float*)(p.ws + WS_ROPE);
    h16* QBf = (h16*)(p.ws + WS_QB); h16* KBf = (h16*)(p.ws + WS_KB);
    const int lane = threadIdx.x & 63, wave = threadIdx.x >> 6;
    for (int row = blockIdx.x * 8 + wave; row < MROWS; row += gridDim.x * 8) {
        const int t = row < MREAL ? NMETA + (row & (S - 1)) : row - MREAL;
        {
            const int head = lane >> 3, i = lane & 7;
            const float c = ROPE[(t * 8 + i) * 2], s = ROPE[(t * 8 + i) * 2 + 1];
            auto rope2 = [&](h16* base) { h16* pr = base + head * 64; const float x1 = (float)pr[i], x2 = (float)pr[i + 8]; pr[i] = (h16)(x1 * c - x2 * s); pr[i + 8] = (h16)(x2 * c + x1 * s); };
            if (row < MREAL) { rope2(QBf + (size_t)row * 512); rope2(P + (size_t)row * NP2 + C_IQ); rope2(KBf + ((size_t)(row >> 13) * KVROWS + 64 + (row & (S - 1))) * 512); }
            else { rope2(KBf + (size_t)(row - MREAL) * 512); rope2(KBf + ((size_t)KVROWS + (row - MREAL)) * 512); }
        }
        const float v = E[(size_t)row * 128 + lane];
        const float mean = wave_sum(v) * (1.f / 64.f); const float d = v - mean;
        const float var = wave_sum(d * d) * (1.f / 64.f);
        float y = d * rsqrtf(var + 1e-6f) * p.idx_g[lane] + p.idx_b[lane];
        const float other = __shfl_xor(y, 8);
        if (lane < 16) {
            const int i = lane & 7; const float c = ROPE[(t * 8 + i) * 2], s = ROPE[(t * 8 + i) * 2 + 1];
            y = lane < 8 ? (y * c - other * s) : (y * c + other * s);
        }
        KI[(size_t)row * 64 + lane] = (h16)y;
    }
}

constexpr int NMI = 130;
constexpr int QB = 32, CAP = 128;
constexpr int IX_KB = 0, IX_HIST = 32768, IX_MASK = 32768  , IX_CAND = 98304, IX_CANDI = 114688, IX_ST = 131072, IX_FLAG = 132096;
constexpr int HROW = 512;
typedef float f32x16 __attribute__((ext_vector_type(16)));
#define ST_LO 0
#define ST_HI 1
#define ST_NEED 2
#define ST_CNT 3
#define ST_FLAGS 4
#define ST_NCAND 5
#define ST_SH 6
#define ST_RUN 7
#define FL_ACTIVE 1u
#define FL_TIE 2u

__device__ __forceinline__ float relu_(float x) { return __builtin_amdgcn_fmed3f(x, 0.f, __builtin_inff()); }
__device__ __forceinline__ unsigned skey_c(float x) { const unsigned u = __float_as_uint(x); return u ^ (((unsigned)((int)u >> 31)) | 0x80000000u); }
__device__ __forceinline__ int custom_bin(unsigned key) {
    const int k14 = (int)(key >> 18); const int a = k14 - 11488, bb = k14 - 3873;
    const int lowpart = min(max(bb, 0), 511);
    return max(min(a, 1023), lowpart);
}

__device__ __forceinline__ void glds16(const void* gsrc, unsigned lds_dst) { unsigned keep;
    asm volatile("s_mov_b32 %0, m0\n\ts_mov_b32 m0, %2\n\ts_nop 0\n\tglobal_load_lds_dwordx4 %1, off\n\ts_mov_b32 m0, %0" : "=&s"(keep) : "v"(gsrc), "s"(lds_dst) : "memory"); }

struct IdxLane { unsigned loA, hiA, loB, hiB, flA, flB, shA, shB, needA, needB, runA, runB; int qA, qB, rA, rB; bool anyTie; };

template <int MODE, bool DIAG>
__device__ __forceinline__ void idx_tile(char* lds, const char* kb, int t, const h16x8 (&afrag)[4], const float (&wreg)[16], IdxLane& L) {
    unsigned* HIST = (unsigned*)(lds + IX_HIST); unsigned* MASK = (unsigned*)(lds + IX_MASK); unsigned* CAND = (unsigned*)(lds + IX_CAND); unsigned* CANDI = (unsigned*)(lds + IX_CANDI); unsigned* ST = (unsigned*)(lds + IX_ST);
    const int lane = threadIdx.x & 63, w = threadIdx.x >> 6, hl = lane >> 5, cc = lane & 31;
    h16x8 bf[2][4];
#pragma unroll
    for (int kh = 0; kh < 2; ++kh)
#pragma unroll
        for (int ks = 0; ks < 4; ++ks) { const int ki = 32 * kh + cc; bf[kh][ks] = *(const h16x8*)(kb + ki * 128 + (((2 * ks + hl) ^ ((ki >> 1) & 7)) << 4)); }
    f32x16 accs[2];
    accs[0] = (f32x16){0.f, 0.f, 0.f, 0.f, 0.f, 0.f, 0.f, 0.f, 0.f, 0.f, 0.f, 0.f, 0.f, 0.f, 0.f, 0.f}; accs[1] = accs[0];
#pragma unroll
    for (int ks = 0; ks < 4; ++ks) { accs[0] = __builtin_amdgcn_mfma_f32_32x32x16_f16(afrag[ks], bf[0][ks], accs[0], 0, 0, 0); accs[1] = __builtin_amdgcn_mfma_f32_32x32x16_f16(afrag[ks], bf[1][ks], accs[1], 0, 0, 0); }
#pragma unroll
    for (int kh = 0; kh < 2; ++kh) {
        const f32x16 acc = accs[kh];
        float pq[4];
#pragma unroll
        for (int q4 = 0; q4 < 4; ++q4)
            pq[q4] = __builtin_fmaf(wreg[4 * q4 + 3], relu_(acc[4 * q4 + 3]), __builtin_fmaf(wreg[4 * q4 + 2], relu_(acc[4 * q4 + 2]), __builtin_fmaf(wreg[4 * q4 + 1], relu_(acc[4 * q4 + 1]), __builtin_fmaf(wreg[4 * q4], relu_(acc[4 * q4]), 0.f))));
        const auto r01 = __builtin_amdgcn_permlane32_swap(__float_as_uint(pq[0]), __float_as_uint(pq[1]), false, false);
        const auto r23 = __builtin_amdgcn_permlane32_swap(__float_as_uint(pq[2]), __float_as_uint(pq[3]), false, false);
        const float sA = __uint_as_float(r01[0]) + __uint_as_float(r01[1]);
        const float sB = __uint_as_float(r23[0]) + __uint_as_float(r23[1]);
        const int sidx = 64 * t + 32 * kh + cc;
        const bool vA = DIAG ? (sidx <= L.rA) : true, vB = DIAG ? (sidx <= L.rB) : true;
        const unsigned kA = skey_c(sA), kB = skey_c(sB);
        if (MODE == 0) {
            const int bA = custom_bin(kA), bB = custom_bin(kB);
            if (vA) atomicAdd(&HIST[L.qA * HROW + (bA >> 1)], 1u << (16 * (bA & 1)));
            if (vB) atomicAdd(&HIST[L.qB * HROW + (bB >> 1)], 1u << (16 * (bB & 1)));
        } else if (MODE == 1) {
            if (vA && (L.flA & FL_ACTIVE) && (kA - L.loA) <= (L.hiA - L.loA)) { const unsigned sb = (kA - L.loA) >> L.shA; atomicAdd(&HIST[L.qA * HROW + (sb >> 1)], 1u << (16 * (sb & 1))); }
            if (vB && (L.flB & FL_ACTIVE) && (kB - L.loB) <= (L.hiB - L.loB)) { const unsigned sb = (kB - L.loB) >> L.shB; atomicAdd(&HIST[L.qB * HROW + (sb >> 1)], 1u << (16 * (sb & 1))); }
        } else {
            bool selA = vA && kA > L.hiA, selB = vB && kB > L.hiB;
            const bool inA = vA && (kA - L.loA) <= (L.hiA - L.loA), inB = vB && (kB - L.loB) <= (L.hiB - L.loB);
            if (L.anyTie) {
                const unsigned long long eA = __ballot(inA && (L.flA & FL_TIE)), eB = __ballot(inB && (L.flB & FL_TIE));
                const unsigned pA = hl ? (unsigned)(eA >> 32) : (unsigned)eA, pB = hl ? (unsigned)(eB >> 32) : (unsigned)eB;
                const unsigned below = (1u << cc) - 1u;
                if (inA && (L.flA & FL_TIE) && L.runA + __popc(pA & below) < L.needA) selA = true;
                if (inB && (L.flB & FL_TIE) && L.runB + __popc(pB & below) < L.needB) selB = true;
                L.runA += __popc(pA); L.runB += __popc(pB);
            }
            if (inA && !(L.flA & FL_TIE)) { const unsigned pos = atomicAdd(&ST[L.qA * 8 + ST_NCAND], 1u); if (pos < CAP) { CAND[L.qA * CAP + pos] = kA; CANDI[L.qA * CAP + pos] = (unsigned)sidx; } }
            if (inB && !(L.flB & FL_TIE)) { const unsigned pos = atomicAdd(&ST[L.qB * 8 + ST_NCAND], 1u); if (pos < CAP) { CAND[L.qB * CAP + pos] = kB; CANDI[L.qB * CAP + pos] = (unsigned)sidx; } }
            const unsigned long long mA = __ballot(selA), mB = __ballot(selB);
            const unsigned val = lane == 0 ? (unsigned)mA : (lane == 1 ? (unsigned)(mA >> 32) : (lane == 2 ? (unsigned)mB : (unsigned)(mB >> 32)));
            if (lane < 4) MASK[(4 * w + lane) * 260 + (t + 1) * 2 + kh] = val;
        }
    }
}

template <int MODE>
__device__ __forceinline__ void idx_pass(const Params& p, int b, int u, char* lds, const h16x8 (&afrag)[4], const float (&wreg)[16]) {
    const h16* KI = (const h16*)(p.ws + WS_KI) + (size_t)b * S * 64;
    unsigned* ST = (unsigned*)(lds + IX_ST);
    const int tid = threadIdx.x, lane = tid & 63, hl = lane >> 5; const int w = __builtin_amdgcn_readfirstlane(tid >> 6);
    const int tq = u >> 1;
    IdxLane L{};
    L.qA = 4 * w + hl; L.qB = 4 * w + 2 + hl; L.rA = 32 * u + L.qA; L.rB = 32 * u + L.qB;
    if (MODE != 0) { L.loA = ST[L.qA * 8 + ST_LO]; L.hiA = ST[L.qA * 8 + ST_HI]; L.flA = ST[L.qA * 8 + ST_FLAGS]; L.shA = ST[L.qA * 8 + ST_SH]; L.needA = ST[L.qA * 8 + ST_NEED];
                     L.loB = ST[L.qB * 8 + ST_LO]; L.hiB = ST[L.qB * 8 + ST_HI]; L.flB = ST[L.qB * 8 + ST_FLAGS]; L.shB = ST[L.qB * 8 + ST_SH]; L.needB = ST[L.qB * 8 + ST_NEED]; }
    L.anyTie = (MODE == 2) && (__ballot((L.flA | L.flB) & FL_TIE) != 0ull);
    const int si = 8 * w + (lane >> 3);
    const h16* ksrc = KI + (size_t)si * 64 + (((lane & 7) ^ ((si >> 1) & 7)) << 3);
    const unsigned lds0 = (unsigned)(uintptr_t)lds + IX_KB + (unsigned)w * 1024u;
#define IDX_DMA(tt) glds16(ksrc + (size_t)(tt) * 64 * 64, (unsigned)__builtin_amdgcn_readfirstlane(lds0 + (unsigned)((tt) & 3) * 8192u))
#define IDX_WAIT(N) asm volatile("s_waitcnt vmcnt(" #N ") lgkmcnt(0)\n\ts_barrier" ::: "memory")
    IDX_DMA(0); if (tq >= 1) IDX_DMA(1); if (tq >= 2) IDX_DMA(2);
    if (tq >= 2) IDX_WAIT(2); else if (tq == 1) IDX_WAIT(1); else IDX_WAIT(0);
    for (int t = 0; t < tq; ++t) {
        if (t + 3 <= tq) IDX_DMA(t + 3);
        idx_tile<MODE, false>(lds, lds + IX_KB + (t & 3) * 8192, t, afrag, wreg, L);
        if (t + 3 <= tq) IDX_WAIT(2); else if (t + 2 <= tq) IDX_WAIT(1); else IDX_WAIT(0);
    }
    idx_tile<MODE, true>(lds, lds + IX_KB + (tq & 3) * 8192, tq, afrag, wreg, L);
    IDX_WAIT(0);
#undef IDX_DMA
#undef IDX_WAIT
}

template <int MODE>
__device__ __forceinline__ void idx_scan(char* lds) {
    unsigned* HIST = (unsigned*)(lds + IX_HIST); unsigned* ST = (unsigned*)(lds + IX_ST); unsigned* FLAG = (unsigned*)(lds + IX_FLAG);
    const int lane = threadIdx.x & 63, w = threadIdx.x >> 6;
    for (int q4 = 0; q4 < 4; ++q4) {
        const int q = 4 * w + q4;
        const unsigned fl = ST[q * 8 + ST_FLAGS];
        if (MODE == 1 && !(fl & FL_ACTIVE)) continue;
        const unsigned need = ST[q * 8 + ST_NEED], lo = ST[q * 8 + ST_LO], hi = ST[q * 8 + ST_HI], sh = ST[q * 8 + ST_SH];
        unsigned c[16];
#pragma unroll
        for (int j = 0; j < 8; ++j) { const unsigned d = HIST[q * HROW + 8 * lane + j]; c[2 * j] = d & 0xFFFFu; c[2 * j + 1] = d >> 16; HIST[q * HROW + 8 * lane + j] = 0u; }
        unsigned tl = 0;
#pragma unroll
        for (int k = 0; k < 16; ++k) tl += c[k];
        unsigned Ssum = tl;
#pragma unroll
        for (int o = 1; o < 64; o <<= 1) { const unsigned v = __shfl_down(Ssum, o); if (lane + o < 64) Ssum += v; }
        const unsigned above = Ssum - tl;
        if (above < need && need <= Ssum) {
            unsigned cum = above; int bstar = 16 * lane; unsigned cnt = 0; bool found = false;
#pragma unroll
            for (int k = 15; k >= 0; --k) { if (!found) { if (cum + c[k] >= need) { bstar = 16 * lane + k; cnt = c[k]; found = true; } else cum += c[k]; } }
            const unsigned nneed = need - cum;
            unsigned nlo, nhi;
            if (MODE == 0) {
                if (bstar >= 512) { nlo = (unsigned)(bstar + 11488) << 18; nhi = bstar == 1023 ? 0xFFFFFFFFu : (nlo | 0x3FFFFu); }
                else if (bstar == 511) { nlo = 4384u << 18; nhi = (11999u << 18) | 0x3FFFFu; }
                else { nhi = ((unsigned)(bstar + 3873) << 18) | 0x3FFFFu; nlo = bstar == 0 ? 0u : ((unsigned)(bstar + 3873) << 18); }
            } else {
                nlo = lo + ((unsigned)bstar << sh); const unsigned top = nlo + ((1u << sh) - 1u); nhi = top < hi ? top : hi; if (top < nlo) nhi = hi;
            }
            const unsigned range = nhi - nlo;
            unsigned nfl = 0, nsh = 0;
            if (nlo < nhi && cnt > CAP) { nfl = FL_ACTIVE; const int bits = 32 - __clz(range); nsh = bits > 10 ? (unsigned)(bits - 10) : 0u; *FLAG = 1u; }
            else if (cnt > CAP) nfl = FL_TIE;
            ST[q * 8 + ST_LO] = nlo; ST[q * 8 + ST_HI] = nhi; ST[q * 8 + ST_NEED] = nneed; ST[q * 8 + ST_CNT] = cnt; ST[q * 8 + ST_FLAGS] = nfl; ST[q * 8 + ST_SH] = nsh;
        }
    }
}

__device__ __forceinline__ void idx_unit(const Params& p, int b, int u, char* lds, int dry = 0) {
    const h16* P = (const h16*)(p.ws + WS_P); const float* E = (const float*)(p.ws + WS_E);
    unsigned long long* Mk = (unsigned long long*)p.out + (dry ? (size_t)(36u << 20) / 8 : 0);
    unsigned* HIST = (unsigned*)(lds + IX_HIST); unsigned* MASK = (unsigned*)(lds + IX_MASK); unsigned* CAND = (unsigned*)(lds + IX_CAND); unsigned* ST = (unsigned*)(lds + IX_ST); unsigned* FLAG = (unsigned*)(lds + IX_FLAG);
    const int tid = threadIdx.x, lane = tid & 63, w = tid >> 6, hl = lane >> 5, cc = lane & 31;
    const int qb = u >> 3, nwords = 4 * qb + 6;
    if (32 * u + 31 < 256) {
        for (int idx = tid; idx < 32 * nwords; idx += NT) {
            const int q = idx & 31, i = idx >> 5, r = 32 * u + q;
            unsigned long long wv;
            if (i == 0) wv = 0xFFFFull; else { const int nv = r - 64 * (i - 1) + 1; wv = nv <= 0 ? 0ull : (nv >= 64 ? ~0ull : ((1ull << nv) - 1ull)); }
            Mk[((size_t)b * NMI + i) * S + r] = wv;
        }
        return;
    }
    for (int i = tid; i < 32 * HROW; i += NT) HIST[i] = 0u;
    if (tid < 32) { ST[tid * 8 + ST_LO] = 0u; ST[tid * 8 + ST_HI] = 0xFFFFFFFFu; ST[tid * 8 + ST_NEED] = 256u; ST[tid * 8 + ST_CNT] = 0u; ST[tid * 8 + ST_FLAGS] = 0u; ST[tid * 8 + ST_NCAND] = 0u; ST[tid * 8 + ST_SH] = 0u; ST[tid * 8 + ST_RUN] = 0u; }
    if (tid == 0) *FLAG = 0u;
    h16x8 afrag[4]; float wreg[16];
    {
        const int qq = cc >> 3, head = cc & 7;
        const size_t row = (size_t)b * S + 32 * u + 4 * w + qq;
#pragma unroll
        for (int ks = 0; ks < 4; ++ks) afrag[ks] = *(const h16x8*)(P + row * NP2 + C_IQ + head * 64 + 16 * ks + 8 * hl);
#pragma unroll
        for (int q4 = 0; q4 < 4; ++q4) { const f32x4 wv = *(const f32x4*)(E + ((size_t)b * S + 32 * u + 4 * w + q4) * 128 + 64 + 4 * hl); wreg[4 * q4] = wv.x; wreg[4 * q4 + 1] = wv.y; wreg[4 * q4 + 2] = wv.z; wreg[4 * q4 + 3] = wv.w; }
    }
#pragma unroll
    for (int ks = 0; ks < 4; ++ks) asm volatile("" : "+v"(afrag[ks]));
#pragma unroll
    for (int i = 0; i < 16; ++i) asm volatile("" : "+v"(wreg[i]));
    __syncthreads();
#if PROBE == 9
    idx_pass<0>(p, b, u, lds, afrag, wreg);
    for (int i = tid; i < 32 * HROW; i += NT) HIST[i] = 0u;
    __syncthreads();
#endif
    if (!dry) idx_pass<0>(p, b, u, lds, afrag, wreg);
    idx_scan<0>(lds);
    __syncthreads();
    for (int iter = 0; iter < 8; ++iter) {
        if (*FLAG == 0u || PROBE == 14) break;
        __syncthreads();
        if (tid == 0) *FLAG = 0u;
        __syncthreads();
        if (!dry) idx_pass<1>(p, b, u, lds, afrag, wreg);
        idx_scan<1>(lds);
        __syncthreads();
    }
    for (int i = tid; i < 32 * 260; i += NT) MASK[i] = 0u;
    __syncthreads();
    if (!dry) idx_pass<2>(p, b, u, lds, afrag, wreg);
#if PROBE == 8
    if (tid < 32) ST[tid * 8 + ST_NCAND] = 0u;
    __syncthreads();
    idx_pass<2>(p, b, u, lds, afrag, wreg);
#endif
    for (int rrep = 0; rrep < (PROBE == 13 ? 2 : 1); ++rrep)
    for (int q4 = 0; q4 < 4; ++q4) {
        const int q = 4 * w + q4;
        const unsigned fl = ST[q * 8 + ST_FLAGS]; if (fl & FL_TIE) continue;
        unsigned nc = ST[q * 8 + ST_NCAND]; if (nc > CAP) nc = CAP;
        const unsigned need = ST[q * 8 + ST_NEED], lo = ST[q * 8 + ST_LO];
        (void)lo;
        const unsigned* CANDI = (const unsigned*)(lds + IX_CANDI);
        const unsigned k0 = lane < nc ? CAND[q * CAP + lane] : 0u, k1 = lane + 64 < nc ? CAND[q * CAP + lane + 64] : 0u;
        const unsigned i0 = lane < nc ? CANDI[q * CAP + lane] : 0u, i1 = lane + 64 < nc ? CANDI[q * CAP + lane + 64] : 0u;
        unsigned r0 = 0, r1 = 0;
        for (unsigned j = 0; j < nc; ++j) { const unsigned kj = CAND[q * CAP + j], ij = CANDI[q * CAP + j];
            r0 += (kj > k0 || (kj == k0 && ij < i0)) ? 1u : 0u; r1 += (kj > k1 || (kj == k1 && ij < i1)) ? 1u : 0u; }
        if (lane < nc && r0 < need) { const int s = (int)i0; atomicOr(&MASK[q * 260 + ((s >> 6) + 1) * 2 + ((s >> 5) & 1)], 1u << (s & 31)); }
        if (lane + 64 < nc && r1 < need) { const int s = (int)i1; atomicOr(&MASK[q * 260 + ((s >> 6) + 1) * 2 + ((s >> 5) & 1)], 1u << (s & 31)); }
    }
    __syncthreads();
    for (int idx = tid; idx < 32 * nwords; idx += NT) {
        const int q = idx & 31, i = idx >> 5, r = 32 * u + q;
        const unsigned long long wv = i == 0 ? 0xFFFFull : ((unsigned long long)MASK[q * 260 + 2 * i] | ((unsigned long long)MASK[q * 260 + 2 * i + 1] << 32));
        Mk[((size_t)b * NMI + i) * S + r] = wv;
    }
    __syncthreads();
}

namespace attn_body {
using bf16=_Float16;
typedef _Float16 fh16x8 __attribute__((ext_vector_type(8)));
typedef unsigned u32x2 __attribute__((ext_vector_type(2)));
#define MFH(a,b,c,x,y,z) __builtin_amdgcn_mfma_f32_32x32x16_f16(__builtin_bit_cast(fh16x8,(a)),__builtin_bit_cast(fh16x8,(b)),(c),0,0,0)
using bf16x8=__attribute__((ext_vector_type(8)))short;
using s16x4=__attribute__((ext_vector_type(4)))short;
using f32x16=__attribute__((ext_vector_type(16)))float;
using u32x4=__attribute__((ext_vector_type(4)))unsigned;
constexpr int BATCH=2,NHEAD=8,SEQ=8192,D=64,DM=NHEAD*D,KVROWS=8320,NMI_=130;
constexpr int NW=8,QBLK=32,QB=QBLK*NW,KVBLK=64,NQB=SEQ/QB;
constexpr int ATTN_PITCH=DM, ATTN_UNIT_ROWS=QB;
__device__ __forceinline__ int crow(int r,int hi){return (r&3)+8*(r>>2)+4*hi;}
#define SBAR() __builtin_amdgcn_sched_barrier(0)
__device__ __forceinline__ float msel(int m,int pos,float keepv){ const int t=__builtin_amdgcn_sbfe(m,pos,1); float d; asm("v_bfi_b32 %0, %1, %2, %3":"=v"(d):"v"(t),"v"(keepv),"s"(0xFF800000u)); return d; }
__device__ __forceinline__ void cinit(f32x16&p0,f32x16&p1,const u32x2&m,int hi,float nmh){
  const int m0=(int)(m[0]>>(4*hi)), m1=(int)(m[1]>>(4*hi));
  #pragma unroll
  for(int r=0;r<16;++r){ const int pos=(r&3)+8*(r>>2); p0[r]=msel(m0,pos,nmh); p1[r]=msel(m1,pos,nmh); }
  asm volatile("s_nop 1":"+v"(p0),"+v"(p1));
}
__device__ __forceinline__ void mload(u32x2&m,const unsigned long long*p){ asm volatile("global_load_dwordx2 %0, %1, off":"=v"(m):"v"(p):"memory"); }
constexpr int NSLOT=3, SLOTB=8192;
constexpr int LDS_K=0, LDS_V=NSLOT*SLOTB, LDS_WS=2*NSLOT*SLOTB, LDS_OST=LDS_WS+NW*64*4, LDS_BYTES=LDS_OST+NW*4096;
constexpr float C2=0.125f*1.4426950408889634f;
__device__ __forceinline__ void glds16(const void*gsrc,unsigned lds_dst){unsigned keep;
  asm volatile("s_mov_b32 %0, m0\n\ts_mov_b32 m0, %2\n\ts_nop 0\n\tglobal_load_lds_dwordx4 %1, off\n\ts_mov_b32 m0, %0":"=&s"(keep):"v"(gsrc),"s"(lds_dst):"memory");}
__device__ __forceinline__ float max3f(float a,float b,float c){float r;asm("v_max3_f32 %0, %1, %2, %3":"=v"(r):"v"(a),"v"(b),"v"(c));return r;}
__device__ __forceinline__ float max2f(float a,float b){float r;asm("v_max_f32_e32 %0, %1, %2":"=v"(r):"v"(a),"v"(b));return r;}
__device__ __forceinline__ float fadd_s(float a,float b){float r;asm("v_add_f32_e32 %0, %1, %2":"=v"(r):"v"(a),"v"(b));return r;}
__device__ __forceinline__ float fsub_s(float a,float b){float r;asm("v_sub_f32_e32 %0, %1, %2":"=v"(r):"v"(a),"v"(b));return r;}
typedef float f32x2_t __attribute__((ext_vector_type(2))); typedef _Float16 bf16x2_t __attribute__((ext_vector_type(2)));
__device__ __forceinline__ unsigned cvtpk_s(float lo,float hi){f32x2_t v={lo,hi};bf16x2_t b=__builtin_convertvector(v,bf16x2_t);return __builtin_bit_cast(unsigned,b);}
#define WAIT_BAR(N) asm volatile("s_waitcnt vmcnt(" #N ") lgkmcnt(0)\n\ts_barrier":::"memory")
#define WAIT_BAR_M(N,M) do{ asm volatile("s_waitcnt vmcnt(" #N ") lgkmcnt(0)\n\ts_barrier":::"memory"); __builtin_amdgcn_sched_barrier(0); asm volatile("":"+v"(M)); }while(0)
#define WAIT_BAR_M2(N,M,M2) do{ asm volatile("s_waitcnt vmcnt(" #N ") lgkmcnt(0)\n\ts_barrier":::"memory"); __builtin_amdgcn_sched_barrier(0); asm volatile("":"+v"(M),"+v"(M2)); }while(0)

__device__ __forceinline__ void qkt(f32x16&p0,f32x16&p1,const char*Kslot,const bf16x8*qr,int r32,int hi){
  const char*kb=Kslot+hi*1024+r32*16;
  #pragma unroll
  for(int d0=0;d0<4;++d0){
    const bf16x8 b0=*reinterpret_cast<const bf16x8*>(kb+d0*2048);
    const bf16x8 b1=*reinterpret_cast<const bf16x8*>(kb+d0*2048+512);
    p0=MFH(b0,qr[d0],p0,0,0,0);p1=MFH(b1,qr[d0],p1,0,0,0);}
}
typedef __attribute__((address_space(3))) const char* lds_cptr;
typedef short v4i16_t __attribute__((ext_vector_type(4)));
__device__ __forceinline__ void kload8(bf16x8*kf,lds_cptr kp){
  kf[0]=*(const __attribute__((address_space(3))) bf16x8*)(kp);      kf[1]=*(const __attribute__((address_space(3))) bf16x8*)(kp+512);
  kf[2]=*(const __attribute__((address_space(3))) bf16x8*)(kp+2048); kf[3]=*(const __attribute__((address_space(3))) bf16x8*)(kp+2560);
  kf[4]=*(const __attribute__((address_space(3))) bf16x8*)(kp+4096); kf[5]=*(const __attribute__((address_space(3))) bf16x8*)(kp+4608);
  kf[6]=*(const __attribute__((address_space(3))) bf16x8*)(kp+6144); kf[7]=*(const __attribute__((address_space(3))) bf16x8*)(kp+6656);
}
__device__ __forceinline__ void kload2(bf16x8*kf,lds_cptr kp,int j){ kf[2*j]=*(const __attribute__((address_space(3))) bf16x8*)(kp+j*2048); kf[2*j+1]=*(const __attribute__((address_space(3))) bf16x8*)(kp+j*2048+512); }
__device__ __forceinline__ s16x4 vtr(lds_cptr p){ return __builtin_bit_cast(s16x4,__builtin_amdgcn_ds_read_tr16_b64_v4i16((__attribute__((address_space(3))) v4i16_t*)p)); }
__device__ __forceinline__ float rowmax(const f32x16&p0,const f32x16&p1){
  float a=max3f(p0[0],p0[1],p1[0]),b=max3f(p0[2],p0[3],p1[1]);a=max3f(a,p1[2],p1[3]);
  #pragma unroll
  for(int r=4;r<16;r+=4){a=max3f(a,p0[r],p0[r+1]);b=max3f(b,p0[r+2],p0[r+3]);a=max3f(a,p1[r],p1[r+1]);b=max3f(b,p1[r+2],p1[r+3]);}
  const float m=max2f(a,b);
  auto rr=__builtin_amdgcn_permlane32_swap(__float_as_uint(m),__float_as_uint(m),false,false);
  return max2f(__uint_as_float(rr[0]),__uint_as_float(rr[1]));
}
__device__ __forceinline__ void pv(f32x16*o,int vb,bf16x8 pa0,bf16x8 pa1,bf16x8 pa2,bf16x8 pa3){
  #pragma unroll
  for(int d0=0;d0<2;++d0){s16x4 lo[4],hi[4];
    #pragma unroll
    for(int ks=0;ks<4;++ks){
      asm volatile("ds_read_b64_tr_b16 %0,%1 offset:%c2":"=&v"(lo[ks]):"v"(vb),"i"(d0*4096+ks*1024):"memory");
      asm volatile("ds_read_b64_tr_b16 %0,%1 offset:%c2":"=&v"(hi[ks]):"v"(vb),"i"(d0*4096+ks*1024+512):"memory");}
    asm volatile("s_waitcnt lgkmcnt(0)":::"memory");SBAR();
    #define PK(k) (bf16x8){lo[k][0],lo[k][1],lo[k][2],lo[k][3],hi[k][0],hi[k][1],hi[k][2],hi[k][3]}
    o[d0]=MFH(pa0,PK(0),o[d0],0,0,0);
    o[d0]=MFH(pa1,PK(1),o[d0],0,0,0);
    o[d0]=MFH(pa2,PK(2),o[d0],0,0,0);
    o[d0]=MFH(pa3,PK(3),o[d0],0,0,0);
    #undef PK
  }
}

#ifndef ATTN_STORE16
#define ATTN_STORE16(p,v) (*(u32x4*)(p)=(v))
#endif
template<int THRL> __device__ __forceinline__ void attn_unit(int b,int h,int qb,const bf16*Q,const bf16*__restrict__ K,const bf16*__restrict__ V,bf16*O,const unsigned long long*__restrict__ Mk,char*shm){
  const int tid=threadIdx.x,lane=tid&63,r32=lane&31,hi=lane>>5; const int wid=__builtin_amdgcn_readfirstlane(tid>>6);
  const long rowbase=(long)b*SEQ, kvbase=(long)b*KVROWS; const int q0=qb*QB;
  const bf16*Qw=Q+(rowbase+q0+wid*QBLK)*DM+h*D;
  const bf16*Kh=K+kvbase*DM+h*D,*Vh=V+kvbase*DM+h*D;
  const unsigned long long*mrow=Mk+(long)b*NMI_*SEQ+(q0+wid*QBLK+r32);
  u32x2 mA,mB; mload(mA,mrow); mload(mB,mrow+SEQ);
  const unsigned lds0=(unsigned)(uintptr_t)shm;
  float*wsf=(float*)(shm+LDS_WS)+wid*64;
  const bf16*ksrc=Kh+(long)lane*DM+wid*8;
  const bf16*vsrc=Vh+(long)(16*(wid&3)+(lane>>2))*DM+(wid>>2)*32+(lane&3)*8;
  const unsigned kdst=lds0+LDS_K+wid*1024, vdst=lds0+LDS_V+wid*1024;
  #define DMA_K(t,slot) glds16(ksrc+(long)(t)*KVBLK*DM,(unsigned)__builtin_amdgcn_readfirstlane(kdst+(slot)))
  #define DMA_V(t,slot) glds16(vsrc+(long)(t)*KVBLK*DM,(unsigned)__builtin_amdgcn_readfirstlane(vdst+(slot)))
  const int vb0=(int)(lds0+LDS_V)+((lane>>4)&1)*32+(lane&3)*8+(4*hi+((lane&15)>>2))*64;
  const char*Kbase=shm+LDS_K; bf16x8 kf[8];
  const lds_cptr shm3=(lds_cptr)shm; const lds_cptr kp0=shm3+LDS_K+hi*1024+r32*16; const lds_cptr vp0=shm3+LDS_V+((lane>>4)&1)*32+(lane&3)*8+(4*hi+((lane&15)>>2))*64;
  const int NT=(q0+QB)/KVBLK+2;
  DMA_K(0,0);DMA_V(0,0);DMA_K(1,SLOTB);
  bf16x8 qr[4];
  #pragma unroll
  for(int d0=0;d0<4;++d0)qr[d0]=*reinterpret_cast<const bf16x8*>(&Qw[(long)r32*DM+d0*16+hi*8]);
  float mhat=0.f,l_reg=0.f;f32x16 o[2];o[0]=f32x16{};o[1]=f32x16{};
  const int qrel=wid*QBLK+r32;
  bool resc=false;
  #define START(P0,P1) do{ const float rm=rowmax(P0,P1); resc=false; \
    { const float dl=rm; mhat=fadd_s(mhat,dl); \
      _Pragma("unroll") for(int r=0;r<16;++r){P0[r]=fsub_s(P0[r],dl);P1[r]=fsub_s(P1[r],dl);} \
      } \
    _Pragma("unroll") for(int r=0;r<16;++r)P0[r]=__builtin_amdgcn_exp2f(P0[r]); }while(0)
  #define RESC() do{ if(resc){ asm volatile("s_waitcnt lgkmcnt(0)":::"memory"); \
      _Pragma("unroll") for(int d_=0;d_<2;++d_) _Pragma("unroll") for(int r=0;r<16;++r)o[d_][r]*=wsf[crow(r,hi)]; } }while(0)
  f32x16 pA0,pA1,pB0,pB1;
  int sl_prev=0,sl_cur=0,sl_next=SLOTB;
  #define ROT() do{sl_prev=sl_cur;sl_cur=sl_next;sl_next=(sl_next==(NSLOT-1)*SLOTB)?0:sl_next+SLOTB;}while(0)
  DMA_K(2,2*SLOTB);
  WAIT_BAR_M2(3,mA,mB);
  cinit(pA0,pA1,mA,hi,0.f);qkt(pA0,pA1,Kbase,qr,r32,hi);asm volatile("s_nop 15\n\ts_nop 7":"+v"(pA0),"+v"(pA1));
  START(pA0,pA1);
  _Pragma("unroll") for(int r=0;r<16;++r)pA1[r]=__builtin_amdgcn_exp2f(pA1[r]);
  WAIT_BAR(0);
  DMA_K(3,0);DMA_V(1,SLOTB);
  ROT();
  kload8(kf,kp0+sl_cur);
  WAIT_BAR(2);
  s16x4 vlo[8],vhi[8]; u32x4 pw0,pw1,pw2,pw3;
  #define PKW(P,B) cvtpk_s(P[B],P[B+1])
  #define PAF(k) __builtin_bit_cast(bf16x8,pw##k)
  #define VFR(i) (bf16x8){vlo[i][0],vlo[i][1],vlo[i][2],vlo[i][3],vhi[i][0],vhi[i][1],vhi[i][2],vhi[i][3]}
  #define PIN(x) asm volatile("":"+v"(x))
  #define MX3(a,b,c) __builtin_fmaxf(__builtin_fmaxf((a),(b)),(c))
  #define GAPA(MF,A0,A1,A2,A3,W0,W1,PW) do{ MF; sacc+=A0; sacc+=A1; sacc+=A2; sacc+=A3; PIN(sacc); W0; W1; PIN(PW); SBAR(); }while(0)
  #define EX(v) __builtin_amdgcn_exp2f(v)
  #define GAPB(MF,X,B) do{ MF; X[B]=EX(X[B]); X[B+1]=EX(X[B+1]); X[B+2]=EX(X[B+2]); X[B+3]=EX(X[B+3]); PIN(X); SBAR(); }while(0)
  #define VRD(i) do{ vlo[i]=vtr(vp_+(((i)>>2)*4096+((i)&3)*1024)); vhi[i]=vtr(vp_+(((i)>>2)*4096+((i)&3)*1024+512)); }while(0)
  #define KRD(G,j) do{ if(G){ kload2(kf,kp0+sl_next,j); SBAR(); } }while(0)
  #define STEP(C0,C1,P0,P1,t,GK,GV,GL,MC,MN,GM) do{ SBAR(); \
    if(GM){mload(MN,mrow+(long)((t)+1)*SEQ);} \
    cinit(C0,C1,MC,hi,-mhat); SBAR(); \
    const lds_cptr vp_=vp0+sl_prev; \
    VRD(0); SBAR(); float sacc=(P0[0]+P0[1]); \
    GAPA(C0=MFH(kf[0],qr[0],C0,0,0,0), P0[2],P0[3],P0[4],P0[5],     pw0[0]=PKW(P0,0), pw0[1]=PKW(P0,2), pw0); \
    VRD(4); SBAR(); GAPA(C1=MFH(kf[1],qr[0],C1,0,0,0), P0[6],P0[7],P0[8],P0[9],     pw0[2]=PKW(P0,4), pw0[3]=PKW(P0,6), pw0); \
    VRD(1); SBAR(); GAPA(C0=MFH(kf[2],qr[1],C0,0,0,0),   P0[10],P0[11],P0[12],P0[13], pw1[0]=PKW(P0,8), pw1[1]=PKW(P0,10), pw1); \
    VRD(5); SBAR(); GAPA(C1=MFH(kf[3],qr[1],C1,0,0,0),   P0[14],P0[15],P1[0],P1[1],   pw1[2]=PKW(P0,12),pw1[3]=PKW(P0,14), pw1); \
    VRD(2); SBAR(); GAPA(C0=MFH(kf[4],qr[2],C0,0,0,0),   P1[2],P1[3],P1[4],P1[5],     pw2[0]=PKW(P1,0), pw2[1]=PKW(P1,2), pw2); \
    VRD(6); SBAR(); GAPA(C1=MFH(kf[5],qr[2],C1,0,0,0),   P1[6],P1[7],P1[8],P1[9],     pw2[2]=PKW(P1,4), pw2[3]=PKW(P1,6), pw2); \
    VRD(3); SBAR(); GAPA(C0=MFH(kf[6],qr[3],C0,0,0,0),   P1[10],P1[11],P1[12],P1[13], pw3[0]=PKW(P1,8), pw3[1]=PKW(P1,10), pw3); \
    VRD(7); SBAR(); GAPA(C1=MFH(kf[7],qr[3],C1,0,0,0),   P1[14],P1[15],0.f,0.f,       pw3[2]=PKW(P1,12),pw3[3]=PKW(P1,14), pw3); \
    l_reg+=sacc; \
    if(GK){DMA_K((t)+3,sl_cur);} if(GV){DMA_V((t)+1,sl_next);} \
    { float a=MX3(C0[0],C0[1],C1[0]),b=MX3(C0[2],C0[3],C1[1]); a=MX3(a,C1[2],C1[3]); \
      _Pragma("unroll") for(int r=4;r<16;r+=4){a=MX3(a,C0[r],C0[r+1]);b=MX3(b,C0[r+2],C0[r+3]);a=MX3(a,C1[r],C1[r+1]);b=MX3(b,C1[r+2],C1[r+3]);} \
      float rm=__builtin_fmaxf(a,b); { auto rr=__builtin_amdgcn_permlane32_swap(__float_as_uint(rm),__float_as_uint(rm),false,false); rm=__builtin_fmaxf(__uint_as_float(rr[0]),__uint_as_float(rr[1])); } \
      resc=false; \
      if(__builtin_expect(__any(rm>(float)THRL),0)){ const float dl=__builtin_fmaxf(rm,0.f); mhat+=dl; \
        _Pragma("unroll") for(int r=0;r<16;++r){C0[r]-=dl;C1[r]-=dl;} \
        const float f=__builtin_amdgcn_exp2f(-dl); l_reg*=f; if(hi==0)wsf[r32]=f; resc=true; } } \
    SBAR(); \
    GAPB(o[0]=MFH(PAF(0),VFR(0),o[0],0,0,0), C0,0); \
    GAPB(o[1]=MFH(PAF(0),VFR(4),o[1],0,0,0), C0,4); \
    KRD(GL,0); GAPB(o[0]=MFH(PAF(1),VFR(1),o[0],0,0,0), C0,8); \
    KRD(GL,1); GAPB(o[1]=MFH(PAF(1),VFR(5),o[1],0,0,0), C0,12); \
    KRD(GL,2); GAPB(o[0]=MFH(PAF(2),VFR(2),o[0],0,0,0), C1,0); \
    KRD(GL,3); GAPB(o[1]=MFH(PAF(2),VFR(6),o[1],0,0,0), C1,4); \
    GAPB(o[0]=MFH(PAF(3),VFR(3),o[0],0,0,0), C1,8); \
    GAPB(o[1]=MFH(PAF(3),VFR(7),o[1],0,0,0), C1,12); \
    }while(0)
  int t=1;
  for(;t+5<NT;t+=2){
    STEP(pB0,pB1,pA0,pA1,t,true,true,true,mB,mA,true);     WAIT_BAR_M(2,mA); RESC(); ROT();
    STEP(pA0,pA1,pB0,pB1,t+1,true,true,true,mA,mB,true);   WAIT_BAR_M(2,mB); RESC(); ROT();
  }
  #define ENDW(tt,M) do{ if((tt)+3<NT){WAIT_BAR_M(2,M);} else if((tt)+2<NT){WAIT_BAR_M(1,M);} else {WAIT_BAR_M(0,M);} }while(0)
  for(;t+1<NT;t+=2){
    STEP(pB0,pB1,pA0,pA1,t,(t+3<NT),(t+1<NT),(t+1<NT),mB,mA,(t+1<NT));       ENDW(t,mA);   RESC(); ROT();
    STEP(pA0,pA1,pB0,pB1,t+1,(t+4<NT),(t+2<NT),(t+2<NT),mA,mB,(t+2<NT));     ENDW(t+1,mB); RESC(); ROT();
  }
  STEP(pB0,pB1,pA0,pA1,NT-1,false,false,false,mB,mA,false); RESC();
  { float sacc=pB0[0]+pB0[1]; _Pragma("unroll") for(int r=2;r<16;++r)sacc+=pB0[r]; _Pragma("unroll") for(int r=0;r<16;++r)sacc+=pB1[r]; l_reg+=sacc;
    pw0=(u32x4){PKW(pB0,0),PKW(pB0,2),PKW(pB0,4),PKW(pB0,6)};pw1=(u32x4){PKW(pB0,8),PKW(pB0,10),PKW(pB0,12),PKW(pB0,14)};pw2=(u32x4){PKW(pB1,0),PKW(pB1,2),PKW(pB1,4),PKW(pB1,6)};pw3=(u32x4){PKW(pB1,8),PKW(pB1,10),PKW(pB1,12),PKW(pB1,14)};
    SBAR(); pv(o,vb0+sl_cur,PAF(0),PAF(1),PAF(2),PAF(3)); }
  #undef PKW
  #undef PAF
  #undef VFR
  #undef PIN
  #undef MX3
  #undef GAPA
  #undef GAPB
  #undef EX
  #undef VRD
  #undef KRD
  #undef STEP
  #undef ENDW
  {auto rr=__builtin_amdgcn_permlane32_swap(__float_as_uint(l_reg),__float_as_uint(l_reg),false,false);l_reg=__uint_as_float(rr[0])+__uint_as_float(rr[1]);}
  if(hi==0)wsf[32+r32]=l_reg;asm volatile("s_waitcnt lgkmcnt(0)":::"memory");
  float rli[16];
  #pragma unroll
  for(int r=0;r<16;++r)rli[r]=__builtin_amdgcn_rcpf(wsf[32+crow(r,hi)]);
  bf16*Ow=O+(rowbase+q0+wid*QBLK)*DM+h*D;
  { bf16*stg=(bf16*)(shm+LDS_OST)+wid*2048;
    #pragma unroll
    for(int r=0;r<16;++r){const int orow=crow(r,hi);
      #pragma unroll
      for(int d0=0;d0<2;++d0)stg[orow*64+d0*32+r32]=(bf16)(o[d0][r]*rli[r]);}
    asm volatile("s_waitcnt lgkmcnt(0)":::"memory");
    #pragma unroll
    for(int i=0;i<4;++i){const int row=i*8+(lane>>3),ch=lane&7; const u32x4 v=*(const u32x4*)(stg+row*64+ch*8); ATTN_STORE16(Ow+(long)row*DM+ch*8,v);} }
  asm volatile("s_waitcnt lgkmcnt(0)\n\ts_barrier":::"memory");
  #undef DMA_K
  #undef DMA_V
  #undef START
  #undef RESC
  #undef ROT
}
constexpr int ATTN_LDS_BYTES=LDS_BYTES;
struct AttnTensors { const bf16* Q; const bf16* K; const bf16* V; bf16* O; const unsigned long long* Mk; };
struct AttnUnit { int bh; int qb; };
struct StaticOrder {
  int vcu,G;
  __device__ __forceinline__ explicit StaticOrder(int grid,int block):vcu((grid%8==0)?((block%8)*(grid/8)+block/8):block),G(grid){}
  __device__ __forceinline__ bool next(int i,AttnUnit&u)const{ const int v=vcu+G*(i>>1); if(v>=256)return false; const int s=v&15; u.bh=v>>4; u.qb=(i&1)?s:31-s; return true; }
};
template<class Sched,int THRL=8> __device__ __forceinline__ void attn_phase(char*lds,const AttnTensors&T,const Sched&S){
  AttnUnit u;
  for(int i=0;S.next(i,u);++i){ attn_unit<THRL>(u.bh/NHEAD,u.bh%NHEAD,u.qb,T.Q,T.K,T.V,T.O,T.Mk,lds); }
}
#undef SBAR
#undef WAIT_BAR
#undef WAIT_BAR_M
#undef WAIT_BAR_M2
#undef MFH
}

__device__ __forceinline__ float hgrn_lb(const Params& p, int idx) { const float l0 = p.lb_logits[idx], l1 = p.lb_logits[512 + idx]; return 1.f / (1.f + __expf(l1 - l0)); }

__device__ __forceinline__ void hgrn_stepA(const Params& p, int item, char* lds) {
    float* kd = (float*)lds;
    float* kk = kd + 64 * 128;
    float* vv = kk + 64 * 128;
    const h16* P = (const h16*)(p.ws + WS_P); float* ST = (float*)(p.ws + WS_X); float* G = (float*)(p.ws + WS_G);
    const int tid = threadIdx.x;
    const int c = item % NCH, bh = item / NCH, h = bh & 3, b = bh >> 2;
    const int L = c == 0 ? 16 : 64; const size_t rowbase = c == 0 ? (size_t)MREAL : (size_t)(b * S + (c - 1) * 64);
    for (int i = tid; i < L * 128; i += NT) { const int t = i >> 7, v = i & 127; vv[t * 128 + v] = (float)P[(rowbase + t) * NP2 + C_HI + h * 128 + v]; }
    if (tid < 128) {
        const int d = tid; const float lb = hgrn_lb(p, h * 128 + d);
        float bc = 0.f;
        for (int t = 0; t < L; ++t) {
            const float hf = (float)P[(rowbase + t) * NP2 + C_HF + h * 128 + d];
            const float f = lb + (1.f - lb) * sigmoidf_(hf);
            bc += logf(f); kd[t * 128 + d] = bc; kk[t * 128 + d] = 1.f - f;
        }
        for (int t = 0; t < L; ++t) kd[t * 128 + d] = kk[t * 128 + d] * __expf(bc - kd[t * 128 + d]);
        G[(size_t)item * 128 + d] = __expf(bc);
    }
    __syncthreads();
    const int d = tid & 127, vg = tid >> 7;
    float acc[32];
#pragma unroll
    for (int j = 0; j < 32; ++j) acc[j] = 0.f;
    for (int s = 0; s < L; ++s) {
        const float kv = kd[s * 128 + d];
#pragma unroll
        for (int j = 0; j < 32; j += 4) { const f32x4 v4 = *(const f32x4*)(vv + s * 128 + vg * 32 + j); acc[j] += kv * v4.x; acc[j + 1] += kv * v4.y; acc[j + 2] += kv * v4.z; acc[j + 3] += kv * v4.w; }
    }
    float* o = ST + (size_t)item * 16384 + d * 128 + vg * 32;
#pragma unroll
    for (int j = 0; j < 32; j += 4) *(f32x4*)(o + j) = (f32x4){acc[j], acc[j + 1], acc[j + 2], acc[j + 3]};
    __syncthreads();
}

__device__ __forceinline__ void hgrn_scan(const Params& p) {
    float* ST = (float*)(p.ws + WS_X); const float* G = (const float*)(p.ws + WS_G);
    for (int idx = blockIdx.x * NT + threadIdx.x; idx < NB * 4 * 16384; idx += gridDim.x * NT) {
        const int bh = idx >> 14, e = idx & 16383, d = e >> 7;
        float Sv = 0.f;
        for (int c = 0; c < NCH; ++c) {
            const size_t off = (size_t)(bh * NCH + c) * 16384 + e;
            const float u = ST[off]; const float g = G[(size_t)(bh * NCH + c) * 128 + d];
            ST[off] = Sv; Sv = g * Sv + u;
        }
    }
}

__device__ __forceinline__ void hgrn_stepC(const Params& p, int item, char* lds) {
    float* bq = (float*)lds;
    float* qq = bq + 64 * 65;
    float* kk = qq + 64 * 65;
    float* Am = kk + 64 * 65;
    float* qe = Am + 64 * 65;
    float* vv = qe + 64 * 128;
    h16* P = (h16*)(p.ws + WS_P); const float* ST = (const float*)(p.ws + WS_X);
    const int tid = threadIdx.x;
    const int c = 1 + item % 128, bh = item / 128, h = bh & 3, b = bh >> 2;
    const size_t rowbase = (size_t)(b * S + (c - 1) * 64);
    for (int i = tid; i < 64 * 128; i += NT) { const int t = i >> 7, v = i & 127; vv[t * 128 + v] = (float)P[(rowbase + t) * NP2 + C_HI + h * 128 + v]; }
    float aacc[8];
#pragma unroll
    for (int i = 0; i < 8; ++i) aacc[i] = 0.f;
    for (int half = 0; half < 2; ++half) {
        if (tid < 64) {
            const int d = half * 64 + tid; const float lb = hgrn_lb(p, h * 128 + d);
            float bc = 0.f;
            for (int t = 0; t < 64; ++t) {
                const float hf = (float)P[(rowbase + t) * NP2 + C_HF + h * 128 + d];
                const float f = lb + (1.f - lb) * sigmoidf_(hf);
                bc += logf(f); bq[t * 65 + tid] = bc; kk[t * 65 + tid] = 1.f - f;
            }
        }
        for (int i = tid; i < 64 * 64; i += NT) { const int t = i >> 6, dl = i & 63; qq[t * 65 + dl] = siluf_((float)P[(rowbase + t) * NP2 + C_HQ + h * 128 + half * 64 + dl]); }
        __syncthreads();
#pragma unroll
        for (int i = 0; i < 8; ++i) {
            const int pr = tid + NT * i, t = pr >> 6, s = pr & 63;
            if (s <= t) { float sum = 0.f;
                for (int dl = 0; dl < 64; ++dl) sum += qq[t * 65 + dl] * kk[s * 65 + dl] * __expf(bq[t * 65 + dl] - bq[s * 65 + dl]);
                aacc[i] += sum; }
        }
        for (int i = tid; i < 64 * 64; i += NT) { const int t = i >> 6, dl = i & 63; qe[t * 128 + half * 64 + dl] = qq[t * 65 + dl] * __expf(bq[t * 65 + dl]); }
        __syncthreads();
    }
#pragma unroll
    for (int i = 0; i < 8; ++i) { const int pr = tid + NT * i, t = pr >> 6, s = pr & 63; Am[t * 65 + s] = aacc[i]; }
    __syncthreads();
    const int v = tid & 127, tg = tid >> 7;
    float acc[16];
#pragma unroll
    for (int i = 0; i < 16; ++i) acc[i] = 0.f;
    for (int s = 0; s < 64; ++s) { const float vval = vv[s * 128 + v];
#pragma unroll
        for (int i = 0; i < 16; ++i) acc[i] += Am[(tg * 16 + i) * 65 + s] * vval; }
    const float* sp = ST + (size_t)(bh * NCH + c) * 16384 + v;
    for (int d = 0; d < 128; ++d) { const float sv = sp[d * 128];
#pragma unroll
        for (int i = 0; i < 16; ++i) acc[i] += qe[(tg * 16 + i) * 128 + d] * sv; }
#pragma unroll
    for (int i = 0; i < 16; ++i) P[(rowbase + tg * 16 + i) * NP2 + C_HQ + h * 128 + v] = (h16)acc[i];
    __syncthreads();
}

__device__ __forceinline__ void phase_mix(const Params& p) {
    const h16* P = (const h16*)(p.ws + WS_P); h16* MIX = (h16*)(p.ws + WS_X);
    const int lane = threadIdx.x & 63, wave = threadIdx.x >> 6;
    for (int row = blockIdx.x * 8 + wave; row < MREAL; row += gridDim.x * 8) {
        const h16* pr = P + (size_t)row * NP2; h16* o = MIX + (size_t)row * D; const h16* qo = (const h16*)(p.ws + WS_QB) + (size_t)row * 512;
        { const h16x8 a = *(const h16x8*)(qo + lane * 8); const h16x8 g = *(const h16x8*)(pr + C_AG + lane * 8);
          float ss = 0.f;
#pragma unroll
          for (int j = 0; j < 8; ++j) ss += (float)a[j] * (float)a[j];
          const float rs = rsqrtf(wave_sum(ss) * (1.f / 512.f) + 1e-6f);
          h16x8 ov;
#pragma unroll
          for (int j = 0; j < 8; ++j) ov[j] = (h16)((float)a[j] * rs * p.attn_norm[lane * 8 + j] * siluf_((float)g[j]));
          *(h16x8*)(o + lane * 8) = ov; }
        { const h16x8 a = *(const h16x8*)(pr + C_HQ + lane * 8); const h16x8 g = *(const h16x8*)(pr + C_HG + lane * 8);
          float ss = 0.f;
#pragma unroll
          for (int j = 0; j < 8; ++j) ss += (float)a[j] * (float)a[j];
#pragma unroll
          for (int o2 = 1; o2 < 16; o2 <<= 1) ss += __shfl_xor(ss, o2);
          const float rs = rsqrtf(ss * (1.f / 128.f) + 1e-6f);
          h16x8 ov;
#pragma unroll
          for (int j = 0; j < 8; ++j) ov[j] = (h16)((float)a[j] * rs * p.hgrn_norm[(lane & 15) * 8 + j] * siluf_((float)g[j]));
          *(h16x8*)(o + 512 + lane * 8) = ov; }
    }
}

__device__ __forceinline__ void phase_final(const Params& p) {
    const int lane = threadIdx.x & 63, wave = threadIdx.x >> 6;
    for (int row = blockIdx.x * 8 + wave; row < MREAL; row += gridDim.x * 8) {
        float* o = p.out + (size_t)row * D;
        f32x4 v[4]; float ss = 0.f;
        for (int j = 0; j < 4; ++j) { v[j] = *(const f32x4*)(o + (lane + 64 * j) * 4); ss += v[j].x * v[j].x + v[j].y * v[j].y + v[j].z * v[j].z + v[j].w * v[j].w; }
        const float rs = rsqrtf(wave_sum(ss) * (1.f / D) + 1e-6f);
        for (int j = 0; j < 4; ++j) { const f32x4 g = *(const f32x4*)(p.final_norm + (lane + 64 * j) * 4);
            *(f32x4*)(o + (lane + 64 * j) * 4) = (f32x4){v[j].x * rs * g.x, v[j].y * rs * g.y, v[j].z * rs * g.z, v[j].w * rs * g.w}; }
    }
}

#define LAS __attribute__((address_space(3)))
#define XB_TMO      128
#define XB_XCNT(j)  (256  + 64 * (j))
#define XB_XSUB(j)  (1280 + 64 * (j))
#define XB_XGEN(j)  (2304 + 64 * (j))
#define XB_TOP      3328
#define XB_TOPGEN   3392
#define XCD_BAR_WORDS 3456
#define XB_SPIN_CAP (1u << 18)

__device__ __forceinline__ unsigned xb_ld(unsigned* p)              { return __hip_atomic_load(p, __ATOMIC_RELAXED, __HIP_MEMORY_SCOPE_AGENT); }
__device__ __forceinline__ unsigned xb_add(unsigned* p, unsigned v) { return __hip_atomic_fetch_add(p, v, __ATOMIC_RELAXED, __HIP_MEMORY_SCOPE_AGENT); }
__device__ __forceinline__ unsigned xb_xcc_id() { return (unsigned)__builtin_amdgcn_s_getreg((3 << 11) | 20) & 0xFu; }
#define XB_SPIN(cond, bar) do { unsigned _sp = 0; while (cond) { __builtin_amdgcn_s_sleep(1); \
    if ((++_sp & 255u) == 0u) { if (xb_ld(&(bar)[XB_TMO])) break; if (_sp > XB_SPIN_CAP) { atomicAdd(&(bar)[XB_TMO], 1u); break; } } } } while (0)

struct XcdBarrier {
    unsigned* bar; unsigned x;
    volatile LAS unsigned* st;
};

__device__ __forceinline__ XcdBarrier xcd_barrier_post(unsigned* bar, volatile LAS unsigned* st) {
    XcdBarrier b; b.bar = bar; b.x = xb_xcc_id(); b.st = st;
    if (threadIdx.x == 0) (void)xb_add(&bar[XB_XCNT(b.x)], 1u);
    return b;
}
__device__ __forceinline__ void xcd_barrier_complete(unsigned* bar, unsigned x, unsigned& nloc, unsigned& nx) {
    const unsigned G = gridDim.x * gridDim.y * gridDim.z;
    unsigned sum, cnt, mine, sp = 0u;
    for (;;) {
        sum = 0u; cnt = 0u; mine = 0u;
#pragma unroll
        for (unsigned j = 0; j < 16; ++j) { const unsigned c = xb_ld(&bar[XB_XCNT(j)]); sum += c; cnt += (c > 0u) ? 1u : 0u; mine = (j == x) ? c : mine; }
        if (sum == G) break;
        __builtin_amdgcn_s_sleep(1);
        if ((++sp & 255u) == 0u) { if (xb_ld(&bar[XB_TMO])) break; if (sp > XB_SPIN_CAP) { atomicAdd(&bar[XB_TMO], 1u); break; } }
    }
    nloc = mine > 0u ? mine : 1u; nx = cnt > 0u ? cnt : 1u;
}

__device__ __forceinline__ void xcd_barrier(const XcdBarrier& b) {
    asm volatile("s_waitcnt vmcnt(0)" ::: "memory");
    __syncthreads();
    if (threadIdx.x == 0) {
        unsigned* bar = b.bar;
        __builtin_amdgcn_s_waitcnt(0);
        unsigned nloc = b.st[0], nx = b.st[1];
        if (nloc == 0u) { xcd_barrier_complete(bar, b.x, nloc, nx); b.st[0] = nloc; b.st[1] = nx; }
        const unsigned old = xb_add(&bar[XB_XSUB(b.x)], 1u);
        const unsigned gen = old / nloc;
        if (old + 1u == (gen + 1u) * nloc) {
            __builtin_amdgcn_fence(__ATOMIC_RELEASE, "agent");
            asm volatile("s_waitcnt vmcnt(0)" ::: "memory");
            const unsigned og = xb_add(&bar[XB_TOP], 1u);
            const unsigned tg = og / nx;
            if (og + 1u == (tg + 1u) * nx) xb_add(&bar[XB_TOPGEN], 1u);
            else XB_SPIN(xb_ld(&bar[XB_TOPGEN]) == tg, bar);
            __builtin_amdgcn_fence(__ATOMIC_ACQUIRE, "agent");
            xb_add(&bar[XB_XGEN(b.x)], 1u);
            asm volatile("s_waitcnt vmcnt(0)" ::: "memory");
        } else {
            XB_SPIN(xb_ld(&bar[XB_XGEN(b.x)]) == gen, bar);
            __builtin_amdgcn_fence(__ATOMIC_ACQUIRE, "agent");
            asm volatile("s_waitcnt vmcnt(0)" ::: "memory");
        }
    }
    __syncthreads();
}


constexpr int NPHASE = 9;
__global__ void __launch_bounds__(NT, 2) mega(Params p, int ph_lo, int ph_hi) {
    extern __shared__ __attribute__((aligned(16))) char lds[];
    cg::grid_group grid = cg::this_grid();
    volatile LAS unsigned* xst = (volatile LAS unsigned*)(LAS char*)(lds + LDS_BYTES - 16);
    if (threadIdx.x < 4) xst[threadIdx.x] = 0u;
    __syncthreads();
    XcdBarrier xbar = xcd_barrier_post((unsigned*)p.ws, xst);
#define IN(k) (ph_lo <= (k) && (k) < ph_hi)
#define SYNC(k) do { if ((k) + 1 < ph_hi) { if ((k) == 0) grid.sync(); else xcd_barrier(xbar); } } while (0)
    if (IN(0)) { phase_prep(p, lds); if (PROBE == 4) phase_prep(p, lds); SYNC(0); }
    if (PROBE == 2) { for (int i = 0; i < 8; ++i) xcd_barrier(xbar); }
    if (IN(1)) { phase_gemm_in(p, lds); if (PROBE == 1) phase_gemm_in(p, lds); SYNC(1); }
    if (IN(2)) { phase_post(p); SYNC(2); }
    if (IN(3)) {
        constexpr int NA = NB * 4 * NCH;
        for (int rep = 0; rep < ((PROBE == 3 || PROBE == 12) ? 2 : 1); ++rep)
        for (int it = blockIdx.x; it < 512; it += gridDim.x) { const int uu = it < 256 ? 255 - (it >> 1) : (it - 256) >> 1; idx_unit(p, it & 1, uu, lds, (PROBE == 12 && rep == 1) ? 1 : 0); }
        for (int rep = 0; rep < (PROBE == 5 ? 2 : 1); ++rep)
        for (int it = blockIdx.x; it < NA; it += gridDim.x) hgrn_stepA(p, it, lds);
        SYNC(3);
    }
    if (IN(4)) { hgrn_scan(p); SYNC(4); }
    if (IN(5)) {
        constexpr int NC = NB * 4 * 128;
        for (int it = blockIdx.x; it < NC; it += gridDim.x) hgrn_stepC(p, it, lds);
        {
            const attn_body::AttnTensors AT{(const h16*)(p.ws + WS_QB), (const h16*)(p.ws + WS_KB), (const h16*)(p.ws + WS_VB), (h16*)(p.ws + WS_QB), (const unsigned long long*)p.out};
            const attn_body::StaticOrder SO((int)gridDim.x, (int)blockIdx.x);
            attn_body::attn_phase<attn_body::StaticOrder>(lds, AT, SO);
        }
        SYNC(5);
    }
    if (IN(6)) { phase_mix(p); if (PROBE == 6) phase_mix(p); SYNC(6); }
    if (IN(7)) { phase_gemm_out(p, lds); if (PROBE == 7) phase_gemm_out(p, lds); SYNC(7); }
    if (IN(8)) { phase_final(p); }
#undef IN
#undef SYNC
}

extern "C" void kernel_launch(void* const* d_in, const int* in_sizes, int n_in, void* d_out, int out_size, void* d_ws, size_t ws_size, hipStream_t stream) {
    static int grid = 0;
    if (grid == 0) {
        if (n_in != 11 || ws_size < WS_END || out_size != MREAL * D) { fprintf(stderr, "kernel_launch: unexpected shapes n_in %d ws %zu out %d\n", n_in, ws_size, out_size); grid = -1; return; }
        int dev = 0, cus = 0, per_cu = 0;
        hipGetDevice(&dev); hipDeviceGetAttribute(&cus, hipDeviceAttributeMultiprocessorCount, dev);
        hipFuncSetAttribute((const void*)mega, hipFuncAttributeMaxDynamicSharedMemorySize, LDS_BYTES);
        hipOccupancyMaxActiveBlocksPerMultiprocessor(&per_cu, (const void*)mega, NT, LDS_BYTES);
        if (per_cu < 1) { fprintf(stderr, "kernel_launch: occupancy query says %d\n", per_cu); per_cu = 1; }
        grid = cus * 1;
        (void)hipGetLastError();
    }
    if (grid < 0) return;
    Params p{};
    p.x = (const float*)d_in[0]; p.meta = (const float*)d_in[1]; p.mix_norm = (const float*)d_in[2]; p.w_in = (const float*)d_in[3];
    p.idx_g = (const float*)d_in[4]; p.idx_b = (const float*)d_in[5]; p.attn_norm = (const float*)d_in[6]; p.lb_logits = (const float*)d_in[7];
    p.hgrn_norm = (const float*)d_in[8]; p.w_out = (const float*)d_in[9]; p.final_norm = (const float*)d_in[10];
    p.out = (float*)d_out; p.ws = (unsigned char*)d_ws;
    hipMemsetAsync(d_ws, 0, 16384, stream);
#if N_LAUNCH_MODE == 1
    int lo = 0, hi = NPHASE; void* args[] = {&p, &lo, &hi};
    hipError_t e = hipLaunchCooperativeKernel((const void*)mega, dim3(grid), dim3(NT), args, LDS_BYTES, stream);
    if (e != hipSuccess) fprintf(stderr, "cooperative launch failed: %s (grid %d)\n", hipGetErrorString(e), grid);
#else
    for (int ph = 0; ph < NPHASE; ++ph) hipLaunchKernelGGL(mega, dim3(grid), dim3(NT), LDS_BYTES, stream, p, ph, ph + 1);
#endif
}
```

```cpp
#include <hip/hip_runtime.h>
#include <hip/hip_cooperative_groups.h>
#include <cstdint>
#include <cstdio>
namespace cg = cooperative_groups;

typedef _Float16 h16;
typedef _Float16 h16x8 __attribute__((ext_vector_type(8)));
typedef _Float16 h16x4 __attribute__((ext_vector_type(4)));
#define LAS __attribute__((address_space(3)))
typedef float f32x4 __attribute__((ext_vector_type(4)));
typedef float f32x2 __attribute__((ext_vector_type(2)));

#ifndef PROBE
#define PROBE 0
#endif
#ifndef N_LAUNCH_MODE
#define N_LAUNCH_MODE 1
#endif

constexpr int NB = 2, S = 8192, NMETA = 16, D = 1024;
constexpr int MREAL = NB * S;
constexpr int MROWS = MREAL + NMETA;
constexpr int MPAD = 16640;
constexpr int NCOL = 4680, NPAD = 4864;
constexpr int G_IK = 4608;
constexpr int NP2 = 3328;
constexpr int C_AG = 0, C_IQ = 512, C_HQ = 1024, C_HF = 1536, C_HI = 2048, C_HG = 2560, C_IK = 3072, C_IW = 3136;
constexpr int KVROWS = 8320;
constexpr int NCH = 129;
constexpr int NT = 512;

constexpr size_t MiB = 1u << 20;
constexpr size_t WS_WTIN = 1 * MiB, WS_WTOUT = 11 * MiB, WS_ROPE = 13 * MiB, WS_E = 14 * MiB, WS_KI = 23 * MiB, WS_G = 26 * MiB, WS_P = 27 * MiB, WS_QB = 133 * MiB, WS_KB = 149 * MiB, WS_VB = 166 * MiB, WS_X = 190 * MiB, WS_MIX = 223 * MiB, WS_END = 256 * MiB;
static_assert(WS_P + (size_t)MPAD * NP2 * 2 <= WS_QB && WS_QB + (size_t)MREAL * 512 * 2 <= WS_KB && WS_KB + (size_t)NB * KVROWS * 512 * 2 <= WS_VB && WS_VB + (size_t)NB * KVROWS * 512 * 2 <= WS_X, "ws map");
static_assert(WS_X + (size_t)NB * 4 * NCH * 16384 * 2 <= WS_MIX && WS_X + (size_t)MPAD * D * 2 <= WS_MIX + 0 * MiB + 33 * MiB && WS_MIX + (size_t)MREAL * D * 2 <= WS_END, "ST / HN / MIX");

constexpr int LDS_BYTES = 140 * 1024;

struct Params {
    const float *x, *meta, *mix_norm, *w_in, *idx_g, *idx_b, *attn_norm, *lb_logits, *hgrn_norm, *w_out, *final_norm;
    float* out; unsigned char* ws;
};

__device__ __forceinline__ float wave_sum(float v) {
#pragma unroll
    for (int o = 1; o < 64; o <<= 1) v += __shfl_xor(v, o);
    return v;
}
__device__ __forceinline__ float wave_max(float v) {
#pragma unroll
    for (int o = 1; o < 64; o <<= 1) v = fmaxf(v, __shfl_xor(v, o));
    return v;
}
__device__ __forceinline__ float sigmoidf_(float x) { return 1.f / (1.f + __expf(-x)); }
__device__ __forceinline__ float siluf_(float x) { return x * sigmoidf_(x); }
__device__ __forceinline__ int oldcol(int n) { return n < 2560 ? n : (n < 4608 ? n + 72 : (n < 4672 ? 2560 + (n - 4608) : 2624 + (n - 4672))); }
__device__ __forceinline__ unsigned skey(float x) { if (x == 0.f) x = 0.f; unsigned u = __float_as_uint(x); return (u & 0x80000000u) ? ~u : (u | 0x80000000u); }

__device__ __forceinline__ void transpose_item(const float* __restrict__ W, int ldw, int nvalid, bool remap, h16* __restrict__ WT, int K, int item, float* tile) {
    constexpr float C2 = 0.125f * 1.4426950408889634f;
    const int nkt = K / 64, nb = item / nkt, kb = item % nkt, n0 = nb * 64, k0 = kb * 64, tid = threadIdx.x;
    {
        const int nl = tid & 63, kl = tid >> 6, n = n0 + nl;
        int src = -1; if (n < nvalid) src = remap ? oldcol(n) : n;
        const float scl = (remap && n < 512) ? C2 : 1.f;
        for (int kk = kl; kk < 64; kk += 8) tile[kk * 65 + nl] = (src >= 0) ? W[(size_t)(k0 + kk) * ldw + src] * scl : 0.f;
    }
    __syncthreads();
    {
        const int kl = tid & 63, nl = tid >> 6;
        for (int nn = nl; nn < 64; nn += 8) WT[(size_t)(n0 + nn) * K + k0 + kl] = (h16)tile[kl * 65 + nn];
    }
    __syncthreads();
}

__device__ __forceinline__ void phase_prep(const Params& p, char* lds) {
    float* tile = (float*)lds;
    h16* WTin = (h16*)(p.ws + WS_WTIN); h16* WTout = (h16*)(p.ws + WS_WTOUT);
    constexpr int I_IN = (NPAD / 64) * (D / 64), I_OUT = (D / 64) * (D / 64);
    for (int it = blockIdx.x; it < I_IN + I_OUT; it += gridDim.x) {
        if (it < I_IN) transpose_item(p.w_in, NCOL, NCOL, true, WTin, D, it, tile);
        else transpose_item(p.w_out, D, D, false, WTout, D, it - I_IN, tile);
    }
    h16* HN = (h16*)(p.ws + WS_X);
    const int lane = threadIdx.x & 63, wave = threadIdx.x >> 6;
    for (int row = blockIdx.x * 8 + wave; row < MPAD; row += gridDim.x * 8) {
        h16* o = HN + (size_t)row * D;
        if (row >= MROWS) {
            for (int j = 0; j < 4; ++j) { h16x4 z = {(h16)0.f, (h16)0.f, (h16)0.f, (h16)0.f}; *(h16x4*)(o + (lane + 64 * j) * 4) = z; }
            continue;
        }
        const float* src = row < MREAL ? p.x + (size_t)row * D : p.meta + (size_t)(row - MREAL) * D;
        f32x4 v[4]; float ss = 0.f;
        for (int j = 0; j < 4; ++j) { v[j] = *(const f32x4*)(src + (lane + 64 * j) * 4); ss += v[j].x * v[j].x + v[j].y * v[j].y + v[j].z * v[j].z + v[j].w * v[j].w; }
        const float rs = rsqrtf(wave_sum(ss) * (1.f / D) + 1e-6f);
        for (int j = 0; j < 4; ++j) {
            const f32x4 g = *(const f32x4*)(p.mix_norm + (lane + 64 * j) * 4);
            h16x4 hv = {(h16)(v[j].x * rs * g.x), (h16)(v[j].y * rs * g.y), (h16)(v[j].z * rs * g.z), (h16)(v[j].w * rs * g.w)};
            *(h16x4*)(o + (lane + 64 * j) * 4) = hv;
        }
    }
    {
        h16* KB = (h16*)(p.ws + WS_KB); h16* VB = (h16*)(p.ws + WS_VB);
        for (int idx = blockIdx.x * NT + threadIdx.x; idx < NB * 112 * 64; idx += gridDim.x * NT) {
            const int c = idx & 63, rr = (idx >> 6) % 112, b = idx / (112 * 64);
            const int row = b * KVROWS + (rr < 48 ? 16 + rr : 8256 + (rr - 48));
            const h16x8 z = {(h16)0.f, (h16)0.f, (h16)0.f, (h16)0.f, (h16)0.f, (h16)0.f, (h16)0.f, (h16)0.f};
            *(h16x8*)(KB + (size_t)row * 512 + c * 8) = z; *(h16x8*)(VB + (size_t)row * 512 + c * 8) = z;
        }
    }
    float* ROPE = (float*)(p.ws + WS_ROPE);
    const double inv[8] = {1.0, 0.1939227432012558, 0.03760603070259094, 0.007292664609849453, 0.0014142135623842478, 0.00027424818836152554, 5.3182957344688475e-05, 1.0313385246263351e-05};
    for (int idx = blockIdx.x * NT + threadIdx.x; idx < (S + NMETA) * 8; idx += gridDim.x * NT) {
        const int t = idx >> 3, i = idx & 7;
        double iv = inv[0];
        if (i == 1) iv = inv[1]; else if (i == 2) iv = inv[2]; else if (i == 3) iv = inv[3]; else if (i == 4) iv = inv[4]; else if (i == 5) iv = inv[5]; else if (i == 6) iv = inv[6]; else if (i == 7) iv = inv[7];
        const double rev = (double)t * iv * 0.15915494309189535;
        const float fr = (float)(rev - __builtin_rint(rev));
        ROPE[idx * 2] = __builtin_amdgcn_cosf(fr); ROPE[idx * 2 + 1] = __builtin_amdgcn_sinf(fr);
    }
}

namespace pg8 {
#define PG8_LAS __attribute__((address_space(3)))
typedef unsigned short bf16_t;
typedef short bf16x8 __attribute__((ext_vector_type(8)));
typedef unsigned u32x4 __attribute__((ext_vector_type(4)));
constexpr int BM = 256, BK = 64, HALF = 128, HTB = HALF * BK * 2  , STAGE_BYTES = 8 * HTB, NXCD = 8, WGM = 8;

__host__ __device__ __forceinline__ int lds_byte(int r, int c) { const int st = (r >> 4) * 2 + (c >> 5), rr = r & 15, cc = c & 31, ob = rr * 64 + cc * 2; return st * 1024 + (ob ^ (((ob >> 9) & 1) << 5)); }
__host__ __device__ __forceinline__ void stage_rc(int b, int& R, int& C) { const int st = b / 1024, sb = b % 1024, swz = sb ^ (((sb >> 9) & 1) << 5); R = (st >> 1) * 16 + swz / 64; C = (st & 1) * 32 + (swz % 64) / 2; }
__host__ __device__ __forceinline__ int perm32(int rho) { const int n = rho >> 4, i = rho & 15; return 8 * (i >> 2) + 4 * n + (i & 3); }

struct Unit { int pm, pn; };
struct Gemm { const bf16_t* A; const bf16_t* Bt; int M, N, K; };

struct StaticOrder {
    int nM, nN, nwg, G, c;
    __host__ __device__ void init(int M, int N, int G_, int c_) { nM = M / BM; nN = N / BM; nwg = nM * nN; G = G_; c = c_; }
    __host__ __device__ bool next(int i, Unit& u) const {
        const long L = (long)i * G + c; if (L >= nwg) return false;
        int wgid = (int)L; { const int q = nwg / NXCD, r = nwg % NXCD, xcd = wgid % NXCD, off = wgid / NXCD; wgid = (xcd < r ? xcd * (q + 1) : r * (q + 1) + (xcd - r) * q) + off; }
        const int nig = WGM * nN, gid = wgid / nig, fm = gid * WGM, gsz = (nM - fm) < WGM ? (nM - fm) : WGM;
        u.pm = fm + ((wgid % nig) % gsz); u.pn = (wgid % nig) / gsz; return true;
    }
    __device__ __forceinline__ void a_ready(const Unit&) const {}
    __device__ __forceinline__ void done(const Unit&) const {}
};


struct EpiProj {
    static constexpr bool PERM = true, AFTER_DRAIN = false;
    unsigned char* ws;
    __device__ __forceinline__ void operator()(const f32x4 (&acc)[2][2][4][2], const Unit& u, int wr, int wc, int fr, int fq) const {
        const int row0 = u.pm * BM + wr * 64 + fr, colt = u.pn * BM + wc * 32 + 8 * fq;
#pragma unroll
        for (int ai = 0; ai < 2; ++ai)
#pragma unroll
            for (int m = 0; m < 4; ++m) {
                const int grow = row0 + ai * HALF + m * 16;
#pragma unroll
                for (int bj = 0; bj < 2; ++bj) {
                    const int gcol = colt + bj * HALF;
                    const f32x4 v0 = acc[ai][bj][m][0], v1 = acc[ai][bj][m][1];
                    h16x8 hv = {(h16)v0[0], (h16)v0[1], (h16)v0[2], (h16)v0[3], (h16)v1[0], (h16)v1[1], (h16)v1[2], (h16)v1[3]};
                    if (u.pn == 14 || u.pn == 15) {
                        typedef __bf16 b16x8 __attribute__((ext_vector_type(8)));
                        const b16x8 bv = {(__bf16)v0[0], (__bf16)v0[1], (__bf16)v0[2], (__bf16)v0[3], (__bf16)v1[0], (__bf16)v1[1], (__bf16)v1[2], (__bf16)v1[3]};
                        hv = __builtin_bit_cast(h16x8, bv);
                    }
                    if (gcol < 512) { if (grow < MREAL) *(h16x8*)((h16*)(ws + WS_QB) + (size_t)grow * 512 + gcol) = hv; }
                    else if (gcol < 1536) {
                        h16* dst = (h16*)(ws + (gcol < 1024 ? WS_KB : WS_VB)); const int cc = (gcol - 512) & 511;
                        if (grow < MREAL) *(h16x8*)(dst + ((size_t)(grow >> 13) * KVROWS + 64 + (grow & (S - 1))) * 512 + cc) = hv;
                        else if (grow < MROWS) { *(h16x8*)(dst + (size_t)(grow - MREAL) * 512 + cc) = hv; *(h16x8*)(dst + ((size_t)KVROWS + (grow - MREAL)) * 512 + cc) = hv; }
                    } else {
                        *(h16x8*)((h16*)(ws + WS_P) + (size_t)grow * NP2 + (gcol - 1536)) = hv;
                        if (gcol >= G_IK && gcol < G_IK + 128) { float* e = (float*)(ws + WS_E) + (size_t)grow * 128 + (gcol - G_IK); *(f32x4*)e = v0; *(f32x4*)(e + 4) = v1; }
                    }
                }
            }
    }
};
struct EpiOut {
    static constexpr bool PERM = false, AFTER_DRAIN = false;
    const float* x; float* out;
    __device__ __forceinline__ void operator()(const f32x4 (&acc)[2][2][4][2], const Unit& u, int wr, int wc, int fr, int fq) const {
        const int row0 = u.pm * BM + wr * 64 + fr, col0 = u.pn * BM + wc * 32 + 4 * fq;
#pragma unroll
        for (int ai = 0; ai < 2; ++ai)
#pragma unroll
            for (int m = 0; m < 4; ++m) {
                const size_t off = (size_t)(row0 + ai * HALF + m * 16) * D + col0;
#pragma unroll
                for (int bj = 0; bj < 2; ++bj)
#pragma unroll
                    for (int n = 0; n < 2; ++n) { const f32x4 xv = *(const f32x4*)(x + off + bj * HALF + n * 16); *(f32x4*)(out + off + bj * HALF + n * 16) = xv + acc[ai][bj][m][n]; }
            }
    }
};
template <class Epi, class Sched, bool ALIGN_EPI = false, bool SP2 = false>
__device__ __forceinline__ void gemm_phase(PG8_LAS unsigned char* lds, const Gemm g, const Sched& S, const Epi& E) {
    const int tid = threadIdx.x, wid = __builtin_amdgcn_readfirstlane(tid >> 6), lane = tid & 63, wr = wid >> 2, wc = wid & 3, fr = lane & 15, fq = lane >> 4;
    const int K = g.K, nt = K / BK;
    unsigned voffA[2], voffB[2];
#pragma unroll
    for (int i = 0; i < 2; ++i) { int R, C; stage_rc(tid * 16 + i * 8192, R, C); const int Rb = Epi::PERM ? ((R & ~31) + perm32(R & 31)) : R;
        voffA[i] = (unsigned)(R * K + C) * 2u; voffB[i] = (unsigned)(Rb * K + C) * 2u; }
    const size_t kstep = (size_t)(BK * 2);
    const size_t hstep = (size_t)HALF * K * 2;
    const size_t tstep = 2 * hstep;
    const unsigned ldsw = (unsigned)wid * 1024u;
    const int aoff = lds_byte(wr * 64 + fr, fq * 8), boff = lds_byte(wc * 32 + fr, fq * 8);
#define PG8_SA(b, h) (((b) * 2 + (h)) * HTB)
#define PG8_SB(b, h) ((4 + (b) * 2 + (h)) * HTB)
#define PG8_STAGE(bufoff, gbase, voff) do { _Pragma("unroll") for (int _i = 0; _i < 2; ++_i) \
        __builtin_amdgcn_global_load_lds((const unsigned*)((const char*)(gbase) + (voff)[_i]), (PG8_LAS unsigned*)(lds + (bufoff) + ldsw + _i * 8192), 16, 0, 0); } while (0)
#define PG8_LDA(dst, b, h) do { _Pragma("unroll") for (int m = 0; m < 4; ++m) _Pragma("unroll") for (int k = 0; k < 2; ++k) dst[m][k] = *(const PG8_LAS bf16x8*)(lds + PG8_SA(b, h) + aoff + m * 2048 + k * 1024); } while (0)
#define PG8_LDB(dst, b, h) do { _Pragma("unroll") for (int n = 0; n < 2; ++n) _Pragma("unroll") for (int k = 0; k < 2; ++k) dst[n][k] = *(const PG8_LAS bf16x8*)(lds + PG8_SB(b, h) + boff + n * 2048 + k * 1024); } while (0)
#define PG8_MMA(ai, bj, At, Bt) do { __builtin_amdgcn_s_setprio(1); _Pragma("unroll") for (int m = 0; m < 4; ++m) _Pragma("unroll") for (int n = 0; n < 2; ++n) _Pragma("unroll") for (int k = 0; k < 2; ++k) \
        acc[ai][bj][m][n] = __builtin_amdgcn_mfma_f32_16x16x32_f16(__builtin_bit_cast(h16x8, Bt[n][k]), __builtin_bit_cast(h16x8, At[m][k]), acc[ai][bj][m][n], 0, 0, 0); __builtin_amdgcn_s_setprio(0); } while (0)
#define PG8_WAIT_V(n) asm volatile("s_waitcnt vmcnt(" #n ")" ::: "memory")
#define PG8_WAIT_L(n) asm volatile("s_waitcnt lgkmcnt(" #n ")" ::: "memory")
#define PG8_BAR __builtin_amdgcn_s_barrier()
#define PG8_SCHED __builtin_amdgcn_sched_barrier(0)
    Unit cur, nxt; int ui = 0;
    if (!S.next(0, cur)) return;
    f32x4 acc[2][2][4][2];
#pragma unroll
    for (int a = 0; a < 2; ++a)
#pragma unroll
        for (int b = 0; b < 2; ++b)
#pragma unroll
            for (int m = 0; m < 4; ++m)
#pragma unroll
                for (int n = 0; n < 2; ++n) acc[a][b][m][n] = (f32x4){0.f, 0.f, 0.f, 0.f};
    bf16x8 At[4][2], B0[2][2], B1[2][2];
    const char* cA = (const char*)g.A + (size_t)cur.pm * tstep; const char* cB = (const char*)g.Bt + (size_t)cur.pn * tstep;
    S.a_ready(cur);
    if constexpr (SP2) {
        PG8_STAGE(PG8_SB(0, 0), cB, voffB); PG8_STAGE(PG8_SB(0, 1), cB + hstep, voffB); PG8_STAGE(PG8_SA(0, 0), cA, voffA); PG8_STAGE(PG8_SA(0, 1), cA + hstep, voffA);
        if (wr == 1) PG8_BAR;
        PG8_WAIT_V(2); PG8_BAR;
        PG8_STAGE(PG8_SB(1, 0), cB + kstep, voffB); PG8_STAGE(PG8_SA(1, 0), cA + kstep, voffA); PG8_STAGE(PG8_SB(1, 1), cB + hstep + kstep, voffB);
        PG8_WAIT_V(6); PG8_BAR;
    } else {
        PG8_STAGE(PG8_SB(0, 0), cB, voffB); PG8_STAGE(PG8_SA(0, 0), cA, voffA); PG8_STAGE(PG8_SB(0, 1), cB + hstep, voffB); PG8_STAGE(PG8_SA(0, 1), cA + hstep, voffA);
        if (wr == 1) PG8_BAR;
        PG8_WAIT_V(4); PG8_BAR;
        PG8_STAGE(PG8_SB(1, 0), cB + kstep, voffB); PG8_STAGE(PG8_SA(1, 0), cA + kstep, voffA); PG8_STAGE(PG8_SB(1, 1), cB + hstep + kstep, voffB);
        PG8_WAIT_V(6); PG8_BAR;
    }
    for (;;) {
        const bool has_next = S.next(ui + 1, nxt);
        const char* nA = has_next ? (const char*)g.A + (size_t)nxt.pm * tstep : cA; const char* nB = has_next ? (const char*)g.Bt + (size_t)nxt.pn * tstep : cB;
        for (int t = 0; t < nt; t += 2) {
            const bool last = (t == nt - 2);
            const char* a1 = cA + (size_t)(t + 1) * kstep;
            const char* a2 = last ? nA : cA + (size_t)(t + 2) * kstep; const char* b2 = last ? nB : cB + (size_t)(t + 2) * kstep;
            const char* a3 = a2 + kstep; const char* b3 = b2 + kstep;
            if (last && has_next) S.a_ready(nxt);
            if constexpr (SP2) {
            PG8_LDB(B0, 0, 0); PG8_LDB(B1, 0, 1); PG8_SCHED; PG8_LDA(At, 0, 0); PG8_STAGE(PG8_SA(1, 1), a1 + hstep, voffA);
            PG8_WAIT_V(8); PG8_WAIT_L(0); PG8_BAR; PG8_MMA(0, 0, At, B0); PG8_MMA(0, 1, At, B1); PG8_BAR; PG8_SCHED;
            PG8_LDA(At, 0, 1); PG8_STAGE(PG8_SB(0, 0), b2, voffB); PG8_STAGE(PG8_SB(0, 1), b2 + hstep, voffB); PG8_STAGE(PG8_SA(0, 0), a2, voffA);
            PG8_WAIT_V(8); PG8_WAIT_L(0); PG8_BAR; PG8_MMA(1, 0, At, B0); PG8_MMA(1, 1, At, B1); PG8_BAR; PG8_SCHED;
            PG8_LDB(B0, 1, 0); PG8_LDB(B1, 1, 1); PG8_SCHED; PG8_LDA(At, 1, 0); PG8_STAGE(PG8_SA(0, 1), a2 + hstep, voffA);
            PG8_WAIT_V(8); PG8_WAIT_L(0); PG8_BAR; PG8_MMA(0, 0, At, B0); PG8_MMA(0, 1, At, B1); PG8_BAR; PG8_SCHED;
            PG8_LDA(At, 1, 1); PG8_STAGE(PG8_SB(1, 0), b3, voffB); PG8_STAGE(PG8_SB(1, 1), b3 + hstep, voffB); PG8_STAGE(PG8_SA(1, 0), a3, voffA);
            PG8_WAIT_V(8); PG8_WAIT_L(0); PG8_BAR; PG8_MMA(1, 0, At, B0); PG8_MMA(1, 1, At, B1); PG8_BAR; PG8_SCHED;
            } else {
            PG8_LDB(B0, 0, 0); PG8_SCHED; PG8_LDA(At, 0, 0); PG8_STAGE(PG8_SA(1, 1), a1 + hstep, voffA);
            PG8_WAIT_L(8); PG8_BAR; PG8_WAIT_L(0); PG8_MMA(0, 0, At, B0); PG8_BAR; PG8_SCHED;
            PG8_LDB(B1, 0, 1); PG8_STAGE(PG8_SB(0, 0), b2, voffB);
            PG8_BAR; PG8_WAIT_L(0); PG8_MMA(0, 1, At, B1); PG8_BAR;
            PG8_LDA(At, 0, 1); PG8_STAGE(PG8_SA(0, 0), a2, voffA);
            PG8_BAR; PG8_WAIT_L(0); PG8_MMA(1, 0, At, B0); PG8_BAR; PG8_SCHED;
            PG8_STAGE(PG8_SB(0, 1), b2 + hstep, voffB);
            PG8_WAIT_V(6); PG8_BAR; PG8_MMA(1, 1, At, B1); PG8_BAR;
            PG8_LDB(B0, 1, 0); PG8_SCHED; PG8_LDA(At, 1, 0); PG8_STAGE(PG8_SA(0, 1), a2 + hstep, voffA);
            PG8_WAIT_L(8); PG8_BAR; PG8_WAIT_L(0); PG8_MMA(0, 0, At, B0); PG8_BAR; PG8_SCHED;
            PG8_LDB(B1, 1, 1); PG8_STAGE(PG8_SB(1, 0), b3, voffB);
            PG8_BAR; PG8_WAIT_L(0); PG8_MMA(0, 1, At, B1); PG8_BAR;
            PG8_LDA(At, 1, 1); PG8_STAGE(PG8_SA(1, 0), a3, voffA);
            PG8_BAR; PG8_WAIT_L(0); PG8_MMA(1, 0, At, B0); PG8_BAR; PG8_SCHED;
            PG8_STAGE(PG8_SB(1, 1), b3 + hstep, voffB);
            PG8_WAIT_V(6); PG8_BAR; PG8_MMA(1, 1, At, B1); PG8_BAR;
            }
        }
        if constexpr (ALIGN_EPI) { if (wr == 0) PG8_BAR; }
        if constexpr (!Epi::AFTER_DRAIN) { E(acc, cur, wr, wc, fr, fq); S.done(cur); }
        if (!has_next) break;
#pragma unroll
        for (int a = 0; a < 2; ++a)
#pragma unroll
            for (int b = 0; b < 2; ++b)
#pragma unroll
                for (int m = 0; m < 4; ++m)
#pragma unroll
                    for (int n = 0; n < 2; ++n) acc[a][b][m][n] = (f32x4){0.f, 0.f, 0.f, 0.f};
        cur = nxt; cA = nA; cB = nB; ++ui;
        if constexpr (ALIGN_EPI) { if (wr == 1) PG8_BAR; }
    }
    PG8_WAIT_V(0);
    if constexpr (!ALIGN_EPI) { if (wr == 0) PG8_BAR; }
    PG8_BAR;
    if constexpr (Epi::AFTER_DRAIN) { E.fused(acc, cur, wr, wc, fr, fq, lds, wid, lane); S.done(cur); }
#undef PG8_SA
#undef PG8_SB
#undef PG8_STAGE
#undef PG8_LDA
#undef PG8_LDB
#undef PG8_MMA
#undef PG8_WAIT_V
#undef PG8_WAIT_L
#undef PG8_BAR
#undef PG8_SCHED
}
}

__device__ __forceinline__ void phase_gemm_in(const Params& p, char* lds) {
    pg8::Gemm g{(const pg8::bf16_t*)(p.ws + WS_X), (const pg8::bf16_t*)(p.ws + WS_WTIN), MPAD, NPAD, D};
    pg8::StaticOrder So; So.init(MPAD, NPAD, (int)gridDim.x, (int)blockIdx.x);
    pg8::EpiProj E{p.ws};
    pg8::gemm_phase<pg8::EpiProj, pg8::StaticOrder, true, true>((PG8_LAS unsigned char*)lds, g, So, E);
}
__device__ __forceinline__ void phase_gemm_out(const Params& p, char* lds) {
    pg8::Gemm g{(const pg8::bf16_t*)(p.ws + WS_MIX), (const pg8::bf16_t*)(p.ws + WS_WTOUT), MREAL, D, D};
    pg8::StaticOrder So; So.init(MREAL, D, (int)gridDim.x, (int)blockIdx.x);
    pg8::EpiOut E{p.x, p.out};
    pg8::gemm_phase<pg8::EpiOut, pg8::StaticOrder, true, true>((PG8_LAS unsigned char*)lds, g, So, E);
}

__device__ __forceinline__ void phase_post(const Params& p) {
    h16* P = (h16*)(p.ws + WS_P); const float* E = (const float*)(p.ws + WS_E); h16* KI = (h16*)(p.ws + WS_KI); const float* ROPE = (const float*)(p.ws + WS_ROPE);
    h16* QBf = (h16*)(p.ws + WS_QB); h16* KBf = (h16*)(p.ws + WS_KB);
    const int lane = threadIdx.x & 63, wave = threadIdx.x >> 6;
    for (int row = blockIdx.x * 8 + wave; row < MROWS; row += gridDim.x * 8) {
        const int t = row < MREAL ? NMETA + (row & (S - 1)) : row - MREAL;
        {
            const int head = lane >> 3, i = lane & 7;
            const float c = ROPE[(t * 8 + i) * 2], s = ROPE[(t * 8 + i) * 2 + 1];
            auto rope2 = [&](h16* base) { h16* pr = base + head * 64; const float x1 = (float)pr[i], x2 = (float)pr[i + 8]; pr[i] = (h16)(x1 * c - x2 * s); pr[i + 8] = (h16)(x2 * c + x1 * s); };
            if (row < MREAL) { rope2(QBf + (size_t)row * 512); rope2(P + (size_t)row * NP2 + C_IQ); rope2(KBf + ((size_t)(row >> 13) * KVROWS + 64 + (row & (S - 1))) * 512); }
            else { rope2(KBf + (size_t)(row - MREAL) * 512); rope2(KBf + ((size_t)KVROWS + (row - MREAL)) * 512); }
        }
        const float v = E[(size_t)row * 128 + lane];
        const float mean = wave_sum(v) * (1.f / 64.f); const float d = v - mean;
        const float var = wave_sum(d * d) * (1.f / 64.f);
        float y = d * rsqrtf(var + 1e-6f) * p.idx_g[lane] + p.idx_b[lane];
        const float other = __shfl_xor(y, 8);
        if (lane < 16) {
            const int i = lane & 7; const float c = ROPE[(t * 8 + i) * 2], s = ROPE[(t * 8 + i) * 2 + 1];
            y = lane < 8 ? (y * c - other * s) : (y * c + other * s);
        }
        KI[(size_t)row * 64 + lane] = (h16)y;
    }
}

constexpr int NMI = 130;
constexpr int QB = 32, CAP = 128;
constexpr int IX_KB = 0, IX_HIST = 32768, IX_MASK = 32768  , IX_CAND = 98304, IX_CANDI = 114688, IX_ST = 131072, IX_FLAG = 132096;
constexpr int HROW = 512;
typedef float f32x16 __attribute__((ext_vector_type(16)));
#define ST_LO 0
#define ST_HI 1
#define ST_NEED 2
#define ST_CNT 3
#define ST_FLAGS 4
#define ST_NCAND 5
#define ST_SH 6
#define ST_RUN 7
#define FL_ACTIVE 1u
#define FL_TIE 2u

__device__ __forceinline__ float relu_(float x) { return __builtin_amdgcn_fmed3f(x, 0.f, __builtin_inff()); }
__device__ __forceinline__ unsigned skey_c(float x) { const unsigned u = __float_as_uint(x); return u ^ (((unsigned)((int)u >> 31)) | 0x80000000u); }
__device__ __forceinline__ int custom_bin(unsigned key) {
    const int k14 = (int)(key >> 18); const int a = k14 - 11488, bb = k14 - 3873;
    const int lowpart = min(max(bb, 0), 511);
    return max(min(a, 1023), lowpart);
}

__device__ __forceinline__ void glds16(const void* gsrc, unsigned lds_dst) { unsigned keep;
    asm volatile("s_mov_b32 %0, m0\n\ts_mov_b32 m0, %2\n\ts_nop 0\n\tglobal_load_lds_dwordx4 %1, off\n\ts_mov_b32 m0, %0" : "=&s"(keep) : "v"(gsrc), "s"(lds_dst) : "memory"); }

struct IdxLane { unsigned loA, hiA, loB, hiB, flA, flB, shA, shB, needA, needB, runA, runB; int qA, qB, rA, rB; bool anyTie; };

template <int MODE, bool DIAG>
__device__ __forceinline__ void idx_tile(char* lds, const char* kb, int t, const h16x8 (&afrag)[4], const float (&wreg)[16], IdxLane& L) {
    unsigned* HIST = (unsigned*)(lds + IX_HIST); unsigned* MASK = (unsigned*)(lds + IX_MASK); unsigned* CAND = (unsigned*)(lds + IX_CAND); unsigned* CANDI = (unsigned*)(lds + IX_CANDI); unsigned* ST = (unsigned*)(lds + IX_ST);
    const int lane = threadIdx.x & 63, w = threadIdx.x >> 6, hl = lane >> 5, cc = lane & 31;
    h16x8 bf[2][4];
#pragma unroll
    for (int kh = 0; kh < 2; ++kh)
#pragma unroll
        for (int ks = 0; ks < 4; ++ks) { const int ki = 32 * kh + cc; bf[kh][ks] = *(const h16x8*)(kb + ki * 128 + (((2 * ks + hl) ^ ((ki >> 1) & 7)) << 4)); }
    f32x16 accs[2];
    accs[0] = (f32x16){0.f, 0.f, 0.f, 0.f, 0.f, 0.f, 0.f, 0.f, 0.f, 0.f, 0.f, 0.f, 0.f, 0.f, 0.f, 0.f}; accs[1] = accs[0];
#pragma unroll
    for (int ks = 0; ks < 4; ++ks) { accs[0] = __builtin_amdgcn_mfma_f32_32x32x16_f16(afrag[ks], bf[0][ks], accs[0], 0, 0, 0); accs[1] = __builtin_amdgcn_mfma_f32_32x32x16_f16(afrag[ks], bf[1][ks], accs[1], 0, 0, 0); }
#pragma unroll
    for (int kh = 0; kh < 2; ++kh) {
        const f32x16 acc = accs[kh];
        float pq[4];
#pragma unroll
        for (int q4 = 0; q4 < 4; ++q4)
            pq[q4] = __builtin_fmaf(wreg[4 * q4 + 3], relu_(acc[4 * q4 + 3]), __builtin_fmaf(wreg[4 * q4 + 2], relu_(acc[4 * q4 + 2]), __builtin_fmaf(wreg[4 * q4 + 1], relu_(acc[4 * q4 + 1]), __builtin_fmaf(wreg[4 * q4], relu_(acc[4 * q4]), 0.f))));
        const auto r01 = __builtin_amdgcn_permlane32_swap(__float_as_uint(pq[0]), __float_as_uint(pq[1]), false, false);
        const auto r23 = __builtin_amdgcn_permlane32_swap(__float_as_uint(pq[2]), __float_as_uint(pq[3]), false, false);
        const float sA = __uint_as_float(r01[0]) + __uint_as_float(r01[1]);
        const float sB = __uint_as_float(r23[0]) + __uint_as_float(r23[1]);
        const int sidx = 64 * t + 32 * kh + cc;
        const bool vA = DIAG ? (sidx <= L.rA) : true, vB = DIAG ? (sidx <= L.rB) : true;
        const unsigned kA = skey_c(sA), kB = skey_c(sB);
        if (MODE == 0) {
            const int bA = custom_bin(kA), bB = custom_bin(kB);
            if (vA) atomicAdd(&HIST[L.qA * HROW + (bA >> 1)], 1u << (16 * (bA & 1)));
            if (vB) atomicAdd(&HIST[L.qB * HROW + (bB >> 1)], 1u << (16 * (bB & 1)));
        } else if (MODE == 1) {
            if (vA && (L.flA & FL_ACTIVE) && (kA - L.loA) <= (L.hiA - L.loA)) { const unsigned sb = (kA - L.loA) >> L.shA; atomicAdd(&HIST[L.qA * HROW + (sb >> 1)], 1u << (16 * (sb & 1))); }
            if (vB && (L.flB & FL_ACTIVE) && (kB - L.loB) <= (L.hiB - L.loB)) { const unsigned sb = (kB - L.loB) >> L.shB; atomicAdd(&HIST[L.qB * HROW + (sb >> 1)], 1u << (16 * (sb & 1))); }
        } else {
            bool selA = vA && kA > L.hiA, selB = vB && kB > L.hiB;
            const bool inA = vA && (kA - L.loA) <= (L.hiA - L.loA), inB = vB && (kB - L.loB) <= (L.hiB - L.loB);
            if (L.anyTie) {
                const unsigned long long eA = __ballot(inA && (L.flA & FL_TIE)), eB = __ballot(inB && (L.flB & FL_TIE));
                const unsigned pA = hl ? (unsigned)(eA >> 32) : (unsigned)eA, pB = hl ? (unsigned)(eB >> 32) : (unsigned)eB;
                const unsigned below = (1u << cc) - 1u;
                if (inA && (L.flA & FL_TIE) && L.runA + __popc(pA & below) < L.needA) selA = true;
                if (inB && (L.flB & FL_TIE) && L.runB + __popc(pB & below) < L.needB) selB = true;
                L.runA += __popc(pA); L.runB += __popc(pB);
            }
            if (inA && !(L.flA & FL_TIE)) { const unsigned pos = atomicAdd(&ST[L.qA * 8 + ST_NCAND], 1u); if (pos < CAP) { CAND[L.qA * CAP + pos] = kA; CANDI[L.qA * CAP + pos] = (unsigned)sidx; } }
            if (inB && !(L.flB & FL_TIE)) { const unsigned pos = atomicAdd(&ST[L.qB * 8 + ST_NCAND], 1u); if (pos < CAP) { CAND[L.qB * CAP + pos] = kB; CANDI[L.qB * CAP + pos] = (unsigned)sidx; } }
            const unsigned long long mA = __ballot(selA), mB = __ballot(selB);
            const unsigned val = lane == 0 ? (unsigned)mA : (lane == 1 ? (unsigned)(mA >> 32) : (lane == 2 ? (unsigned)mB : (unsigned)(mB >> 32)));
            if (lane < 4) MASK[(4 * w + lane) * 260 + (t + 1) * 2 + kh] = val;
        }
    }
}

template <int MODE>
__device__ __forceinline__ void idx_pass(const Params& p, int b, int u, char* lds, const h16x8 (&afrag)[4], const float (&wreg)[16]) {
    const h16* KI = (const h16*)(p.ws + WS_KI) + (size_t)b * S * 64;
    unsigned* ST = (unsigned*)(lds + IX_ST);
    const int tid = threadIdx.x, lane = tid & 63, hl = lane >> 5; const int w = __builtin_amdgcn_readfirstlane(tid >> 6);
    const int tq = u >> 1;
    IdxLane L{};
    L.qA = 4 * w + hl; L.qB = 4 * w + 2 + hl; L.rA = 32 * u + L.qA; L.rB = 32 * u + L.qB;
    if (MODE != 0) { L.loA = ST[L.qA * 8 + ST_LO]; L.hiA = ST[L.qA * 8 + ST_HI]; L.flA = ST[L.qA * 8 + ST_FLAGS]; L.shA = ST[L.qA * 8 + ST_SH]; L.needA = ST[L.qA * 8 + ST_NEED];
                     L.loB = ST[L.qB * 8 + ST_LO]; L.hiB = ST[L.qB * 8 + ST_HI]; L.flB = ST[L.qB * 8 + ST_FLAGS]; L.shB = ST[L.qB * 8 + ST_SH]; L.needB = ST[L.qB * 8 + ST_NEED]; }
    L.anyTie = (MODE == 2) && (__ballot((L.flA | L.flB) & FL_TIE) != 0ull);
    const int si = 8 * w + (lane >> 3);
    const h16* ksrc = KI + (size_t)si * 64 + (((lane & 7) ^ ((si >> 1) & 7)) << 3);
    const unsigned lds0 = (unsigned)(uintptr_t)lds + IX_KB + (unsigned)w * 1024u;
#define IDX_DMA(tt) glds16(ksrc + (size_t)(tt) * 64 * 64, (unsigned)__builtin_amdgcn_readfirstlane(lds0 + (unsigned)((tt) & 3) * 8192u))
#define IDX_WAIT(N) asm volatile("s_waitcnt vmcnt(" #N ") lgkmcnt(0)\n\ts_barrier" ::: "memory")
    IDX_DMA(0); if (tq >= 1) IDX_DMA(1); if (tq >= 2) IDX_DMA(2);
    if (tq >= 2) IDX_WAIT(2); else if (tq == 1) IDX_WAIT(1); else IDX_WAIT(0);
    for (int t = 0; t < tq; ++t) {
        if (t + 3 <= tq) IDX_DMA(t + 3);
        idx_tile<MODE, false>(lds, lds + IX_KB + (t & 3) * 8192, t, afrag, wreg, L);
        if (t + 3 <= tq) IDX_WAIT(2); else if (t + 2 <= tq) IDX_WAIT(1); else IDX_WAIT(0);
    }
    idx_tile<MODE, true>(lds, lds + IX_KB + (tq & 3) * 8192, tq, afrag, wreg, L);
    IDX_WAIT(0);
#undef IDX_DMA
#undef IDX_WAIT
}

template <int MODE>
__device__ __forceinline__ void idx_scan(char* lds) {
    unsigned* HIST = (unsigned*)(lds + IX_HIST); unsigned* ST = (unsigned*)(lds + IX_ST); unsigned* FLAG = (unsigned*)(lds + IX_FLAG);
    const int lane = threadIdx.x & 63, w = threadIdx.x >> 6;
    for (int q4 = 0; q4 < 4; ++q4) {
        const int q = 4 * w + q4;
        const unsigned fl = ST[q * 8 + ST_FLAGS];
        if (MODE == 1 && !(fl & FL_ACTIVE)) continue;
        const unsigned need = ST[q * 8 + ST_NEED], lo = ST[q * 8 + ST_LO], hi = ST[q * 8 + ST_HI], sh = ST[q * 8 + ST_SH];
        unsigned c[16];
#pragma unroll
        for (int j = 0; j < 8; ++j) { const unsigned d = HIST[q * HROW + 8 * lane + j]; c[2 * j] = d & 0xFFFFu; c[2 * j + 1] = d >> 16; HIST[q * HROW + 8 * lane + j] = 0u; }
        unsigned tl = 0;
#pragma unroll
        for (int k = 0; k < 16; ++k) tl += c[k];
        unsigned Ssum = tl;
#pragma unroll
        for (int o = 1; o < 64; o <<= 1) { const unsigned v = __shfl_down(Ssum, o); if (lane + o < 64) Ssum += v; }
        const unsigned above = Ssum - tl;
        if (above < need && need <= Ssum) {
            unsigned cum = above; int bstar = 16 * lane; unsigned cnt = 0; bool found = false;
#pragma unroll
            for (int k = 15; k >= 0; --k) { if (!found) { if (cum + c[k] >= need) { bstar = 16 * lane + k; cnt = c[k]; found = true; } else cum += c[k]; } }
            const unsigned nneed = need - cum;
            unsigned nlo, nhi;
            if (MODE == 0) {
                if (bstar >= 512) { nlo = (unsigned)(bstar + 11488) << 18; nhi = bstar == 1023 ? 0xFFFFFFFFu : (nlo | 0x3FFFFu); }
                else if (bstar == 511) { nlo = 4384u << 18; nhi = (11999u << 18) | 0x3FFFFu; }
                else { nhi = ((unsigned)(bstar + 3873) << 18) | 0x3FFFFu; nlo = bstar == 0 ? 0u : ((unsigned)(bstar + 3873) << 18); }
            } else {
                nlo = lo + ((unsigned)bstar << sh); const unsigned top = nlo + ((1u << sh) - 1u); nhi = top < hi ? top : hi; if (top < nlo) nhi = hi;
            }
            const unsigned range = nhi - nlo;
            unsigned nfl = 0, nsh = 0;
            if (nlo < nhi && cnt > CAP) { nfl = FL_ACTIVE; const int bits = 32 - __clz(range); nsh = bits > 10 ? (unsigned)(bits - 10) : 0u; *FLAG = 1u; }
            else if (cnt > CAP) nfl = FL_TIE;
            ST[q * 8 + ST_LO] = nlo; ST[q * 8 + ST_HI] = nhi; ST[q * 8 + ST_NEED] = nneed; ST[q * 8 + ST_CNT] = cnt; ST[q * 8 + ST_FLAGS] = nfl; ST[q * 8 + ST_SH] = nsh;
        }
    }
}

__device__ __forceinline__ void idx_unit(const Params& p, int b, int u, char* lds, int dry = 0) {
    const h16* P = (const h16*)(p.ws + WS_P); const float* E = (const float*)(p.ws + WS_E);
    unsigned long long* Mk = (unsigned long long*)p.out + (dry ? (size_t)(36u << 20) / 8 : 0);
    unsigned* HIST = (unsigned*)(lds + IX_HIST); unsigned* MASK = (unsigned*)(lds + IX_MASK); unsigned* CAND = (unsigned*)(lds + IX_CAND); unsigned* ST = (unsigned*)(lds + IX_ST); unsigned* FLAG = (unsigned*)(lds + IX_FLAG);
    const int tid = threadIdx.x, lane = tid & 63, w = tid >> 6, hl = lane >> 5, cc = lane & 31;
    const int qb = u >> 3, nwords = 4 * qb + 6;
    if (32 * u + 31 < 256) {
        for (int idx = tid; idx < 32 * nwords; idx += NT) {
            const int q = idx & 31, i = idx >> 5, r = 32 * u + q;
            unsigned long long wv;
            if (i == 0) wv = 0xFFFFull; else { const int nv = r - 64 * (i - 1) + 1; wv = nv <= 0 ? 0ull : (nv >= 64 ? ~0ull : ((1ull << nv) - 1ull)); }
            Mk[((size_t)b * NMI + i) * S + r] = wv;
        }
        return;
    }
    for (int i = tid; i < 32 * HROW; i += NT) HIST[i] = 0u;
    if (tid < 32) { ST[tid * 8 + ST_LO] = 0u; ST[tid * 8 + ST_HI] = 0xFFFFFFFFu; ST[tid * 8 + ST_NEED] = 256u; ST[tid * 8 + ST_CNT] = 0u; ST[tid * 8 + ST_FLAGS] = 0u; ST[tid * 8 + ST_NCAND] = 0u; ST[tid * 8 + ST_SH] = 0u; ST[tid * 8 + ST_RUN] = 0u; }
    if (tid == 0) *FLAG = 0u;
    h16x8 afrag[4]; float wreg[16];
    {
        const int qq = cc >> 3, head = cc & 7;
        const size_t row = (size_t)b * S + 32 * u + 4 * w + qq;
#pragma unroll
        for (int ks = 0; ks < 4; ++ks) afrag[ks] = *(const h16x8*)(P + row * NP2 + C_IQ + head * 64 + 16 * ks + 8 * hl);
#pragma unroll
        for (int q4 = 0; q4 < 4; ++q4) { const f32x4 wv = *(const f32x4*)(E + ((size_t)b * S + 32 * u + 4 * w + q4) * 128 + 64 + 4 * hl); wreg[4 * q4] = wv.x; wreg[4 * q4 + 1] = wv.y; wreg[4 * q4 + 2] = wv.z; wreg[4 * q4 + 3] = wv.w; }
    }
#pragma unroll
    for (int ks = 0; ks < 4; ++ks) asm volatile("" : "+v"(afrag[ks]));
#pragma unroll
    for (int i = 0; i < 16; ++i) asm volatile("" : "+v"(wreg[i]));
    __syncthreads();
#if PROBE == 9
    idx_pass<0>(p, b, u, lds, afrag, wreg);
    for (int i = tid; i < 32 * HROW; i += NT) HIST[i] = 0u;
    __syncthreads();
#endif
    if (!dry) idx_pass<0>(p, b, u, lds, afrag, wreg);
    idx_scan<0>(lds);
    __syncthreads();
    for (int iter = 0; iter < 8; ++iter) {
        if (*FLAG == 0u || PROBE == 14) break;
        __syncthreads();
        if (tid == 0) *FLAG = 0u;
        __syncthreads();
        if (!dry) idx_pass<1>(p, b, u, lds, afrag, wreg);
        idx_scan<1>(lds);
        __syncthreads();
    }
    for (int i = tid; i < 32 * 260; i += NT) MASK[i] = 0u;
    __syncthreads();
    if (!dry) idx_pass<2>(p, b, u, lds, afrag, wreg);
#if PROBE == 8
    if (tid < 32) ST[tid * 8 + ST_NCAND] = 0u;
    __syncthreads();
    idx_pass<2>(p, b, u, lds, afrag, wreg);
#endif
    for (int rrep = 0; rrep < (PROBE == 13 ? 2 : 1); ++rrep)
    for (int q4 = 0; q4 < 4; ++q4) {
        const int q = 4 * w + q4;
        const unsigned fl = ST[q * 8 + ST_FLAGS]; if (fl & FL_TIE) continue;
        unsigned nc = ST[q * 8 + ST_NCAND]; if (nc > CAP) nc = CAP;
        const unsigned need = ST[q * 8 + ST_NEED], lo = ST[q * 8 + ST_LO];
        (void)lo;
        const unsigned* CANDI = (const unsigned*)(lds + IX_CANDI);
        const unsigned k0 = lane < nc ? CAND[q * CAP + lane] : 0u, k1 = lane + 64 < nc ? CAND[q * CAP + lane + 64] : 0u;
        const unsigned i0 = lane < nc ? CANDI[q * CAP + lane] : 0u, i1 = lane + 64 < nc ? CANDI[q * CAP + lane + 64] : 0u;
        unsigned r0 = 0, r1 = 0;
        for (unsigned j = 0; j < nc; ++j) { const unsigned kj = CAND[q * CAP + j], ij = CANDI[q * CAP + j];
            r0 += (kj > k0 || (kj == k0 && ij < i0)) ? 1u : 0u; r1 += (kj > k1 || (kj == k1 && ij < i1)) ? 1u : 0u; }
        if (lane < nc && r0 < need) { const int s = (int)i0; atomicOr(&MASK[q * 260 + ((s >> 6) + 1) * 2 + ((s >> 5) & 1)], 1u << (s & 31)); }
        if (lane + 64 < nc && r1 < need) { const int s = (int)i1; atomicOr(&MASK[q * 260 + ((s >> 6) + 1) * 2 + ((s >> 5) & 1)], 1u << (s & 31)); }
    }
    __syncthreads();
    for (int idx = tid; idx < 32 * nwords; idx += NT) {
        const int q = idx & 31, i = idx >> 5, r = 32 * u + q;
        const unsigned long long wv = i == 0 ? 0xFFFFull : ((unsigned long long)MASK[q * 260 + 2 * i] | ((unsigned long long)MASK[q * 260 + 2 * i + 1] << 32));
        Mk[((size_t)b * NMI + i) * S + r] = wv;
    }
    __syncthreads();
}

namespace attn_body {
using bf16=_Float16;
typedef _Float16 fh16x8 __attribute__((ext_vector_type(8)));
typedef unsigned u32x2 __attribute__((ext_vector_type(2)));
#define MFH(a,b,c,x,y,z) __builtin_amdgcn_mfma_f32_32x32x16_f16(__builtin_bit_cast(fh16x8,(a)),__builtin_bit_cast(fh16x8,(b)),(c),0,0,0)
using bf16x8=__attribute__((ext_vector_type(8)))short;
using s16x4=__attribute__((ext_vector_type(4)))short;
using f32x16=__attribute__((ext_vector_type(16)))float;
using u32x4=__attribute__((ext_vector_type(4)))unsigned;
constexpr int BATCH=2,NHEAD=8,SEQ=8192,D=64,DM=NHEAD*D,KVROWS=8320,NMI_=130;
constexpr int NW=8,QBLK=32,QB=QBLK*NW,KVBLK=64,NQB=SEQ/QB;
constexpr int ATTN_PITCH=DM, ATTN_UNIT_ROWS=QB;
__device__ __forceinline__ int crow(int r,int hi){return (r&3)+8*(r>>2)+4*hi;}
#define SBAR() __builtin_amdgcn_sched_barrier(0)
__device__ __forceinline__ float msel(int m,int pos,float keepv){ const int t=__builtin_amdgcn_sbfe(m,pos,1); float d; asm("v_bfi_b32 %0, %1, %2, %3":"=v"(d):"v"(t),"v"(keepv),"s"(0xFF800000u)); return d; }
__device__ __forceinline__ void cinit(f32x16&p0,f32x16&p1,const u32x2&m,int hi,float nmh){
  const int m0=(int)(m[0]>>(4*hi)), m1=(int)(m[1]>>(4*hi));
  #pragma unroll
  for(int r=0;r<16;++r){ const int pos=(r&3)+8*(r>>2); p0[r]=msel(m0,pos,nmh); p1[r]=msel(m1,pos,nmh); }
  asm volatile("s_nop 1":"+v"(p0),"+v"(p1));
}
__device__ __forceinline__ void mload(u32x2&m,const unsigned long long*p){ asm volatile("global_load_dwordx2 %0, %1, off":"=v"(m):"v"(p):"memory"); }
constexpr int NSLOT=3, SLOTB=8192;
constexpr int LDS_K=0, LDS_V=NSLOT*SLOTB, LDS_WS=2*NSLOT*SLOTB, LDS_OST=LDS_WS+NW*64*4, LDS_BYTES=LDS_OST+NW*4096;
constexpr float C2=0.125f*1.4426950408889634f;
__device__ __forceinline__ void glds16(const void*gsrc,unsigned lds_dst){unsigned keep;
  asm volatile("s_mov_b32 %0, m0\n\ts_mov_b32 m0, %2\n\ts_nop 0\n\tglobal_load_lds_dwordx4 %1, off\n\ts_mov_b32 m0, %0":"=&s"(keep):"v"(gsrc),"s"(lds_dst):"memory");}
__device__ __forceinline__ float max3f(float a,float b,float c){float r;asm("v_max3_f32 %0, %1, %2, %3":"=v"(r):"v"(a),"v"(b),"v"(c));return r;}
__device__ __forceinline__ float max2f(float a,float b){float r;asm("v_max_f32_e32 %0, %1, %2":"=v"(r):"v"(a),"v"(b));return r;}
__device__ __forceinline__ float fadd_s(float a,float b){float r;asm("v_add_f32_e32 %0, %1, %2":"=v"(r):"v"(a),"v"(b));return r;}
__device__ __forceinline__ float fsub_s(float a,float b){float r;asm("v_sub_f32_e32 %0, %1, %2":"=v"(r):"v"(a),"v"(b));return r;}
typedef float f32x2_t __attribute__((ext_vector_type(2))); typedef _Float16 bf16x2_t __attribute__((ext_vector_type(2)));
__device__ __forceinline__ unsigned cvtpk_s(float lo,float hi){f32x2_t v={lo,hi};bf16x2_t b=__builtin_convertvector(v,bf16x2_t);return __builtin_bit_cast(unsigned,b);}
#define WAIT_BAR(N) asm volatile("s_waitcnt vmcnt(" #N ") lgkmcnt(0)\n\ts_barrier":::"memory")
#define WAIT_BAR_M(N,M) do{ asm volatile("s_waitcnt vmcnt(" #N ") lgkmcnt(0)\n\ts_barrier":::"memory"); __builtin_amdgcn_sched_barrier(0); asm volatile("":"+v"(M)); }while(0)
#define WAIT_BAR_M2(N,M,M2) do{ asm volatile("s_waitcnt vmcnt(" #N ") lgkmcnt(0)\n\ts_barrier":::"memory"); __builtin_amdgcn_sched_barrier(0); asm volatile("":"+v"(M),"+v"(M2)); }while(0)

__device__ __forceinline__ void qkt(f32x16&p0,f32x16&p1,const char*Kslot,const bf16x8*qr,int r32,int hi){
  const char*kb=Kslot+hi*1024+r32*16;
  #pragma unroll
  for(int d0=0;d0<4;++d0){
    const bf16x8 b0=*reinterpret_cast<const bf16x8*>(kb+d0*2048);
    const bf16x8 b1=*reinterpret_cast<const bf16x8*>(kb+d0*2048+512);
    p0=MFH(b0,qr[d0],p0,0,0,0);p1=MFH(b1,qr[d0],p1,0,0,0);}
}
typedef __attribute__((address_space(3))) const char* lds_cptr;
typedef short v4i16_t __attribute__((ext_vector_type(4)));
__device__ __forceinline__ void kload8(bf16x8*kf,lds_cptr kp){
  kf[0]=*(const __attribute__((address_space(3))) bf16x8*)(kp);      kf[1]=*(const __attribute__((address_space(3))) bf16x8*)(kp+512);
  kf[2]=*(const __attribute__((address_space(3))) bf16x8*)(kp+2048); kf[3]=*(const __attribute__((address_space(3))) bf16x8*)(kp+2560);
  kf[4]=*(const __attribute__((address_space(3))) bf16x8*)(kp+4096); kf[5]=*(const __attribute__((address_space(3))) bf16x8*)(kp+4608);
  kf[6]=*(const __attribute__((address_space(3))) bf16x8*)(kp+6144); kf[7]=*(const __attribute__((address_space(3))) bf16x8*)(kp+6656);
}
__device__ __forceinline__ void kload2(bf16x8*kf,lds_cptr kp,int j){ kf[2*j]=*(const __attribute__((address_space(3))) bf16x8*)(kp+j*2048); kf[2*j+1]=*(const __attribute__((address_space(3))) bf16x8*)(kp+j*2048+512); }
__device__ __forceinline__ s16x4 vtr(lds_cptr p){ return __builtin_bit_cast(s16x4,__builtin_amdgcn_ds_read_tr16_b64_v4i16((__attribute__((address_space(3))) v4i16_t*)p)); }
__device__ __forceinline__ float rowmax(const f32x16&p0,const f32x16&p1){
  float a=max3f(p0[0],p0[1],p1[0]),b=max3f(p0[2],p0[3],p1[1]);a=max3f(a,p1[2],p1[3]);
  #pragma unroll
  for(int r=4;r<16;r+=4){a=max3f(a,p0[r],p0[r+1]);b=max3f(b,p0[r+2],p0[r+3]);a=max3f(a,p1[r],p1[r+1]);b=max3f(b,p1[r+2],p1[r+3]);}
  const float m=max2f(a,b);
  auto rr=__builtin_amdgcn_permlane32_swap(__float_as_uint(m),__float_as_uint(m),false,false);
  return max2f(__uint_as_float(rr[0]),__uint_as_float(rr[1]));
}
__device__ __forceinline__ void pv(f32x16*o,int vb,bf16x8 pa0,bf16x8 pa1,bf16x8 pa2,bf16x8 pa3){
  #pragma unroll
  for(int d0=0;d0<2;++d0){s16x4 lo[4],hi[4];
    #pragma unroll
    for(int ks=0;ks<4;++ks){
      asm volatile("ds_read_b64_tr_b16 %0,%1 offset:%c2":"=&v"(lo[ks]):"v"(vb),"i"(d0*4096+ks*1024):"memory");
      asm volatile("ds_read_b64_tr_b16 %0,%1 offset:%c2":"=&v"(hi[ks]):"v"(vb),"i"(d0*4096+ks*1024+512):"memory");}
    asm volatile("s_waitcnt lgkmcnt(0)":::"memory");SBAR();
    #define PK(k) (bf16x8){lo[k][0],lo[k][1],lo[k][2],lo[k][3],hi[k][0],hi[k][1],hi[k][2],hi[k][3]}
    o[d0]=MFH(pa0,PK(0),o[d0],0,0,0);
    o[d0]=MFH(pa1,PK(1),o[d0],0,0,0);
    o[d0]=MFH(pa2,PK(2),o[d0],0,0,0);
    o[d0]=MFH(pa3,PK(3),o[d0],0,0,0);
    #undef PK
  }
}

#ifndef ATTN_STORE16
#define ATTN_STORE16(p,v) (*(u32x4*)(p)=(v))
#endif
template<int THRL> __device__ __forceinline__ void attn_unit(int b,int h,int qb,const bf16*Q,const bf16*__restrict__ K,const bf16*__restrict__ V,bf16*O,const unsigned long long*__restrict__ Mk,char*shm){
  const int tid=threadIdx.x,lane=tid&63,r32=lane&31,hi=lane>>5; const int wid=__builtin_amdgcn_readfirstlane(tid>>6);
  const long rowbase=(long)b*SEQ, kvbase=(long)b*KVROWS; const int q0=qb*QB;
  const bf16*Qw=Q+(rowbase+q0+wid*QBLK)*DM+h*D;
  const bf16*Kh=K+kvbase*DM+h*D,*Vh=V+kvbase*DM+h*D;
  const unsigned long long*mrow=Mk+(long)b*NMI_*SEQ+(q0+wid*QBLK+r32);
  u32x2 mA,mB; mload(mA,mrow); mload(mB,mrow+SEQ);
  const unsigned lds0=(unsigned)(uintptr_t)shm;
  float*wsf=(float*)(shm+LDS_WS)+wid*64;
  const bf16*ksrc=Kh+(long)lane*DM+wid*8;
  const bf16*vsrc=Vh+(long)(16*(wid&3)+(lane>>2))*DM+(wid>>2)*32+(lane&3)*8;
  const unsigned kdst=lds0+LDS_K+wid*1024, vdst=lds0+LDS_V+wid*1024;
  #define DMA_K(t,slot) glds16(ksrc+(long)(t)*KVBLK*DM,(unsigned)__builtin_amdgcn_readfirstlane(kdst+(slot)))
  #define DMA_V(t,slot) glds16(vsrc+(long)(t)*KVBLK*DM,(unsigned)__builtin_amdgcn_readfirstlane(vdst+(slot)))
  const int vb0=(int)(lds0+LDS_V)+((lane>>4)&1)*32+(lane&3)*8+(4*hi+((lane&15)>>2))*64;
  const char*Kbase=shm+LDS_K; bf16x8 kf[8];
  const lds_cptr shm3=(lds_cptr)shm; const lds_cptr kp0=shm3+LDS_K+hi*1024+r32*16; const lds_cptr vp0=shm3+LDS_V+((lane>>4)&1)*32+(lane&3)*8+(4*hi+((lane&15)>>2))*64;
  const int NT=(q0+QB)/KVBLK+2;
  DMA_K(0,0);DMA_V(0,0);DMA_K(1,SLOTB);
  bf16x8 qr[4];
  #pragma unroll
  for(int d0=0;d0<4;++d0)qr[d0]=*reinterpret_cast<const bf16x8*>(&Qw[(long)r32*DM+d0*16+hi*8]);
  float mhat=0.f,l_reg=0.f;f32x16 o[2];o[0]=f32x16{};o[1]=f32x16{};
  const int qrel=wid*QBLK+r32;
  bool resc=false;
  #define START(P0,P1) do{ const float rm=rowmax(P0,P1); resc=false; \
    { const float dl=rm; mhat=fadd_s(mhat,dl); \
      _Pragma("unroll") for(int r=0;r<16;++r){P0[r]=fsub_s(P0[r],dl);P1[r]=fsub_s(P1[r],dl);} \
      } \
    _Pragma("unroll") for(int r=0;r<16;++r)P0[r]=__builtin_amdgcn_exp2f(P0[r]); }while(0)
  #define RESC() do{ if(resc){ asm volatile("s_waitcnt lgkmcnt(0)":::"memory"); \
      _Pragma("unroll") for(int d_=0;d_<2;++d_) _Pragma("unroll") for(int r=0;r<16;++r)o[d_][r]*=wsf[crow(r,hi)]; } }while(0)
  f32x16 pA0,pA1,pB0,pB1;
  int sl_prev=0,sl_cur=0,sl_next=SLOTB;
  #define ROT() do{sl_prev=sl_cur;sl_cur=sl_next;sl_next=(sl_next==(NSLOT-1)*SLOTB)?0:sl_next+SLOTB;}while(0)
  DMA_K(2,2*SLOTB);
  WAIT_BAR_M2(3,mA,mB);
  cinit(pA0,pA1,mA,hi,0.f);qkt(pA0,pA1,Kbase,qr,r32,hi);asm volatile("s_nop 15\n\ts_nop 7":"+v"(pA0),"+v"(pA1));
  START(pA0,pA1);
  _Pragma("unroll") for(int r=0;r<16;++r)pA1[r]=__builtin_amdgcn_exp2f(pA1[r]);
  WAIT_BAR(0);
  DMA_K(3,0);DMA_V(1,SLOTB);
  ROT();
  kload8(kf,kp0+sl_cur);
  WAIT_BAR(2);
  s16x4 vlo[8],vhi[8]; u32x4 pw0,pw1,pw2,pw3;
  #define PKW(P,B) cvtpk_s(P[B],P[B+1])
  #define PAF(k) __builtin_bit_cast(bf16x8,pw##k)
  #define VFR(i) (bf16x8){vlo[i][0],vlo[i][1],vlo[i][2],vlo[i][3],vhi[i][0],vhi[i][1],vhi[i][2],vhi[i][3]}
  #define PIN(x) asm volatile("":"+v"(x))
  #define MX3(a,b,c) __builtin_fmaxf(__builtin_fmaxf((a),(b)),(c))
  #define GAPA(MF,A0,A1,A2,A3,W0,W1,PW) do{ MF; sacc+=A0; sacc+=A1; sacc+=A2; sacc+=A3; PIN(sacc); W0; W1; PIN(PW); SBAR(); }while(0)
  #define EX(v) __builtin_amdgcn_exp2f(v)
  #define GAPB(MF,X,B) do{ MF; X[B]=EX(X[B]); X[B+1]=EX(X[B+1]); X[B+2]=EX(X[B+2]); X[B+3]=EX(X[B+3]); PIN(X); SBAR(); }while(0)
  #define VRD(i) do{ vlo[i]=vtr(vp_+(((i)>>2)*4096+((i)&3)*1024)); vhi[i]=vtr(vp_+(((i)>>2)*4096+((i)&3)*1024+512)); }while(0)
  #define KRD(G,j) do{ if(G){ kload2(kf,kp0+sl_next,j); SBAR(); } }while(0)
  #define STEP(C0,C1,P0,P1,t,GK,GV,GL,MC,MN,GM) do{ SBAR(); \
    if(GM){mload(MN,mrow+(long)((t)+1)*SEQ);} \
    cinit(C0,C1,MC,hi,-mhat); SBAR(); \
    const lds_cptr vp_=vp0+sl_prev; \
    VRD(0); SBAR(); float sacc=(P0[0]+P0[1]); \
    GAPA(C0=MFH(kf[0],qr[0],C0,0,0,0), P0[2],P0[3],P0[4],P0[5],     pw0[0]=PKW(P0,0), pw0[1]=PKW(P0,2), pw0); \
    VRD(4); SBAR(); GAPA(C1=MFH(kf[1],qr[0],C1,0,0,0), P0[6],P0[7],P0[8],P0[9],     pw0[2]=PKW(P0,4), pw0[3]=PKW(P0,6), pw0); \
    VRD(1); SBAR(); GAPA(C0=MFH(kf[2],qr[1],C0,0,0,0),   P0[10],P0[11],P0[12],P0[13], pw1[0]=PKW(P0,8), pw1[1]=PKW(P0,10), pw1); \
    VRD(5); SBAR(); GAPA(C1=MFH(kf[3],qr[1],C1,0,0,0),   P0[14],P0[15],P1[0],P1[1],   pw1[2]=PKW(P0,12),pw1[3]=PKW(P0,14), pw1); \
    VRD(2); SBAR(); GAPA(C0=MFH(kf[4],qr[2],C0,0,0,0),   P1[2],P1[3],P1[4],P1[5],     pw2[0]=PKW(P1,0), pw2[1]=PKW(P1,2), pw2); \
    VRD(6); SBAR(); GAPA(C1=MFH(kf[5],qr[2],C1,0,0,0),   P1[6],P1[7],P1[8],P1[9],     pw2[2]=PKW(P1,4), pw2[3]=PKW(P1,6), pw2); \
    VRD(3); SBAR(); GAPA(C0=MFH(kf[6],qr[3],C0,0,0,0),   P1[10],P1[11],P1[12],P1[13], pw3[0]=PKW(P1,8), pw3[1]=PKW(P1,10), pw3); \
    VRD(7); SBAR(); GAPA(C1=MFH(kf[7],qr[3],C1,0,0,0),   P1[14],P1[15],0.f,0.f,       pw3[2]=PKW(P1,12),pw3[3]=PKW(P1,14), pw3); \
    l_reg+=sacc; \
    if(GK){DMA_K((t)+3,sl_cur);} if(GV){DMA_V((t)+1,sl_next);} \
    { float a=MX3(C0[0],C0[1],C1[0]),b=MX3(C0[2],C0[3],C1[1]); a=MX3(a,C1[2],C1[3]); \
      _Pragma("unroll") for(int r=4;r<16;r+=4){a=MX3(a,C0[r],C0[r+1]);b=MX3(b,C0[r+2],C0[r+3]);a=MX3(a,C1[r],C1[r+1]);b=MX3(b,C1[r+2],C1[r+3]);} \
      float rm=__builtin_fmaxf(a,b); { auto rr=__builtin_amdgcn_permlane32_swap(__float_as_uint(rm),__float_as_uint(rm),false,false); rm=__builtin_fmaxf(__uint_as_float(rr[0]),__uint_as_float(rr[1])); } \
      resc=false; \
      if(__builtin_expect(__any(rm>(float)THRL),0)){ const float dl=__builtin_fmaxf(rm,0.f); mhat+=dl; \
        _Pragma("unroll") for(int r=0;r<16;++r){C0[r]-=dl;C1[r]-=dl;} \
        const float f=__builtin_amdgcn_exp2f(-dl); l_reg*=f; if(hi==0)wsf[r32]=f; resc=true; } } \
    SBAR(); \
    GAPB(o[0]=MFH(PAF(0),VFR(0),o[0],0,0,0), C0,0); \
    GAPB(o[1]=MFH(PAF(0),VFR(4),o[1],0,0,0), C0,4); \
    KRD(GL,0); GAPB(o[0]=MFH(PAF(1),VFR(1),o[0],0,0,0), C0,8); \
    KRD(GL,1); GAPB(o[1]=MFH(PAF(1),VFR(5),o[1],0,0,0), C0,12); \
    KRD(GL,2); GAPB(o[0]=MFH(PAF(2),VFR(2),o[0],0,0,0), C1,0); \
    KRD(GL,3); GAPB(o[1]=MFH(PAF(2),VFR(6),o[1],0,0,0), C1,4); \
    GAPB(o[0]=MFH(PAF(3),VFR(3),o[0],0,0,0), C1,8); \
    GAPB(o[1]=MFH(PAF(3),VFR(7),o[1],0,0,0), C1,12); \
    }while(0)
  int t=1;
  for(;t+5<NT;t+=2){
    STEP(pB0,pB1,pA0,pA1,t,true,true,true,mB,mA,true);     WAIT_BAR_M(2,mA); RESC(); ROT();
    STEP(pA0,pA1,pB0,pB1,t+1,true,true,true,mA,mB,true);   WAIT_BAR_M(2,mB); RESC(); ROT();
  }
  #define ENDW(tt,M) do{ if((tt)+3<NT){WAIT_BAR_M(2,M);} else if((tt)+2<NT){WAIT_BAR_M(1,M);} else {WAIT_BAR_M(0,M);} }while(0)
  for(;t+1<NT;t+=2){
    STEP(pB0,pB1,pA0,pA1,t,(t+3<NT),(t+1<NT),(t+1<NT),mB,mA,(t+1<NT));       ENDW(t,mA);   RESC(); ROT();
    STEP(pA0,pA1,pB0,pB1,t+1,(t+4<NT),(t+2<NT),(t+2<NT),mA,mB,(t+2<NT));     ENDW(t+1,mB); RESC(); ROT();
  }
  STEP(pB0,pB1,pA0,pA1,NT-1,false,false,false,mB,mA,false); RESC();
  { float sacc=pB0[0]+pB0[1]; _Pragma("unroll") for(int r=2;r<16;++r)sacc+=pB0[r]; _Pragma("unroll") for(int r=0;r<16;++r)sacc+=pB1[r]; l_reg+=sacc;
    pw0=(u32x4){PKW(pB0,0),PKW(pB0,2),PKW(pB0,4),PKW(pB0,6)};pw1=(u32x4){PKW(pB0,8),PKW(pB0,10),PKW(pB0,12),PKW(pB0,14)};pw2=(u32x4){PKW(pB1,0),PKW(pB1,2),PKW(pB1,4),PKW(pB1,6)};pw3=(u32x4){PKW(pB1,8),PKW(pB1,10),PKW(pB1,12),PKW(pB1,14)};
    SBAR(); pv(o,vb0+sl_cur,PAF(0),PAF(1),PAF(2),PAF(3)); }
  #undef PKW
  #undef PAF
  #undef VFR
  #undef PIN
  #undef MX3
  #undef GAPA
  #undef GAPB
  #undef EX
  #undef VRD
  #undef KRD
  #undef STEP
  #undef ENDW
  {auto rr=__builtin_amdgcn_permlane32_swap(__float_as_uint(l_reg),__float_as_uint(l_reg),false,false);l_reg=__uint_as_float(rr[0])+__uint_as_float(rr[1]);}
  if(hi==0)wsf[32+r32]=l_reg;asm volatile("s_waitcnt lgkmcnt(0)":::"memory");
  float rli[16];
  #pragma unroll
  for(int r=0;r<16;++r)rli[r]=__builtin_amdgcn_rcpf(wsf[32+crow(r,hi)]);
  bf16*Ow=O+(rowbase+q0+wid*QBLK)*DM+h*D;
  { bf16*stg=(bf16*)(shm+LDS_OST)+wid*2048;
    #pragma unroll
    for(int r=0;r<16;++r){const int orow=crow(r,hi);
      #pragma unroll
      for(int d0=0;d0<2;++d0)stg[orow*64+d0*32+r32]=(bf16)(o[d0][r]*rli[r]);}
    asm volatile("s_waitcnt lgkmcnt(0)":::"memory");
    #pragma unroll
    for(int i=0;i<4;++i){const int row=i*8+(lane>>3),ch=lane&7; const u32x4 v=*(const u32x4*)(stg+row*64+ch*8); ATTN_STORE16(Ow+(long)row*DM+ch*8,v);} }
  asm volatile("s_waitcnt lgkmcnt(0)\n\ts_barrier":::"memory");
  #undef DMA_K
  #undef DMA_V
  #undef START
  #undef RESC
  #undef ROT
}
constexpr int ATTN_LDS_BYTES=LDS_BYTES;
struct AttnTensors { const bf16* Q; const bf16* K; const bf16* V; bf16* O; const unsigned long long* Mk; };
struct AttnUnit { int bh; int qb; };
struct StaticOrder {
  int vcu,G;
  __device__ __forceinline__ explicit StaticOrder(int grid,int block):vcu((grid%8==0)?((block%8)*(grid/8)+block/8):block),G(grid){}
  __device__ __forceinline__ bool next(int i,AttnUnit&u)const{ const int v=vcu+G*(i>>1); if(v>=256)return false; const int s=v&15; u.bh=v>>4; u.qb=(i&1)?s:31-s; return true; }
};
template<class Sched,int THRL=8> __device__ __forceinline__ void attn_phase(char*lds,const AttnTensors&T,const Sched&S){
  AttnUnit u;
  for(int i=0;S.next(i,u);++i){ attn_unit<THRL>(u.bh/NHEAD,u.bh%NHEAD,u.qb,T.Q,T.K,T.V,T.O,T.Mk,lds); }
}
#undef SBAR
#undef WAIT_BAR
#undef WAIT_BAR_M
#undef WAIT_BAR_M2
#undef MFH
}

typedef __bf16 bf16;
typedef __bf16 bf16x8 __attribute__((ext_vector_type(8)));
typedef __bf16 bf16x4 __attribute__((ext_vector_type(4)));
typedef __bf16 bf16x2 __attribute__((ext_vector_type(2)));
typedef short s16x4_t __attribute__((ext_vector_type(4)));
typedef short s16x8_t __attribute__((ext_vector_type(8)));
typedef LAS const char* lcptr;
constexpr int HVP = 272;
constexpr int HAP = 144;
__device__ __forceinline__ float hgrn_lb(const Params& p, int idx) { const float l0 = p.lb_logits[idx], l1 = p.lb_logits[512 + idx]; return 1.f / (1.f + __expf(l1 - l0)); }
__device__ __forceinline__ bf16x8 tr_frag(lcptr plo, lcptr phi) {
    const s16x4_t lo = __builtin_amdgcn_ds_read_tr16_b64_v4i16((LAS s16x4_t*)plo), hi = __builtin_amdgcn_ds_read_tr16_b64_v4i16((LAS s16x4_t*)phi);
    return __builtin_bit_cast(bf16x8, (s16x8_t){lo[0], lo[1], lo[2], lo[3], hi[0], hi[1], hi[2], hi[3]});
}
__device__ __forceinline__ void hgrn_fb(const Params& p, const h16* P, size_t rowbase, int h, int d, int g, int L, float (&cs)[16], float (&kk)[16], float* gtot) {
    const float lb = hgrn_lb(p, h * 128 + d);
    float run = 0.f;
#pragma unroll
    for (int i = 0; i < 16; ++i) {
        const int t = 16 * g + i;
        if (t < L) { const float hf = (float)P[(rowbase + t) * NP2 + C_HF + h * 128 + d]; const float f = lb + (1.f - lb) * sigmoidf_(hf); run += __logf(f); kk[i] = 1.f - f; }
        else kk[i] = 0.f;
        cs[i] = run;
    }
    gtot[g * 128 + d] = run;
}
__device__ __forceinline__ void hgrn_load_v(const bf16* Pb, size_t rowbase, int h, int L, char* vs) {
    for (int idx = threadIdx.x; idx < 64 * 16; idx += NT) {
        const int t = idx >> 4, c16 = idx & 15;
        bf16x8 v = {};
        if (t < L) v = *(const bf16x8*)(Pb + (rowbase + t) * NP2 + C_HI + h * 128 + c16 * 8);
        *(bf16x8*)(vs + t * HVP + c16 * 16) = v;
    }
}

constexpr int HA_VS = 0, HA_KT = 17408, HA_GT = 35840;
__device__ __forceinline__ void hgrn_stepA(const Params& p, int item, char* lds) {
    const h16* P = (const h16*)(p.ws + WS_P); bf16* ST = (bf16*)(p.ws + WS_X); float* G = (float*)(p.ws + WS_G);
    float* gtot = (float*)(lds + HA_GT);
    const int tid = threadIdx.x, d = tid & 127, g = tid >> 7;
    const int c = item % NCH, bh = item / NCH, h = bh & 3, b = bh >> 2;
    const int L = c == 0 ? 16 : 64; const size_t rowbase = c == 0 ? (size_t)MREAL : (size_t)(b * S + (c - 1) * 64);
    hgrn_load_v((const bf16*)P, rowbase, h, L, lds + HA_VS);
    float cs[16], kk[16];
    hgrn_fb(p, P, rowbase, h, d, g, L, cs, kk, gtot);
    __syncthreads();
    {
        const float t0 = gtot[d], t1 = gtot[128 + d], t2 = gtot[256 + d], t3 = gtot[384 + d];
        const float bend = (t0 + t1) + (t2 + t3), off = g == 0 ? 0.f : (g == 1 ? t0 : (g == 2 ? t0 + t1 : t0 + t1 + t2));
        bf16x8 o0, o1;
#pragma unroll
        for (int i = 0; i < 8; ++i) { o0[i] = (bf16)(kk[i] * __expf(bend - (off + cs[i]))); o1[i] = (bf16)(kk[8 + i] * __expf(bend - (off + cs[8 + i]))); }
        *(bf16x8*)(lds + HA_KT + d * HAP + 32 * g) = o0; *(bf16x8*)(lds + HA_KT + d * HAP + 32 * g + 16) = o1;
        if (g == 0) G[(size_t)item * 128 + d] = __expf(bend);
    }
    __syncthreads();
    const int w = tid >> 6, lane = tid & 63, hl = lane >> 5, r32 = lane & 31;
    const int dt = w >> 1, vt0 = 2 * (w & 1);
    f32x16 acc0 = {0.f, 0.f, 0.f, 0.f, 0.f, 0.f, 0.f, 0.f, 0.f, 0.f, 0.f, 0.f, 0.f, 0.f, 0.f, 0.f}, acc1 = acc0;
    const lcptr vbase = (lcptr)(lds + HA_VS) + (8 * hl + ((lane & 15) >> 2)) * HVP + (16 * ((lane >> 4) & 1) + 4 * (lane & 3)) * 2;
#pragma unroll
    for (int ks = 0; ks < 4; ++ks) {
        const bf16x8 a = *(const bf16x8*)(lds + HA_KT + (32 * dt + r32) * HAP + (16 * ks + 8 * hl) * 2);
        const lcptr pv0 = vbase + (16 * ks) * HVP + (32 * vt0) * 2, pv1 = pv0 + 64;
        const bf16x8 b0 = tr_frag(pv0, pv0 + 4 * HVP), b1 = tr_frag(pv1, pv1 + 4 * HVP);
        acc0 = __builtin_amdgcn_mfma_f32_32x32x16_bf16(a, b0, acc0, 0, 0, 0);
        acc1 = __builtin_amdgcn_mfma_f32_32x32x16_bf16(a, b1, acc1, 0, 0, 0);
    }
    bf16* o = ST + ((size_t)item * 128 + 32 * vt0 + r32) * 128 + 32 * dt + 4 * hl;
#pragma unroll
    for (int r4 = 0; r4 < 4; ++r4) {
        const bf16x4 x0 = {(bf16)acc0[4 * r4], (bf16)acc0[4 * r4 + 1], (bf16)acc0[4 * r4 + 2], (bf16)acc0[4 * r4 + 3]};
        const bf16x4 x1 = {(bf16)acc1[4 * r4], (bf16)acc1[4 * r4 + 1], (bf16)acc1[4 * r4 + 2], (bf16)acc1[4 * r4 + 3]};
        *(bf16x4*)(o + 8 * r4) = x0; *(bf16x4*)(o + 32 * 128 + 8 * r4) = x1;
    }
    __syncthreads();
}

__device__ __forceinline__ void hgrn_scan(const Params& p) {
    bf16* ST = (bf16*)(p.ws + WS_X); const float* G = (const float*)(p.ws + WS_G);
    for (int e = blockIdx.x * NT + threadIdx.x; e < NB * 4 * 128 * 64; e += gridDim.x * NT) {
        const int bh = e >> 13, vd = e & 8191, dp = e & 63;
        float s0 = 0.f, s1 = 0.f;
#pragma unroll 8
        for (int c = 0; c < NCH; ++c) {
            bf16x2* ptr = (bf16x2*)(ST + (size_t)(bh * NCH + c) * 16384) + vd;
            const bf16x2 u = *ptr; const f32x2 g = *(const f32x2*)(G + (size_t)(bh * NCH + c) * 128 + 2 * dp);
            const bf16x2 sv = {(bf16)s0, (bf16)s1}; *ptr = sv;
            s0 = g.x * s0 + (float)u[0]; s1 = g.y * s1 + (float)u[1];
        }
    }
}

constexpr int HC_VS = 0, HC_QH = 17408, HC_Q0 = 34816, HC_Q1 = 47872, HC_Q2 = 56576, HC_KD = 60928, HC_KG = 73984, HC_AM = 91392, HC_GT = 100608, HC_OT = 34816, HC_OTP = 132;
__device__ __forceinline__ void hgrn_stepC(const Params& p, int item, char* lds) {
    const h16* P = (const h16*)(p.ws + WS_P); const bf16* ST = (const bf16*)(p.ws + WS_X); h16* MIX = (h16*)(p.ws + WS_MIX);
    float* gtot = (float*)(lds + HC_GT);
    const int tid = threadIdx.x, d = tid & 127, g = tid >> 7;
    const int w = tid >> 6, lane = tid & 63, hl = lane >> 5, r32 = lane & 31;
    const int c = 1 + item % 128, bh = item / 128, h = bh & 3, b = bh >> 2;
    const size_t rowbase = (size_t)(b * S + (c - 1) * 64);
    const int tt = w >> 2, vt = w & 3;
    bf16x8 sfr[8];
    { const bf16* sp = ST + ((size_t)(bh * NCH + c) * 128 + 32 * vt + r32) * 128 + 8 * hl;
#pragma unroll
      for (int ks = 0; ks < 8; ++ks) sfr[ks] = *(const bf16x8*)(sp + 16 * ks); }
    hgrn_load_v((const bf16*)P, rowbase, h, 64, lds + HC_VS);
    for (int i = tid; i < 64 * HAP / 16; i += NT) *(f32x4*)(lds + HC_AM + i * 16) = (f32x4){0.f, 0.f, 0.f, 0.f};
    float cs[16], kk[16], qv[16];
#pragma unroll
    for (int i = 0; i < 16; ++i) qv[i] = siluf_((float)P[(rowbase + 16 * g + i) * NP2 + C_HQ + h * 128 + d]);
    hgrn_fb(p, P, rowbase, h, d, g, 64, cs, kk, gtot);
    __syncthreads();
    {
        const float t0 = gtot[d], t1 = gtot[128 + d], t2 = gtot[256 + d];
        const float bg = g == 0 ? 0.f : (g == 1 ? t0 : (g == 2 ? t0 + t1 : t0 + t1 + t2));
        const float tg = g == 0 ? t0 : (g == 1 ? t1 : t2);
        const float e1 = g >= 2 ? (g == 2 ? t1 : t2) : 0.f;
        const float e2 = g == 3 ? t1 : 0.f;
#pragma unroll
        for (int i = 0; i < 16; ++i) {
            const int t = 16 * g + i; const float cc = cs[i], q = qv[i];
            *(bf16*)(lds + HC_QH + t * HVP + d * 2) = (bf16)(q * __expf(bg + cc));
            if (g >= 1) *(bf16*)(lds + (g == 1 ? HC_Q0 : (g == 2 ? HC_Q1 : HC_Q2)) + i * HVP + d * 2) = (bf16)(q * __expf(cc));
            if (g >= 2) *(bf16*)(lds + (g == 2 ? HC_Q0 : HC_Q1) + (16 + i) * HVP + d * 2) = (bf16)(q * __expf(e1 + cc));
            if (g == 3) *(bf16*)(lds + HC_Q0 + (32 + i) * HVP + d * 2) = (bf16)(q * __expf(e1 + e2 + cc));
            if (g <= 2) *(bf16*)(lds + HC_KD + t * HVP + d * 2) = (bf16)(kk[i] * __expf(tg - cc));
            *(bf16*)(lds + HC_KG + t * HVP + d * 2) = (bf16)(kk[i] * __expf(fminf(-cc, 80.f)));
        }
    }
    __syncthreads();
    for (int n = w; n < 10; n += 8) {
        const int I = n >= 6 ? 3 : (n >= 3 ? 2 : (n >= 1 ? 1 : 0)), J = n - I * (I + 1) / 2;
        const char* qp; const char* kp;
        if (J == I) { qp = I == 0 ? lds + HC_QH : lds + (I == 1 ? HC_Q0 : (I == 2 ? HC_Q1 : HC_Q2)); kp = lds + HC_KG + 16 * I * HVP; }
        else { qp = lds + (J == 0 ? HC_Q0 : (J == 1 ? HC_Q1 : HC_Q2)) + (16 * I - 16 * (J + 1)) * HVP; kp = lds + HC_KD + 16 * J * HVP; }
        f32x4 a4 = {0.f, 0.f, 0.f, 0.f};
        const int fo = (lane & 15) * HVP + 16 * (lane >> 4);
#pragma unroll
        for (int ks = 0; ks < 4; ++ks) {
            const bf16x8 af = *(const bf16x8*)(qp + fo + 64 * ks), bf_ = *(const bf16x8*)(kp + fo + 64 * ks);
            a4 = __builtin_amdgcn_mfma_f32_16x16x32_bf16(af, bf_, a4, 0, 0, 0);
        }
        const int sl = lane & 15, tl0 = 4 * (lane >> 4);
#pragma unroll
        for (int r = 0; r < 4; ++r) { const int tl = tl0 + r; const float val = (J == I && sl > tl) ? 0.f : a4[r]; *(bf16*)(lds + HC_AM + (16 * I + tl) * HAP + (16 * J + sl) * 2) = (bf16)val; }
    }
    __syncthreads();
    f32x16 acc = {0.f, 0.f, 0.f, 0.f, 0.f, 0.f, 0.f, 0.f, 0.f, 0.f, 0.f, 0.f, 0.f, 0.f, 0.f, 0.f};
    {
        const lcptr vbase = (lcptr)(lds + HC_VS) + (8 * hl + ((lane & 15) >> 2)) * HVP + (32 * vt + 16 * ((lane >> 4) & 1) + 4 * (lane & 3)) * 2;
#pragma unroll
        for (int ks = 0; ks < 4; ++ks) {
            const bf16x8 a = *(const bf16x8*)(lds + HC_AM + (32 * tt + r32) * HAP + (16 * ks + 8 * hl) * 2);
            const lcptr pv = vbase + (16 * ks) * HVP;
            acc = __builtin_amdgcn_mfma_f32_32x32x16_bf16(a, tr_frag(pv, pv + 4 * HVP), acc, 0, 0, 0);
        }
#pragma unroll
        for (int ks = 0; ks < 8; ++ks) {
            const bf16x8 a = *(const bf16x8*)(lds + HC_QH + (32 * tt + r32) * HVP + (16 * ks + 8 * hl) * 2);
            acc = __builtin_amdgcn_mfma_f32_32x32x16_bf16(a, sfr[ks], acc, 0, 0, 0);
        }
    }
    __syncthreads();
    float* OT = (float*)(lds + HC_OT);
#pragma unroll
    for (int i = 0; i < 16; ++i) OT[(32 * tt + (i & 3) + 8 * (i >> 2) + 4 * hl) * HC_OTP + 32 * vt + r32] = acc[i];
    __syncthreads();
    {
        const int t = tid >> 3, j = tid & 7;
        f32x4 x[4]; float ss = 0.f;
#pragma unroll
        for (int k = 0; k < 4; ++k) { x[k] = *(const f32x4*)(OT + t * HC_OTP + 16 * j + 4 * k); ss += x[k].x * x[k].x + x[k].y * x[k].y + x[k].z * x[k].z + x[k].w * x[k].w; }
        ss += __shfl_xor(ss, 1); ss += __shfl_xor(ss, 2); ss += __shfl_xor(ss, 4);
        const float rs = rsqrtf(ss * (1.f / 128.f) + 1e-6f);
        const h16* gp = P + (rowbase + t) * NP2 + C_HG + h * 128 + 16 * j;
        const h16x8 g0 = *(const h16x8*)gp, g1 = *(const h16x8*)(gp + 8);
        h16x8 o0, o1;
#pragma unroll
        for (int k = 0; k < 8; ++k) {
            o0[k] = (h16)(x[k >> 2][k & 3] * rs * p.hgrn_norm[16 * j + k] * siluf_((float)g0[k]));
            o1[k] = (h16)(x[2 + (k >> 2)][k & 3] * rs * p.hgrn_norm[16 * j + 8 + k] * siluf_((float)g1[k]));
        }
        h16* op = MIX + (rowbase + t) * D + 512 + h * 128 + 16 * j;
        *(h16x8*)op = o0; *(h16x8*)(op + 8) = o1;
    }
    __syncthreads();
}

__device__ __forceinline__ void phase_mix(const Params& p) {
    const h16* P = (const h16*)(p.ws + WS_P); h16* MIX = (h16*)(p.ws + WS_MIX);
    const int lane = threadIdx.x & 63, wave = threadIdx.x >> 6;
    for (int row = blockIdx.x * 8 + wave; row < MREAL; row += gridDim.x * 8) {
        const h16* pr = P + (size_t)row * NP2; h16* o = MIX + (size_t)row * D; const h16* qo = (const h16*)(p.ws + WS_QB) + (size_t)row * 512;
        const h16x8 a = *(const h16x8*)(qo + lane * 8); const h16x8 g = *(const h16x8*)(pr + C_AG + lane * 8);
        float ss = 0.f;
#pragma unroll
        for (int j = 0; j < 8; ++j) ss += (float)a[j] * (float)a[j];
        const float rs = rsqrtf(wave_sum(ss) * (1.f / 512.f) + 1e-6f);
        h16x8 ov;
#pragma unroll
        for (int j = 0; j < 8; ++j) ov[j] = (h16)((float)a[j] * rs * p.attn_norm[lane * 8 + j] * siluf_((float)g[j]));
        *(h16x8*)(o + lane * 8) = ov;
    }
}

__device__ __forceinline__ void phase_final(const Params& p) {
    const int lane = threadIdx.x & 63, wave = threadIdx.x >> 6;
    for (int row = blockIdx.x * 8 + wave; row < MREAL; row += gridDim.x * 8) {
        float* o = p.out + (size_t)row * D;
        f32x4 v[4]; float ss = 0.f;
        for (int j = 0; j < 4; ++j) { v[j] = *(const f32x4*)(o + (lane + 64 * j) * 4); ss += v[j].x * v[j].x + v[j].y * v[j].y + v[j].z * v[j].z + v[j].w * v[j].w; }
        const float rs = rsqrtf(wave_sum(ss) * (1.f / D) + 1e-6f);
        for (int j = 0; j < 4; ++j) { const f32x4 g = *(const f32x4*)(p.final_norm + (lane + 64 * j) * 4);
            *(f32x4*)(o + (lane + 64 * j) * 4) = (f32x4){v[j].x * rs * g.x, v[j].y * rs * g.y, v[j].z * rs * g.z, v[j].w * rs * g.w}; }
    }
}

#define XB_TMO      128
#define XB_XCNT(j)  (256  + 64 * (j))
#define XB_XSUB(j)  (1280 + 64 * (j))
#define XB_XGEN(j)  (2304 + 64 * (j))
#define XB_TOP      3328
#define XB_TOPGEN   3392
#define XCD_BAR_WORDS 3456
#define XB_SPIN_CAP (1u << 18)

__device__ __forceinline__ unsigned xb_ld(unsigned* p)              { return __hip_atomic_load(p, __ATOMIC_RELAXED, __HIP_MEMORY_SCOPE_AGENT); }
__device__ __forceinline__ unsigned xb_add(unsigned* p, unsigned v) { return __hip_atomic_fetch_add(p, v, __ATOMIC_RELAXED, __HIP_MEMORY_SCOPE_AGENT); }
__device__ __forceinline__ unsigned xb_xcc_id() { return (unsigned)__builtin_amdgcn_s_getreg((3 << 11) | 20) & 0xFu; }
#define XB_SPIN(cond, bar) do { unsigned _sp = 0; while (cond) { __builtin_amdgcn_s_sleep(1); \
    if ((++_sp & 255u) == 0u) { if (xb_ld(&(bar)[XB_TMO])) break; if (_sp > XB_SPIN_CAP) { atomicAdd(&(bar)[XB_TMO], 1u); break; } } } } while (0)

struct XcdBarrier {
    unsigned* bar; unsigned x;
    volatile LAS unsigned* st;
};

__device__ __forceinline__ XcdBarrier xcd_barrier_post(unsigned* bar, volatile LAS unsigned* st) {
    XcdBarrier b; b.bar = bar; b.x = xb_xcc_id(); b.st = st;
    if (threadIdx.x == 0) (void)xb_add(&bar[XB_XCNT(b.x)], 1u);
    return b;
}
__device__ __forceinline__ void xcd_barrier_complete(unsigned* bar, unsigned x, unsigned& nloc, unsigned& nx) {
    const unsigned G = gridDim.x * gridDim.y * gridDim.z;
    unsigned sum, cnt, mine, sp = 0u;
    for (;;) {
        sum = 0u; cnt = 0u; mine = 0u;
#pragma unroll
        for (unsigned j = 0; j < 16; ++j) { const unsigned c = xb_ld(&bar[XB_XCNT(j)]); sum += c; cnt += (c > 0u) ? 1u : 0u; mine = (j == x) ? c : mine; }
        if (sum == G) break;
        __builtin_amdgcn_s_sleep(1);
        if ((++sp & 255u) == 0u) { if (xb_ld(&bar[XB_TMO])) break; if (sp > XB_SPIN_CAP) { atomicAdd(&bar[XB_TMO], 1u); break; } }
    }
    nloc = mine > 0u ? mine : 1u; nx = cnt > 0u ? cnt : 1u;
}

__device__ __forceinline__ void xcd_barrier(const XcdBarrier& b) {
    asm volatile("s_waitcnt vmcnt(0)" ::: "memory");
    __syncthreads();
    if (threadIdx.x == 0) {
        unsigned* bar = b.bar;
        __builtin_amdgcn_s_waitcnt(0);
        unsigned nloc = b.st[0], nx = b.st[1];
        if (nloc == 0u) { xcd_barrier_complete(bar, b.x, nloc, nx); b.st[0] = nloc; b.st[1] = nx; }
        const unsigned old = xb_add(&bar[XB_XSUB(b.x)], 1u);
        const unsigned gen = old / nloc;
        if (old + 1u == (gen + 1u) * nloc) {
            __builtin_amdgcn_fence(__ATOMIC_RELEASE, "agent");
            asm volatile("s_waitcnt vmcnt(0)" ::: "memory");
            const unsigned og = xb_add(&bar[XB_TOP], 1u);
            const unsigned tg = og / nx;
            if (og + 1u == (tg + 1u) * nx) xb_add(&bar[XB_TOPGEN], 1u);
            else XB_SPIN(xb_ld(&bar[XB_TOPGEN]) == tg, bar);
            __builtin_amdgcn_fence(__ATOMIC_ACQUIRE, "agent");
            xb_add(&bar[XB_XGEN(b.x)], 1u);
            asm volatile("s_waitcnt vmcnt(0)" ::: "memory");
        } else {
            XB_SPIN(xb_ld(&bar[XB_XGEN(b.x)]) == gen, bar);
            __builtin_amdgcn_fence(__ATOMIC_ACQUIRE, "agent");
            asm volatile("s_waitcnt vmcnt(0)" ::: "memory");
        }
    }
    __syncthreads();
}


constexpr int NPHASE = 9;
__global__ void __launch_bounds__(NT, 2) mega(Params p, int ph_lo, int ph_hi) {
    extern __shared__ __attribute__((aligned(16))) char lds[];
    cg::grid_group grid = cg::this_grid();
    volatile LAS unsigned* xst = (volatile LAS unsigned*)(LAS char*)(lds + LDS_BYTES - 16);
    if (threadIdx.x < 4) xst[threadIdx.x] = 0u;
    __syncthreads();
    XcdBarrier xbar = xcd_barrier_post((unsigned*)p.ws, xst);
#define IN(k) (ph_lo <= (k) && (k) < ph_hi)
#define SYNC(k) do { if ((k) + 1 < ph_hi) { if ((k) == 0) grid.sync(); else xcd_barrier(xbar); } } while (0)
    if (IN(0)) { phase_prep(p, lds); if (PROBE == 4) phase_prep(p, lds); SYNC(0); }
    if (PROBE == 2) { for (int i = 0; i < 8; ++i) xcd_barrier(xbar); }
    if (IN(1)) { phase_gemm_in(p, lds); if (PROBE == 1) phase_gemm_in(p, lds); SYNC(1); }
    if (IN(2)) { phase_post(p); SYNC(2); }
    if (IN(3)) {
        constexpr int NA = NB * 4 * NCH;
        for (int rep = 0; rep < ((PROBE == 3 || PROBE == 12) ? 2 : 1); ++rep)
        for (int it = blockIdx.x; it < 512; it += gridDim.x) { const int uu = it < 256 ? 255 - (it >> 1) : (it - 256) >> 1; idx_unit(p, it & 1, uu, lds, (PROBE == 12 && rep == 1) ? 1 : 0); }
        for (int rep = 0; rep < (PROBE == 5 ? 2 : 1); ++rep)
        for (int it = blockIdx.x; it < NA; it += gridDim.x) hgrn_stepA(p, it, lds);
        SYNC(3);
    }
    if (IN(4)) { hgrn_scan(p); SYNC(4); }
    if (IN(5)) {
        constexpr int NC = NB * 4 * 128;
        for (int it = blockIdx.x; it < NC; it += gridDim.x) hgrn_stepC(p, it, lds);
        {
            const attn_body::AttnTensors AT{(const h16*)(p.ws + WS_QB), (const h16*)(p.ws + WS_KB), (const h16*)(p.ws + WS_VB), (h16*)(p.ws + WS_QB), (const unsigned long long*)p.out};
            const attn_body::StaticOrder SO((int)gridDim.x, (int)blockIdx.x);
            attn_body::attn_phase<attn_body::StaticOrder>(lds, AT, SO);
        }
        SYNC(5);
    }
    if (IN(6)) { phase_mix(p); if (PROBE == 6) phase_mix(p); SYNC(6); }
    if (IN(7)) { phase_gemm_out(p, lds); if (PROBE == 7) phase_gemm_out(p, lds); SYNC(7); }
    if (IN(8)) { phase_final(p); }
#undef IN
#undef SYNC
}

extern "C" void kernel_launch(void* const* d_in, const int* in_sizes, int n_in, void* d_out, int out_size, void* d_ws, size_t ws_size, hipStream_t stream) {
    static int grid = 0;
    if (grid == 0) {
        if (n_in != 11 || ws_size < WS_END || out_size != MREAL * D) { fprintf(stderr, "kernel_launch: unexpected shapes n_in %d ws %zu out %d\n", n_in, ws_size, out_size); grid = -1; return; }
        int dev = 0, cus = 0, per_cu = 0;
        hipGetDevice(&dev); hipDeviceGetAttribute(&cus, hipDeviceAttributeMultiprocessorCount, dev);
        hipFuncSetAttribute((const void*)mega, hipFuncAttributeMaxDynamicSharedMemorySize, LDS_BYTES);
        hipOccupancyMaxActiveBlocksPerMultiprocessor(&per_cu, (const void*)mega, NT, LDS_BYTES);
        if (per_cu < 1) { fprintf(stderr, "kernel_launch: occupancy query says %d\n", per_cu); per_cu = 1; }
        grid = cus * 1;
        (void)hipGetLastError();
    }
    if (grid < 0) return;
    Params p{};
    p.x = (const float*)d_in[0]; p.meta = (const float*)d_in[1]; p.mix_norm = (const float*)d_in[2]; p.w_in = (const float*)d_in[3];
    p.idx_g = (const float*)d_in[4]; p.idx_b = (const float*)d_in[5]; p.attn_norm = (const float*)d_in[6]; p.lb_logits = (const float*)d_in[7];
    p.hgrn_norm = (const float*)d_in[8]; p.w_out = (const float*)d_in[9]; p.final_norm = (const float*)d_in[10];
    p.out = (float*)d_out; p.ws = (unsigned char*)d_ws;
    hipMemsetAsync(d_ws, 0, 16384, stream);
#if N_LAUNCH_MODE == 1
    int lo = 0, hi = NPHASE; void* args[] = {&p, &lo, &hi};
    hipError_t e = hipLaunchCooperativeKernel((const void*)mega, dim3(grid), dim3(NT), args, LDS_BYTES, stream);
    if (e != hipSuccess) fprintf(stderr, "cooperative launch failed: %s (grid %d)\n", hipGetErrorString(e), grid);
#else
    for (int ph = 0; ph < NPHASE; ++ph) hipLaunchKernelGGL(mega, dim3(grid), dim3(NT), LDS_BYTES, stream, p, ph, ph + 1);
#endif
}
```

```cpp
#include <hip/hip_runtime.h>
#include <hip/hip_cooperative_groups.h>
#include <cstdint>
#include <cstdio>
namespace cg = cooperative_groups;

typedef _Float16 h16;
typedef _Float16 h16x8 __attribute__((ext_vector_type(8)));
typedef _Float16 h16x4 __attribute__((ext_vector_type(4)));
#define LAS __attribute__((address_space(3)))
typedef float f32x4 __attribute__((ext_vector_type(4)));
typedef float f32x2 __attribute__((ext_vector_type(2)));

#ifndef PROBE
#define PROBE 0
#endif
#ifndef USE_CG_SYNC
#define USE_CG_SYNC 0
#endif
#ifndef N_LAUNCH_MODE
#define N_LAUNCH_MODE 1
#endif

constexpr int NB = 2, S = 8192, NMETA = 16, D = 1024;
constexpr int MREAL = NB * S;
constexpr int MROWS = MREAL + NMETA;
constexpr int MPAD = 16640;
constexpr int NCOL = 4680, NPAD = 4864;
constexpr int G_IK = 4608;
constexpr int NP2 = 3328;
constexpr int C_AG = 0, C_IQ = 512, C_HQ = 1024, C_HF = 1536, C_HI = 2048, C_HG = 2560, C_IK = 3072, C_IW = 3136;
constexpr int KVROWS = 8320;
constexpr int NCH = 129;
constexpr int NT = 512;

constexpr size_t MiB = 1u << 20;
constexpr size_t WS_WTIN = 1 * MiB, WS_WTOUT = 11 * MiB, WS_ROPE = 13 * MiB, WS_W8 = 14 * MiB, WS_KI = 23 * MiB, WS_G = 26 * MiB, WS_P = 27 * MiB, WS_QB = 133 * MiB, WS_KB = 149 * MiB, WS_VB = 166 * MiB, WS_X = 190 * MiB, WS_MIX = 223 * MiB, WS_END = 256 * MiB;
static_assert(WS_P + (size_t)MPAD * NP2 * 2 <= WS_QB && WS_QB + (size_t)MREAL * 512 * 2 <= WS_KB && WS_KB + (size_t)NB * KVROWS * 512 * 2 <= WS_VB && WS_VB + (size_t)NB * KVROWS * 512 * 2 <= WS_X, "ws map");
static_assert(WS_X + (size_t)NB * 4 * NCH * 16384 * 2 <= WS_MIX && WS_X + (size_t)MPAD * D * 2 <= WS_MIX + 0 * MiB + 33 * MiB && WS_MIX + (size_t)MREAL * D * 2 <= WS_END, "ST / HN / MIX");

constexpr int LDS_BYTES = 140 * 1024;

struct Params {
    const float *x, *meta, *mix_norm, *w_in, *idx_g, *idx_b, *attn_norm, *lb_logits, *hgrn_norm, *w_out, *final_norm;
    float* out; unsigned char* ws;
};

__device__ __forceinline__ float wave_sum(float v) {
#pragma unroll
    for (int o = 1; o < 64; o <<= 1) v += __shfl_xor(v, o);
    return v;
}
__device__ __forceinline__ float wave_max(float v) {
#pragma unroll
    for (int o = 1; o < 64; o <<= 1) v = fmaxf(v, __shfl_xor(v, o));
    return v;
}
__device__ __forceinline__ float sigmoidf_(float x) { return 1.f / (1.f + __expf(-x)); }
__device__ __forceinline__ float siluf_(float x) { return x * sigmoidf_(x); }
__device__ __forceinline__ int oldcol(int n) { if (n < 2560) return n; if (n < 4608) return n + 72; const int j = n - 4608; return j < 32 ? 2560 + j : (j < 40 ? 2624 + (j - 32) : ((j >= 128 && j < 160) ? 2592 + (j - 128) : -1)); }
__device__ __forceinline__ unsigned skey(float x) { if (x == 0.f) x = 0.f; unsigned u = __float_as_uint(x); return (u & 0x80000000u) ? ~u : (u | 0x80000000u); }

__device__ __forceinline__ void transpose_item(const float* __restrict__ W, int ldw, int nvalid, bool remap, h16* __restrict__ WT, int K, int item, float* tile) {
    constexpr float C2 = 0.125f * 1.4426950408889634f;
    const int nkt = K / 64, nb = item / nkt, kb = item % nkt, n0 = nb * 64, k0 = kb * 64, tid = threadIdx.x;
    {
        const int nl = tid & 63, kl = tid >> 6, n = n0 + nl;
        int src = -1; if (remap) src = oldcol(n); else if (n < nvalid) src = n;
        const float scl = (remap && n < 512) ? C2 : 1.f;
        for (int kk = kl; kk < 64; kk += 8) tile[kk * 65 + nl] = (src >= 0) ? W[(size_t)(k0 + kk) * ldw + src] * scl : 0.f;
    }
    __syncthreads();
    {
        const int kl = tid & 63, nl = tid >> 6;
        for (int nn = nl; nn < 64; nn += 8) WT[(size_t)(n0 + nn) * K + k0 + kl] = (h16)tile[kl * 65 + nn];
    }
    __syncthreads();
}

__device__ __forceinline__ void phase_prep(const Params& p, char* lds) {
    float* tile = (float*)lds;
    h16* WTin = (h16*)(p.ws + WS_WTIN); h16* WTout = (h16*)(p.ws + WS_WTOUT);
    constexpr int I_IN = (NPAD / 64) * (D / 64), I_OUT = (D / 64) * (D / 64);
    for (int it = blockIdx.x; it < I_IN + I_OUT; it += gridDim.x) {
        if (it < I_IN) transpose_item(p.w_in, NCOL, NCOL, true, WTin, D, it, tile);
        else transpose_item(p.w_out, D, D, false, WTout, D, it - I_IN, tile);
    }
    h16* HN = (h16*)(p.ws + WS_X);
    const int lane = threadIdx.x & 63, wave = threadIdx.x >> 6;
    for (int row = blockIdx.x * 8 + wave; row < MPAD; row += gridDim.x * 8) {
        h16* o = HN + (size_t)row * D;
        if (row >= MROWS) {
            for (int j = 0; j < 4; ++j) { h16x4 z = {(h16)0.f, (h16)0.f, (h16)0.f, (h16)0.f}; *(h16x4*)(o + (lane + 64 * j) * 4) = z; }
            continue;
        }
        const float* src = row < MREAL ? p.x + (size_t)row * D : p.meta + (size_t)(row - MREAL) * D;
        f32x4 v[4]; float ss = 0.f;
        for (int j = 0; j < 4; ++j) { v[j] = *(const f32x4*)(src + (lane + 64 * j) * 4); ss += v[j].x * v[j].x + v[j].y * v[j].y + v[j].z * v[j].z + v[j].w * v[j].w; }
        const float rs = rsqrtf(wave_sum(ss) * (1.f / D) + 1e-6f);
        for (int j = 0; j < 4; ++j) {
            const f32x4 g = *(const f32x4*)(p.mix_norm + (lane + 64 * j) * 4);
            h16x4 hv = {(h16)(v[j].x * rs * g.x), (h16)(v[j].y * rs * g.y), (h16)(v[j].z * rs * g.z), (h16)(v[j].w * rs * g.w)};
            *(h16x4*)(o + (lane + 64 * j) * 4) = hv;
        }
    }
    {
        h16* KB = (h16*)(p.ws + WS_KB); h16* VB = (h16*)(p.ws + WS_VB);
        for (int idx = blockIdx.x * NT + threadIdx.x; idx < NB * 112 * 64; idx += gridDim.x * NT) {
            const int c = idx & 63, rr = (idx >> 6) % 112, b = idx / (112 * 64);
            const int row = b * KVROWS + (rr < 48 ? 16 + rr : 8256 + (rr - 48));
            const h16x8 z = {(h16)0.f, (h16)0.f, (h16)0.f, (h16)0.f, (h16)0.f, (h16)0.f, (h16)0.f, (h16)0.f};
            *(h16x8*)(KB + (size_t)row * 512 + c * 8) = z; *(h16x8*)(VB + (size_t)row * 512 + c * 8) = z;
        }
    }
    float* ROPE = (float*)(p.ws + WS_ROPE);
    const double inv[8] = {1.0, 0.1939227432012558, 0.03760603070259094, 0.007292664609849453, 0.0014142135623842478, 0.00027424818836152554, 5.3182957344688475e-05, 1.0313385246263351e-05};
    for (int idx = blockIdx.x * NT + threadIdx.x; idx < (S + NMETA) * 8; idx += gridDim.x * NT) {
        const int t = idx >> 3, i = idx & 7;
        double iv = inv[0];
        if (i == 1) iv = inv[1]; else if (i == 2) iv = inv[2]; else if (i == 3) iv = inv[3]; else if (i == 4) iv = inv[4]; else if (i == 5) iv = inv[5]; else if (i == 6) iv = inv[6]; else if (i == 7) iv = inv[7];
        const double rev = (double)t * iv * 0.15915494309189535;
        const float fr = (float)(rev - __builtin_rint(rev));
        ROPE[idx * 2] = __builtin_amdgcn_cosf(fr); ROPE[idx * 2 + 1] = __builtin_amdgcn_sinf(fr);
    }
}

namespace pg8 {
#define PG8_LAS __attribute__((address_space(3)))
typedef unsigned short bf16_t;
typedef short bf16x8 __attribute__((ext_vector_type(8)));
typedef unsigned u32x4 __attribute__((ext_vector_type(4)));
constexpr int BM = 256, BK = 64, HALF = 128, HTB = HALF * BK * 2  , STAGE_BYTES = 8 * HTB, NXCD = 8, WGM = 8;

__host__ __device__ __forceinline__ int lds_byte(int r, int c) { const int st = (r >> 4) * 2 + (c >> 5), rr = r & 15, cc = c & 31, ob = rr * 64 + cc * 2; return st * 1024 + (ob ^ (((ob >> 9) & 1) << 5)); }
__host__ __device__ __forceinline__ void stage_rc(int b, int& R, int& C) { const int st = b / 1024, sb = b % 1024, swz = sb ^ (((sb >> 9) & 1) << 5); R = (st >> 1) * 16 + swz / 64; C = (st & 1) * 32 + (swz % 64) / 2; }
__host__ __device__ __forceinline__ int perm32(int rho) { const int n = rho >> 4, i = rho & 15; return 8 * (i >> 2) + 4 * n + (i & 3); }

struct Unit { int pm, pn; };
struct Gemm { const bf16_t* A; const bf16_t* Bt; int M, N, K; };

struct StaticOrder {
    int nM, nN, nwg, G, c;
    __host__ __device__ void init(int M, int N, int G_, int c_) { nM = M / BM; nN = N / BM; nwg = nM * nN; G = G_; c = c_; }
    __host__ __device__ bool next(int i, Unit& u) const {
        const long L = (long)i * G + c; if (L >= nwg) return false;
        int wgid = (int)L; { const int q = nwg / NXCD, r = nwg % NXCD, xcd = wgid % NXCD, off = wgid / NXCD; wgid = (xcd < r ? xcd * (q + 1) : r * (q + 1) + (xcd - r) * q) + off; }
        const int nig = WGM * nN, gid = wgid / nig, fm = gid * WGM, gsz = (nM - fm) < WGM ? (nM - fm) : WGM;
        u.pm = fm + ((wgid % nig) % gsz); u.pn = (wgid % nig) / gsz; return true;
    }
    __device__ __forceinline__ void a_ready(const Unit&) const {}
    __device__ __forceinline__ void done(const Unit&) const {}
};


struct EpiProj {
    static constexpr bool PERM = true, AFTER_DRAIN = false;
    unsigned char* ws; const float* idx_g; const float* idx_b;
    __device__ __forceinline__ void operator()(const f32x4 (&acc)[2][2][4][2], const Unit& u, int wr, int wc, int fr, int fq) const {
        const int pn = u.pn;
        const int row0 = u.pm * BM + wr * 64 + fr, colt = pn * BM + wc * 32 + 8 * fq;
        const bool rope_wave = (pn < 4 || pn == 8 || pn == 9) && !(wc & 1);
        const float* ROPE = (const float*)(ws + WS_ROPE);
#pragma unroll
        for (int ai = 0; ai < 2; ++ai)
#pragma unroll
            for (int m = 0; m < 4; ++m) {
                const int grow = row0 + ai * HALF + m * 16;
                const bool valid = grow < MROWS;
                const int t = grow < MREAL ? NMETA + (grow & (S - 1)) : grow - MREAL;
                if (pn == 18) {
                    if (wc == 0) {
                        float x[16];
#pragma unroll
                        for (int k = 0; k < 4; ++k) { x[k] = acc[ai][0][m][0][k]; x[4 + k] = acc[ai][0][m][1][k]; x[8 + k] = acc[ai][1][m][0][k]; x[12 + k] = acc[ai][1][m][1][k]; }
                        float s = 0.f;
#pragma unroll
                        for (int k = 0; k < 16; ++k) s += x[k];
                        s += __shfl_xor(s, 16); s += __shfl_xor(s, 32);
                        const float mean = s * (1.f / 64.f); float q = 0.f;
#pragma unroll
                        for (int k = 0; k < 16; ++k) { x[k] -= mean; q += x[k] * x[k]; }
                        q += __shfl_xor(q, 16); q += __shfl_xor(q, 32);
                        const float rstd = rsqrtf(q * (1.f / 64.f) + 1e-6f);
#pragma unroll
                        for (int k = 0; k < 16; ++k) { const int c = (k < 8 ? 0 : 32) + 8 * fq + (k & 7); x[k] = x[k] * rstd * idx_g[c] + idx_b[c]; }
                        float px[8];
#pragma unroll
                        for (int k = 0; k < 8; ++k) px[k] = __shfl_xor(x[k], 16);
                        if (fq < 2 && valid) {
                            const f32x4* rp = (const f32x4*)(ROPE + (size_t)t * 16);
#pragma unroll
                            for (int k4 = 0; k4 < 4; ++k4) { const f32x4 cs = rp[k4];
                                x[2 * k4] = fq == 0 ? x[2 * k4] * cs.x - px[2 * k4] * cs.y : x[2 * k4] * cs.x + px[2 * k4] * cs.y;
                                x[2 * k4 + 1] = fq == 0 ? x[2 * k4 + 1] * cs.z - px[2 * k4 + 1] * cs.w : x[2 * k4 + 1] * cs.z + px[2 * k4 + 1] * cs.w; }
                        }
                        if (valid) {
                            h16* kp = (h16*)(ws + WS_KI) + (size_t)grow * 64 + 8 * fq;
                            *(h16x8*)kp = (h16x8){(h16)x[0], (h16)x[1], (h16)x[2], (h16)x[3], (h16)x[4], (h16)x[5], (h16)x[6], (h16)x[7]};
                            *(h16x8*)(kp + 32) = (h16x8){(h16)x[8], (h16)x[9], (h16)x[10], (h16)x[11], (h16)x[12], (h16)x[13], (h16)x[14], (h16)x[15]};
                        }
                    } else if (wc == 1 && fq == 0 && valid) {
                        float* wp = (float*)(ws + WS_W8) + (size_t)grow * 8;
                        *(f32x4*)wp = acc[ai][0][m][0]; *(f32x4*)(wp + 4) = acc[ai][0][m][1];
                    }
                    continue;
                }
                f32x4 cs4[4];
                if (rope_wave && fq < 2 && valid) { const f32x4* rp = (const f32x4*)(ROPE + (size_t)t * 16);
#pragma unroll
                    for (int k4 = 0; k4 < 4; ++k4) cs4[k4] = rp[k4]; }
#pragma unroll
                for (int bj = 0; bj < 2; ++bj) {
                    const int gcol = colt + bj * HALF;
                    f32x4 v0 = acc[ai][bj][m][0], v1 = acc[ai][bj][m][1];
                    if (rope_wave) {
                        float x[8] = {v0[0], v0[1], v0[2], v0[3], v1[0], v1[1], v1[2], v1[3]}, px[8];
#pragma unroll
                        for (int k = 0; k < 8; ++k) px[k] = __shfl_xor(x[k], 16);
                        if (fq < 2 && valid) {
#pragma unroll
                            for (int k4 = 0; k4 < 4; ++k4) { const f32x4 cs = cs4[k4];
                                x[2 * k4] = fq == 0 ? x[2 * k4] * cs.x - px[2 * k4] * cs.y : x[2 * k4] * cs.x + px[2 * k4] * cs.y;
                                x[2 * k4 + 1] = fq == 0 ? x[2 * k4 + 1] * cs.z - px[2 * k4 + 1] * cs.w : x[2 * k4 + 1] * cs.z + px[2 * k4 + 1] * cs.w; }
                            v0 = (f32x4){x[0], x[1], x[2], x[3]}; v1 = (f32x4){x[4], x[5], x[6], x[7]};
                        }
                    }
                    h16x8 hv = {(h16)v0[0], (h16)v0[1], (h16)v0[2], (h16)v0[3], (h16)v1[0], (h16)v1[1], (h16)v1[2], (h16)v1[3]};
                    if (pn == 14 || pn == 15) {
                        typedef __bf16 b16x8 __attribute__((ext_vector_type(8)));
                        const b16x8 bv = {(__bf16)v0[0], (__bf16)v0[1], (__bf16)v0[2], (__bf16)v0[3], (__bf16)v1[0], (__bf16)v1[1], (__bf16)v1[2], (__bf16)v1[3]};
                        hv = __builtin_bit_cast(h16x8, bv);
                    }
                    if (gcol < 512) { if (grow < MREAL) *(h16x8*)((h16*)(ws + WS_QB) + (size_t)grow * 512 + gcol) = hv; }
                    else if (gcol < 1536) {
                        h16* dst = (h16*)(ws + (gcol < 1024 ? WS_KB : WS_VB)); const int cc = (gcol - 512) & 511;
                        if (grow < MREAL) *(h16x8*)(dst + ((size_t)(grow >> 13) * KVROWS + 64 + (grow & (S - 1))) * 512 + cc) = hv;
                        else if (grow < MROWS) { *(h16x8*)(dst + (size_t)(grow - MREAL) * 512 + cc) = hv; *(h16x8*)(dst + ((size_t)KVROWS + (grow - MREAL)) * 512 + cc) = hv; }
                    } else {
                        *(h16x8*)((h16*)(ws + WS_P) + (size_t)grow * NP2 + (gcol - 1536)) = hv;
                    }
                }
            }
    }
};
struct EpiOut {
    static constexpr bool PERM = false, AFTER_DRAIN = false;
    const float* x; float* out;
    __device__ __forceinline__ void operator()(const f32x4 (&acc)[2][2][4][2], const Unit& u, int wr, int wc, int fr, int fq) const {
        const int row0 = u.pm * BM + wr * 64 + fr, col0 = u.pn * BM + wc * 32 + 4 * fq;
#pragma unroll
        for (int ai = 0; ai < 2; ++ai)
#pragma unroll
            for (int m = 0; m < 4; ++m) {
                const size_t off = (size_t)(row0 + ai * HALF + m * 16) * D + col0;
#pragma unroll
                for (int bj = 0; bj < 2; ++bj)
#pragma unroll
                    for (int n = 0; n < 2; ++n) { const f32x4 xv = *(const f32x4*)(x + off + bj * HALF + n * 16); *(f32x4*)(out + off + bj * HALF + n * 16) = xv + acc[ai][bj][m][n]; }
            }
    }
};
template <class Epi, class Sched, bool ALIGN_EPI = false, bool SP2 = false>
__device__ __forceinline__ void gemm_phase(PG8_LAS unsigned char* lds, const Gemm g, const Sched& S, const Epi& E) {
    const int tid = threadIdx.x, wid = __builtin_amdgcn_readfirstlane(tid >> 6), lane = tid & 63, wr = wid >> 2, wc = wid & 3, fr = lane & 15, fq = lane >> 4;
    const int K = g.K, nt = K / BK;
    unsigned voffA[2], voffB[2];
#pragma unroll
    for (int i = 0; i < 2; ++i) { int R, C; stage_rc(tid * 16 + i * 8192, R, C); const int Rb = Epi::PERM ? ((R & ~31) + perm32(R & 31)) : R;
        voffA[i] = (unsigned)(R * K + C) * 2u; voffB[i] = (unsigned)(Rb * K + C) * 2u; }
    const size_t kstep = (size_t)(BK * 2);
    const size_t hstep = (size_t)HALF * K * 2;
    const size_t tstep = 2 * hstep;
    const unsigned ldsw = (unsigned)wid * 1024u;
    const int aoff = lds_byte(wr * 64 + fr, fq * 8), boff = lds_byte(wc * 32 + fr, fq * 8);
#define PG8_SA(b, h) (((b) * 2 + (h)) * HTB)
#define PG8_SB(b, h) ((4 + (b) * 2 + (h)) * HTB)
#define PG8_STAGE(bufoff, gbase, voff) do { _Pragma("unroll") for (int _i = 0; _i < 2; ++_i) \
        __builtin_amdgcn_global_load_lds((const unsigned*)((const char*)(gbase) + (voff)[_i]), (PG8_LAS unsigned*)(lds + (bufoff) + ldsw + _i * 8192), 16, 0, 0); } while (0)
#define PG8_LDA(dst, b, h) do { _Pragma("unroll") for (int m = 0; m < 4; ++m) _Pragma("unroll") for (int k = 0; k < 2; ++k) dst[m][k] = *(const PG8_LAS bf16x8*)(lds + PG8_SA(b, h) + aoff + m * 2048 + k * 1024); } while (0)
#define PG8_LDB(dst, b, h) do { _Pragma("unroll") for (int n = 0; n < 2; ++n) _Pragma("unroll") for (int k = 0; k < 2; ++k) dst[n][k] = *(const PG8_LAS bf16x8*)(lds + PG8_SB(b, h) + boff + n * 2048 + k * 1024); } while (0)
#define PG8_MMA(ai, bj, At, Bt) do { __builtin_amdgcn_s_setprio(1); _Pragma("unroll") for (int m = 0; m < 4; ++m) _Pragma("unroll") for (int n = 0; n < 2; ++n) _Pragma("unroll") for (int k = 0; k < 2; ++k) \
        acc[ai][bj][m][n] = __builtin_amdgcn_mfma_f32_16x16x32_f16(__builtin_bit_cast(h16x8, Bt[n][k]), __builtin_bit_cast(h16x8, At[m][k]), acc[ai][bj][m][n], 0, 0, 0); __builtin_amdgcn_s_setprio(0); } while (0)
#define PG8_WAIT_V(n) asm volatile("s_waitcnt vmcnt(" #n ")" ::: "memory")
#define PG8_WAIT_L(n) asm volatile("s_waitcnt lgkmcnt(" #n ")" ::: "memory")
#define PG8_BAR __builtin_amdgcn_s_barrier()
#define PG8_SCHED __builtin_amdgcn_sched_barrier(0)
    Unit cur, nxt; int ui = 0;
    if (!S.next(0, cur)) return;
    f32x4 acc[2][2][4][2];
#pragma unroll
    for (int a = 0; a < 2; ++a)
#pragma unroll
        for (int b = 0; b < 2; ++b)
#pragma unroll
            for (int m = 0; m < 4; ++m)
#pragma unroll
                for (int n = 0; n < 2; ++n) acc[a][b][m][n] = (f32x4){0.f, 0.f, 0.f, 0.f};
    bf16x8 At[4][2], B0[2][2], B1[2][2];
    const char* cA = (const char*)g.A + (size_t)cur.pm * tstep; const char* cB = (const char*)g.Bt + (size_t)cur.pn * tstep;
    S.a_ready(cur);
    if constexpr (SP2) {
        PG8_STAGE(PG8_SB(0, 0), cB, voffB); PG8_STAGE(PG8_SB(0, 1), cB + hstep, voffB); PG8_STAGE(PG8_SA(0, 0), cA, voffA); PG8_STAGE(PG8_SA(0, 1), cA + hstep, voffA);
        if (wr == 1) PG8_BAR;
        PG8_WAIT_V(2); PG8_BAR;
        PG8_STAGE(PG8_SB(1, 0), cB + kstep, voffB); PG8_STAGE(PG8_SA(1, 0), cA + kstep, voffA); PG8_STAGE(PG8_SB(1, 1), cB + hstep + kstep, voffB);
        PG8_WAIT_V(6); PG8_BAR;
    } else {
        PG8_STAGE(PG8_SB(0, 0), cB, voffB); PG8_STAGE(PG8_SA(0, 0), cA, voffA); PG8_STAGE(PG8_SB(0, 1), cB + hstep, voffB); PG8_STAGE(PG8_SA(0, 1), cA + hstep, voffA);
        if (wr == 1) PG8_BAR;
        PG8_WAIT_V(4); PG8_BAR;
        PG8_STAGE(PG8_SB(1, 0), cB + kstep, voffB); PG8_STAGE(PG8_SA(1, 0), cA + kstep, voffA); PG8_STAGE(PG8_SB(1, 1), cB + hstep + kstep, voffB);
        PG8_WAIT_V(6); PG8_BAR;
    }
    for (;;) {
        const bool has_next = S.next(ui + 1, nxt);
        const char* nA = has_next ? (const char*)g.A + (size_t)nxt.pm * tstep : cA; const char* nB = has_next ? (const char*)g.Bt + (size_t)nxt.pn * tstep : cB;
        for (int t = 0; t < nt; t += 2) {
            const bool last = (t == nt - 2);
            const char* a1 = cA + (size_t)(t + 1) * kstep;
            const char* a2 = last ? nA : cA + (size_t)(t + 2) * kstep; const char* b2 = last ? nB : cB + (size_t)(t + 2) * kstep;
            const char* a3 = a2 + kstep; const char* b3 = b2 + kstep;
            if (last && has_next) S.a_ready(nxt);
            if constexpr (SP2) {
            PG8_LDB(B0, 0, 0); PG8_LDB(B1, 0, 1); PG8_SCHED; PG8_LDA(At, 0, 0); PG8_STAGE(PG8_SA(1, 1), a1 + hstep, voffA);
            PG8_WAIT_V(8); PG8_WAIT_L(0); PG8_BAR; PG8_MMA(0, 0, At, B0); PG8_MMA(0, 1, At, B1); PG8_BAR; PG8_SCHED;
            PG8_LDA(At, 0, 1); PG8_STAGE(PG8_SB(0, 0), b2, voffB); PG8_STAGE(PG8_SB(0, 1), b2 + hstep, voffB); PG8_STAGE(PG8_SA(0, 0), a2, voffA);
            PG8_WAIT_V(8); PG8_WAIT_L(0); PG8_BAR; PG8_MMA(1, 0, At, B0); PG8_MMA(1, 1, At, B1); PG8_BAR; PG8_SCHED;
            PG8_LDB(B0, 1, 0); PG8_LDB(B1, 1, 1); PG8_SCHED; PG8_LDA(At, 1, 0); PG8_STAGE(PG8_SA(0, 1), a2 + hstep, voffA);
            PG8_WAIT_V(8); PG8_WAIT_L(0); PG8_BAR; PG8_MMA(0, 0, At, B0); PG8_MMA(0, 1, At, B1); PG8_BAR; PG8_SCHED;
            PG8_LDA(At, 1, 1); PG8_STAGE(PG8_SB(1, 0), b3, voffB); PG8_STAGE(PG8_SB(1, 1), b3 + hstep, voffB); PG8_STAGE(PG8_SA(1, 0), a3, voffA);
            PG8_WAIT_V(8); PG8_WAIT_L(0); PG8_BAR; PG8_MMA(1, 0, At, B0); PG8_MMA(1, 1, At, B1); PG8_BAR; PG8_SCHED;
            } else {
            PG8_LDB(B0, 0, 0); PG8_SCHED; PG8_LDA(At, 0, 0); PG8_STAGE(PG8_SA(1, 1), a1 + hstep, voffA);
            PG8_WAIT_L(8); PG8_BAR; PG8_WAIT_L(0); PG8_MMA(0, 0, At, B0); PG8_BAR; PG8_SCHED;
            PG8_LDB(B1, 0, 1); PG8_STAGE(PG8_SB(0, 0), b2, voffB);
            PG8_BAR; PG8_WAIT_L(0); PG8_MMA(0, 1, At, B1); PG8_BAR;
            PG8_LDA(At, 0, 1); PG8_STAGE(PG8_SA(0, 0), a2, voffA);
            PG8_BAR; PG8_WAIT_L(0); PG8_MMA(1, 0, At, B0); PG8_BAR; PG8_SCHED;
            PG8_STAGE(PG8_SB(0, 1), b2 + hstep, voffB);
            PG8_WAIT_V(6); PG8_BAR; PG8_MMA(1, 1, At, B1); PG8_BAR;
            PG8_LDB(B0, 1, 0); PG8_SCHED; PG8_LDA(At, 1, 0); PG8_STAGE(PG8_SA(0, 1), a2 + hstep, voffA);
            PG8_WAIT_L(8); PG8_BAR; PG8_WAIT_L(0); PG8_MMA(0, 0, At, B0); PG8_BAR; PG8_SCHED;
            PG8_LDB(B1, 1, 1); PG8_STAGE(PG8_SB(1, 0), b3, voffB);
            PG8_BAR; PG8_WAIT_L(0); PG8_MMA(0, 1, At, B1); PG8_BAR;
            PG8_LDA(At, 1, 1); PG8_STAGE(PG8_SA(1, 0), a3, voffA);
            PG8_BAR; PG8_WAIT_L(0); PG8_MMA(1, 0, At, B0); PG8_BAR; PG8_SCHED;
            PG8_STAGE(PG8_SB(1, 1), b3 + hstep, voffB);
            PG8_WAIT_V(6); PG8_BAR; PG8_MMA(1, 1, At, B1); PG8_BAR;
            }
        }
        if constexpr (ALIGN_EPI) { if (wr == 0) PG8_BAR; }
        if constexpr (!Epi::AFTER_DRAIN) { E(acc, cur, wr, wc, fr, fq); S.done(cur); }
        if (!has_next) break;
#pragma unroll
        for (int a = 0; a < 2; ++a)
#pragma unroll
            for (int b = 0; b < 2; ++b)
#pragma unroll
                for (int m = 0; m < 4; ++m)
#pragma unroll
                    for (int n = 0; n < 2; ++n) acc[a][b][m][n] = (f32x4){0.f, 0.f, 0.f, 0.f};
        cur = nxt; cA = nA; cB = nB; ++ui;
        if constexpr (ALIGN_EPI) { if (wr == 1) PG8_BAR; }
    }
    PG8_WAIT_V(0);
    if constexpr (!ALIGN_EPI) { if (wr == 0) PG8_BAR; }
    PG8_BAR;
    if constexpr (Epi::AFTER_DRAIN) { E.fused(acc, cur, wr, wc, fr, fq, lds, wid, lane); S.done(cur); }
#undef PG8_SA
#undef PG8_SB
#undef PG8_STAGE
#undef PG8_LDA
#undef PG8_LDB
#undef PG8_MMA
#undef PG8_WAIT_V
#undef PG8_WAIT_L
#undef PG8_BAR
#undef PG8_SCHED
}
}

__device__ __forceinline__ void phase_gemm_in(const Params& p, char* lds) {
    pg8::Gemm g{(const pg8::bf16_t*)(p.ws + WS_X), (const pg8::bf16_t*)(p.ws + WS_WTIN), MPAD, NPAD, D};
    pg8::StaticOrder So; So.init(MPAD, NPAD, (int)gridDim.x, (int)blockIdx.x);
    pg8::EpiProj E{p.ws, p.idx_g, p.idx_b};
    pg8::gemm_phase<pg8::EpiProj, pg8::StaticOrder, true, true>((PG8_LAS unsigned char*)lds, g, So, E);
}
__device__ __forceinline__ void phase_gemm_out(const Params& p, char* lds) {
    pg8::Gemm g{(const pg8::bf16_t*)(p.ws + WS_MIX), (const pg8::bf16_t*)(p.ws + WS_WTOUT), MREAL, D, D};
    pg8::StaticOrder So; So.init(MREAL, D, (int)gridDim.x, (int)blockIdx.x);
    pg8::EpiOut E{p.x, p.out};
    pg8::gemm_phase<pg8::EpiOut, pg8::StaticOrder, true, true>((PG8_LAS unsigned char*)lds, g, So, E);
}

constexpr int NMI = 130;
constexpr int QB = 32, CAP = 128;
constexpr int IX_KB = 0, IX_HIST = 32768, IX_MASK = 32768  , IX_CAND = 98304, IX_CANDI = 114688, IX_ST = 131072, IX_FLAG = 132096;
constexpr int HROW = 512;
typedef float f32x16 __attribute__((ext_vector_type(16)));
#define ST_LO 0
#define ST_HI 1
#define ST_NEED 2
#define ST_CNT 3
#define ST_FLAGS 4
#define ST_NCAND 5
#define ST_SH 6
#define ST_RUN 7
#define FL_ACTIVE 1u
#define FL_TIE 2u

__device__ __forceinline__ float relu_(float x) { return __builtin_amdgcn_fmed3f(x, 0.f, __builtin_inff()); }
__device__ __forceinline__ unsigned skey_c(float x) { const unsigned u = __float_as_uint(x); return u ^ (((unsigned)((int)u >> 31)) | 0x80000000u); }
__device__ __forceinline__ int custom_bin(unsigned key) {
    const int k14 = (int)(key >> 18); const int a = k14 - 11488, bb = k14 - 3873;
    const int lowpart = min(max(bb, 0), 511);
    return max(min(a, 1023), lowpart);
}

__device__ __forceinline__ void glds16(const void* gsrc, unsigned lds_dst) { unsigned keep;
    asm volatile("s_mov_b32 %0, m0\n\ts_mov_b32 m0, %2\n\ts_nop 0\n\tglobal_load_lds_dwordx4 %1, off\n\ts_mov_b32 m0, %0" : "=&s"(keep) : "v"(gsrc), "s"(lds_dst) : "memory"); }

struct IdxLane { unsigned loA, hiA, loB, hiB, flA, flB, shA, shB, needA, needB, runA, runB; int qA, qB, rA, rB; bool anyTie; };

template <int MODE, bool DIAG>
__device__ __forceinline__ void idx_tile(char* lds, const char* kb, int t, const h16x8 (&afrag)[4], const float (&wreg)[16], IdxLane& L) {
    unsigned* HIST = (unsigned*)(lds + IX_HIST); unsigned* MASK = (unsigned*)(lds + IX_MASK); unsigned* CAND = (unsigned*)(lds + IX_CAND); unsigned* CANDI = (unsigned*)(lds + IX_CANDI); unsigned* ST = (unsigned*)(lds + IX_ST);
    const int lane = threadIdx.x & 63, w = threadIdx.x >> 6, hl = lane >> 5, cc = lane & 31;
    h16x8 bf[2][4];
#pragma unroll
    for (int kh = 0; kh < 2; ++kh)
#pragma unroll
        for (int ks = 0; ks < 4; ++ks) { const int ki = 32 * kh + cc; bf[kh][ks] = *(const h16x8*)(kb + ki * 128 + (((2 * ks + hl) ^ ((ki >> 1) & 7)) << 4)); }
    f32x16 accs[2];
    accs[0] = (f32x16){0.f, 0.f, 0.f, 0.f, 0.f, 0.f, 0.f, 0.f, 0.f, 0.f, 0.f, 0.f, 0.f, 0.f, 0.f, 0.f}; accs[1] = accs[0];
#pragma unroll
    for (int ks = 0; ks < 4; ++ks) { accs[0] = __builtin_amdgcn_mfma_f32_32x32x16_f16(afrag[ks], bf[0][ks], accs[0], 0, 0, 0); accs[1] = __builtin_amdgcn_mfma_f32_32x32x16_f16(afrag[ks], bf[1][ks], accs[1], 0, 0, 0); }
#pragma unroll
    for (int kh = 0; kh < 2; ++kh) {
        const f32x16 acc = accs[kh];
        float pq[4];
#pragma unroll
        for (int q4 = 0; q4 < 4; ++q4)
            pq[q4] = __builtin_fmaf(wreg[4 * q4 + 3], relu_(acc[4 * q4 + 3]), __builtin_fmaf(wreg[4 * q4 + 2], relu_(acc[4 * q4 + 2]), __builtin_fmaf(wreg[4 * q4 + 1], relu_(acc[4 * q4 + 1]), __builtin_fmaf(wreg[4 * q4], relu_(acc[4 * q4]), 0.f))));
        const auto r01 = __builtin_amdgcn_permlane32_swap(__float_as_uint(pq[0]), __float_as_uint(pq[1]), false, false);
        const auto r23 = __builtin_amdgcn_permlane32_swap(__float_as_uint(pq[2]), __float_as_uint(pq[3]), false, false);
        const float sA = __uint_as_float(r01[0]) + __uint_as_float(r01[1]);
        const float sB = __uint_as_float(r23[0]) + __uint_as_float(r23[1]);
        const int sidx = 64 * t + 32 * kh + cc;
        const bool vA = DIAG ? (sidx <= L.rA) : true, vB = DIAG ? (sidx <= L.rB) : true;
        const unsigned kA = skey_c(sA), kB = skey_c(sB);
        if (MODE == 0) {
            const int bA = custom_bin(kA), bB = custom_bin(kB);
            if (vA) atomicAdd(&HIST[L.qA * HROW + (bA >> 1)], 1u << (16 * (bA & 1)));
            if (vB) atomicAdd(&HIST[L.qB * HROW + (bB >> 1)], 1u << (16 * (bB & 1)));
        } else if (MODE == 1) {
            if (vA && (L.flA & FL_ACTIVE) && (kA - L.loA) <= (L.hiA - L.loA)) { const unsigned sb = (kA - L.loA) >> L.shA; atomicAdd(&HIST[L.qA * HROW + (sb >> 1)], 1u << (16 * (sb & 1))); }
            if (vB && (L.flB & FL_ACTIVE) && (kB - L.loB) <= (L.hiB - L.loB)) { const unsigned sb = (kB - L.loB) >> L.shB; atomicAdd(&HIST[L.qB * HROW + (sb >> 1)], 1u << (16 * (sb & 1))); }
        } else {
            bool selA = vA && kA > L.hiA, selB = vB && kB > L.hiB;
            const bool inA = vA && (kA - L.loA) <= (L.hiA - L.loA), inB = vB && (kB - L.loB) <= (L.hiB - L.loB);
            if (L.anyTie) {
                const unsigned long long eA = __ballot(inA && (L.flA & FL_TIE)), eB = __ballot(inB && (L.flB & FL_TIE));
                const unsigned pA = hl ? (unsigned)(eA >> 32) : (unsigned)eA, pB = hl ? (unsigned)(eB >> 32) : (unsigned)eB;
                const unsigned below = (1u << cc) - 1u;
                if (inA && (L.flA & FL_TIE) && L.runA + __popc(pA & below) < L.needA) selA = true;
                if (inB && (L.flB & FL_TIE) && L.runB + __popc(pB & below) < L.needB) selB = true;
                L.runA += __popc(pA); L.runB += __popc(pB);
            }
            if (inA && !(L.flA & FL_TIE)) { const unsigned pos = atomicAdd(&ST[L.qA * 8 + ST_NCAND], 1u); if (pos < CAP) { CAND[L.qA * CAP + pos] = kA; CANDI[L.qA * CAP + pos] = (unsigned)sidx; } }
            if (inB && !(L.flB & FL_TIE)) { const unsigned pos = atomicAdd(&ST[L.qB * 8 + ST_NCAND], 1u); if (pos < CAP) { CAND[L.qB * CAP + pos] = kB; CANDI[L.qB * CAP + pos] = (unsigned)sidx; } }
            const unsigned long long mA = __ballot(selA), mB = __ballot(selB);
            const unsigned val = lane == 0 ? (unsigned)mA : (lane == 1 ? (unsigned)(mA >> 32) : (lane == 2 ? (unsigned)mB : (unsigned)(mB >> 32)));
            if (lane < 4) MASK[(4 * w + lane) * 260 + (t + 1) * 2 + kh] = val;
        }
    }
}

template <int MODE>
__device__ __forceinline__ void idx_pass(const Params& p, int b, int u, char* lds, const h16x8 (&afrag)[4], const float (&wreg)[16]) {
    const h16* KI = (const h16*)(p.ws + WS_KI) + (size_t)b * S * 64;
    unsigned* ST = (unsigned*)(lds + IX_ST);
    const int tid = threadIdx.x, lane = tid & 63, hl = lane >> 5; const int w = __builtin_amdgcn_readfirstlane(tid >> 6);
    const int tq = u >> 1;
    IdxLane L{};
    L.qA = 4 * w + hl; L.qB = 4 * w + 2 + hl; L.rA = 32 * u + L.qA; L.rB = 32 * u + L.qB;
    if (MODE != 0) { L.loA = ST[L.qA * 8 + ST_LO]; L.hiA = ST[L.qA * 8 + ST_HI]; L.flA = ST[L.qA * 8 + ST_FLAGS]; L.shA = ST[L.qA * 8 + ST_SH]; L.needA = ST[L.qA * 8 + ST_NEED];
                     L.loB = ST[L.qB * 8 + ST_LO]; L.hiB = ST[L.qB * 8 + ST_HI]; L.flB = ST[L.qB * 8 + ST_FLAGS]; L.shB = ST[L.qB * 8 + ST_SH]; L.needB = ST[L.qB * 8 + ST_NEED]; }
    L.anyTie = (MODE == 2) && (__ballot((L.flA | L.flB) & FL_TIE) != 0ull);
    const int si = 8 * w + (lane >> 3);
    const h16* ksrc = KI + (size_t)si * 64 + (((lane & 7) ^ ((si >> 1) & 7)) << 3);
    const unsigned lds0 = (unsigned)(uintptr_t)lds + IX_KB + (unsigned)w * 1024u;
#define IDX_DMA(tt) glds16(ksrc + (size_t)(tt) * 64 * 64, (unsigned)__builtin_amdgcn_readfirstlane(lds0 + (unsigned)((tt) & 3) * 8192u))
#define IDX_WAIT(N) asm volatile("s_waitcnt vmcnt(" #N ") lgkmcnt(0)\n\ts_barrier" ::: "memory")
    IDX_DMA(0); if (tq >= 1) IDX_DMA(1); if (tq >= 2) IDX_DMA(2);
    if (tq >= 2) IDX_WAIT(2); else if (tq == 1) IDX_WAIT(1); else IDX_WAIT(0);
    for (int t = 0; t < tq; ++t) {
        if (t + 3 <= tq) IDX_DMA(t + 3);
        idx_tile<MODE, false>(lds, lds + IX_KB + (t & 3) * 8192, t, afrag, wreg, L);
        if (t + 3 <= tq) IDX_WAIT(2); else if (t + 2 <= tq) IDX_WAIT(1); else IDX_WAIT(0);
    }
    idx_tile<MODE, true>(lds, lds + IX_KB + (tq & 3) * 8192, tq, afrag, wreg, L);
    IDX_WAIT(0);
#undef IDX_DMA
#undef IDX_WAIT
}

template <int MODE>
__device__ __forceinline__ void idx_scan(char* lds) {
    unsigned* HIST = (unsigned*)(lds + IX_HIST); unsigned* ST = (unsigned*)(lds + IX_ST); unsigned* FLAG = (unsigned*)(lds + IX_FLAG);
    const int lane = threadIdx.x & 63, w = threadIdx.x >> 6;
    for (int q4 = 0; q4 < 4; ++q4) {
        const int q = 4 * w + q4;
        const unsigned fl = ST[q * 8 + ST_FLAGS];
        if (MODE == 1 && !(fl & FL_ACTIVE)) continue;
        const unsigned need = ST[q * 8 + ST_NEED], lo = ST[q * 8 + ST_LO], hi = ST[q * 8 + ST_HI], sh = ST[q * 8 + ST_SH];
        unsigned c[16];
#pragma unroll
        for (int j = 0; j < 8; ++j) { const unsigned d = HIST[q * HROW + 8 * lane + j]; c[2 * j] = d & 0xFFFFu; c[2 * j + 1] = d >> 16; HIST[q * HROW + 8 * lane + j] = 0u; }
        unsigned tl = 0;
#pragma unroll
        for (int k = 0; k < 16; ++k) tl += c[k];
        unsigned Ssum = tl;
#pragma unroll
        for (int o = 1; o < 64; o <<= 1) { const unsigned v = __shfl_down(Ssum, o); if (lane + o < 64) Ssum += v; }
        const unsigned above = Ssum - tl;
        if (above < need && need <= Ssum) {
            unsigned cum = above; int bstar = 16 * lane; unsigned cnt = 0; bool found = false;
#pragma unroll
            for (int k = 15; k >= 0; --k) { if (!found) { if (cum + c[k] >= need) { bstar = 16 * lane + k; cnt = c[k]; found = true; } else cum += c[k]; } }
            const unsigned nneed = need - cum;
            unsigned nlo, nhi;
            if (MODE == 0) {
                if (bstar >= 512) { nlo = (unsigned)(bstar + 11488) << 18; nhi = bstar == 1023 ? 0xFFFFFFFFu : (nlo | 0x3FFFFu); }
                else if (bstar == 511) { nlo = 4384u << 18; nhi = (11999u << 18) | 0x3FFFFu; }
                else { nhi = ((unsigned)(bstar + 3873) << 18) | 0x3FFFFu; nlo = bstar == 0 ? 0u : ((unsigned)(bstar + 3873) << 18); }
            } else {
                nlo = lo + ((unsigned)bstar << sh); const unsigned top = nlo + ((1u << sh) - 1u); nhi = top < hi ? top : hi; if (top < nlo) nhi = hi;
            }
            const unsigned range = nhi - nlo;
            unsigned nfl = 0, nsh = 0;
            if (nlo < nhi && cnt > CAP) { nfl = FL_ACTIVE; const int bits = 32 - __clz(range); nsh = bits > 10 ? (unsigned)(bits - 10) : 0u; *FLAG = 1u; }
            else if (cnt > CAP) nfl = FL_TIE;
            ST[q * 8 + ST_LO] = nlo; ST[q * 8 + ST_HI] = nhi; ST[q * 8 + ST_NEED] = nneed; ST[q * 8 + ST_CNT] = cnt; ST[q * 8 + ST_FLAGS] = nfl; ST[q * 8 + ST_SH] = nsh;
        }
    }
}

__device__ __forceinline__ void idx_unit(const Params& p, int b, int u, char* lds, int dry = 0) {
    const h16* P = (const h16*)(p.ws + WS_P); const float* W8 = (const float*)(p.ws + WS_W8);
    unsigned long long* Mk = (unsigned long long*)p.out + (dry ? (size_t)(36u << 20) / 8 : 0);
    unsigned* HIST = (unsigned*)(lds + IX_HIST); unsigned* MASK = (unsigned*)(lds + IX_MASK); unsigned* CAND = (unsigned*)(lds + IX_CAND); unsigned* ST = (unsigned*)(lds + IX_ST); unsigned* FLAG = (unsigned*)(lds + IX_FLAG);
    const int tid = threadIdx.x, lane = tid & 63, w = tid >> 6, hl = lane >> 5, cc = lane & 31;
    const int qb = u >> 3, nwords = 4 * qb + 6;
    if (32 * u + 31 < 256) {
        for (int idx = tid; idx < 32 * nwords; idx += NT) {
            const int q = idx & 31, i = idx >> 5, r = 32 * u + q;
            unsigned long long wv;
            if (i == 0) wv = 0xFFFFull; else { const int nv = r - 64 * (i - 1) + 1; wv = nv <= 0 ? 0ull : (nv >= 64 ? ~0ull : ((1ull << nv) - 1ull)); }
            Mk[((size_t)b * NMI + i) * S + r] = wv;
        }
        return;
    }
    for (int i = tid; i < 32 * HROW; i += NT) HIST[i] = 0u;
    if (tid < 32) { ST[tid * 8 + ST_LO] = 0u; ST[tid * 8 + ST_HI] = 0xFFFFFFFFu; ST[tid * 8 + ST_NEED] = 256u; ST[tid * 8 + ST_CNT] = 0u; ST[tid * 8 + ST_FLAGS] = 0u; ST[tid * 8 + ST_NCAND] = 0u; ST[tid * 8 + ST_SH] = 0u; ST[tid * 8 + ST_RUN] = 0u; }
    if (tid == 0) *FLAG = 0u;
    h16x8 afrag[4]; float wreg[16];
    {
        const int qq = cc >> 3, head = cc & 7;
        const size_t row = (size_t)b * S + 32 * u + 4 * w + qq;
#pragma unroll
        for (int ks = 0; ks < 4; ++ks) afrag[ks] = *(const h16x8*)(P + row * NP2 + C_IQ + head * 64 + 16 * ks + 8 * hl);
#pragma unroll
        for (int q4 = 0; q4 < 4; ++q4) { const f32x4 wv = *(const f32x4*)(W8 + ((size_t)b * S + 32 * u + 4 * w + q4) * 8 + 4 * hl); wreg[4 * q4] = wv.x; wreg[4 * q4 + 1] = wv.y; wreg[4 * q4 + 2] = wv.z; wreg[4 * q4 + 3] = wv.w; }
    }
#pragma unroll
    for (int ks = 0; ks < 4; ++ks) asm volatile("" : "+v"(afrag[ks]));
#pragma unroll
    for (int i = 0; i < 16; ++i) asm volatile("" : "+v"(wreg[i]));
    __syncthreads();
#if PROBE == 9
    idx_pass<0>(p, b, u, lds, afrag, wreg);
    for (int i = tid; i < 32 * HROW; i += NT) HIST[i] = 0u;
    __syncthreads();
#endif
    if (!dry) idx_pass<0>(p, b, u, lds, afrag, wreg);
    idx_scan<0>(lds);
    __syncthreads();
    for (int iter = 0; iter < 8; ++iter) {
        if (*FLAG == 0u || PROBE == 14) break;
        __syncthreads();
        if (tid == 0) *FLAG = 0u;
        __syncthreads();
        if (!dry) idx_pass<1>(p, b, u, lds, afrag, wreg);
        idx_scan<1>(lds);
        __syncthreads();
    }
    for (int i = tid; i < 32 * 260; i += NT) MASK[i] = 0u;
    __syncthreads();
    if (!dry) idx_pass<2>(p, b, u, lds, afrag, wreg);
#if PROBE == 8
    if (tid < 32) ST[tid * 8 + ST_NCAND] = 0u;
    __syncthreads();
    idx_pass<2>(p, b, u, lds, afrag, wreg);
#endif
    for (int rrep = 0; rrep < (PROBE == 13 ? 2 : 1); ++rrep)
    for (int q4 = 0; q4 < 4; ++q4) {
        const int q = 4 * w + q4;
        const unsigned fl = ST[q * 8 + ST_FLAGS]; if (fl & FL_TIE) continue;
        unsigned nc = ST[q * 8 + ST_NCAND]; if (nc > CAP) nc = CAP;
        const unsigned need = ST[q * 8 + ST_NEED], lo = ST[q * 8 + ST_LO];
        (void)lo;
        const unsigned* CANDI = (const unsigned*)(lds + IX_CANDI);
        const unsigned k0 = lane < nc ? CAND[q * CAP + lane] : 0u, k1 = lane + 64 < nc ? CAND[q * CAP + lane + 64] : 0u;
        const unsigned i0 = lane < nc ? CANDI[q * CAP + lane] : 0u, i1 = lane + 64 < nc ? CANDI[q * CAP + lane + 64] : 0u;
        unsigned r0 = 0, r1 = 0;
        for (unsigned j = 0; j < nc; ++j) { const unsigned kj = CAND[q * CAP + j], ij = CANDI[q * CAP + j];
            r0 += (kj > k0 || (kj == k0 && ij < i0)) ? 1u : 0u; r1 += (kj > k1 || (kj == k1 && ij < i1)) ? 1u : 0u; }
        if (lane < nc && r0 < need) { const int s = (int)i0; atomicOr(&MASK[q * 260 + ((s >> 6) + 1) * 2 + ((s >> 5) & 1)], 1u << (s & 31)); }
        if (lane + 64 < nc && r1 < need) { const int s = (int)i1; atomicOr(&MASK[q * 260 + ((s >> 6) + 1) * 2 + ((s >> 5) & 1)], 1u << (s & 31)); }
    }
    __syncthreads();
    for (int idx = tid; idx < 32 * nwords; idx += NT) {
        const int q = idx & 31, i = idx >> 5, r = 32 * u + q;
        const unsigned long long wv = i == 0 ? 0xFFFFull : ((unsigned long long)MASK[q * 260 + 2 * i] | ((unsigned long long)MASK[q * 260 + 2 * i + 1] << 32));
        Mk[((size_t)b * NMI + i) * S + r] = wv;
    }
    __syncthreads();
}

namespace attn_body {
using bf16=_Float16;
typedef _Float16 fh16x8 __attribute__((ext_vector_type(8)));
typedef unsigned u32x2 __attribute__((ext_vector_type(2)));
#define MFH(a,b,c,x,y,z) __builtin_amdgcn_mfma_f32_32x32x16_f16(__builtin_bit_cast(fh16x8,(a)),__builtin_bit_cast(fh16x8,(b)),(c),0,0,0)
using bf16x8=__attribute__((ext_vector_type(8)))short;
using s16x4=__attribute__((ext_vector_type(4)))short;
using f32x16=__attribute__((ext_vector_type(16)))float;
using u32x4=__attribute__((ext_vector_type(4)))unsigned;
constexpr int BATCH=2,NHEAD=8,SEQ=8192,D=64,DM=NHEAD*D,KVROWS=8320,NMI_=130;
constexpr int NW=8,QBLK=32,QB=QBLK*NW,KVBLK=64,NQB=SEQ/QB;
constexpr int ATTN_PITCH=DM, ATTN_UNIT_ROWS=QB;
__device__ __forceinline__ int crow(int r,int hi){return (r&3)+8*(r>>2)+4*hi;}
#define SBAR() __builtin_amdgcn_sched_barrier(0)
__device__ __forceinline__ float msel(int m,int pos,float keepv){ const int t=__builtin_amdgcn_sbfe(m,pos,1); float d; asm("v_bfi_b32 %0, %1, %2, %3":"=v"(d):"v"(t),"v"(keepv),"s"(0xFF800000u)); return d; }
__device__ __forceinline__ void cinit(f32x16&p0,f32x16&p1,const u32x2&m,int hi,float nmh){
  const int m0=(int)(m[0]>>(4*hi)), m1=(int)(m[1]>>(4*hi));
  #pragma unroll
  for(int r=0;r<16;++r){ const int pos=(r&3)+8*(r>>2); p0[r]=msel(m0,pos,nmh); p1[r]=msel(m1,pos,nmh); }
  asm volatile("s_nop 1":"+v"(p0),"+v"(p1));
}
__device__ __forceinline__ void mload(u32x2&m,const unsigned long long*p){ asm volatile("global_load_dwordx2 %0, %1, off":"=v"(m):"v"(p):"memory"); }
constexpr int NSLOT=3, SLOTB=8192;
constexpr int LDS_K=0, LDS_V=NSLOT*SLOTB, LDS_WS=2*NSLOT*SLOTB, LDS_OST=LDS_WS+NW*64*4, LDS_BYTES=LDS_OST+NW*4096;
constexpr float C2=0.125f*1.4426950408889634f;
__device__ __forceinline__ void glds16(const void*gsrc,unsigned lds_dst){unsigned keep;
  asm volatile("s_mov_b32 %0, m0\n\ts_mov_b32 m0, %2\n\ts_nop 0\n\tglobal_load_lds_dwordx4 %1, off\n\ts_mov_b32 m0, %0":"=&s"(keep):"v"(gsrc),"s"(lds_dst):"memory");}
__device__ __forceinline__ float max3f(float a,float b,float c){float r;asm("v_max3_f32 %0, %1, %2, %3":"=v"(r):"v"(a),"v"(b),"v"(c));return r;}
__device__ __forceinline__ float max2f(float a,float b){float r;asm("v_max_f32_e32 %0, %1, %2":"=v"(r):"v"(a),"v"(b));return r;}
__device__ __forceinline__ float fadd_s(float a,float b){float r;asm("v_add_f32_e32 %0, %1, %2":"=v"(r):"v"(a),"v"(b));return r;}
__device__ __forceinline__ float fsub_s(float a,float b){float r;asm("v_sub_f32_e32 %0, %1, %2":"=v"(r):"v"(a),"v"(b));return r;}
typedef float f32x2_t __attribute__((ext_vector_type(2))); typedef _Float16 bf16x2_t __attribute__((ext_vector_type(2)));
__device__ __forceinline__ unsigned cvtpk_s(float lo,float hi){f32x2_t v={lo,hi};bf16x2_t b=__builtin_convertvector(v,bf16x2_t);return __builtin_bit_cast(unsigned,b);}
#define WAIT_BAR(N) asm volatile("s_waitcnt vmcnt(" #N ") lgkmcnt(0)\n\ts_barrier":::"memory")
#define WAIT_BAR_M(N,M) do{ asm volatile("s_waitcnt vmcnt(" #N ") lgkmcnt(0)\n\ts_barrier":::"memory"); __builtin_amdgcn_sched_barrier(0); asm volatile("":"+v"(M)); }while(0)
#define WAIT_BAR_M2(N,M,M2) do{ asm volatile("s_waitcnt vmcnt(" #N ") lgkmcnt(0)\n\ts_barrier":::"memory"); __builtin_amdgcn_sched_barrier(0); asm volatile("":"+v"(M),"+v"(M2)); }while(0)

__device__ __forceinline__ void qkt(f32x16&p0,f32x16&p1,const char*Kslot,const bf16x8*qr,int r32,int hi){
  const char*kb=Kslot+hi*1024+r32*16;
  #pragma unroll
  for(int d0=0;d0<4;++d0){
    const bf16x8 b0=*reinterpret_cast<const bf16x8*>(kb+d0*2048);
    const bf16x8 b1=*reinterpret_cast<const bf16x8*>(kb+d0*2048+512);
    p0=MFH(b0,qr[d0],p0,0,0,0);p1=MFH(b1,qr[d0],p1,0,0,0);}
}
typedef __attribute__((address_space(3))) const char* lds_cptr;
typedef short v4i16_t __attribute__((ext_vector_type(4)));
__device__ __forceinline__ void kload8(bf16x8*kf,lds_cptr kp){
  kf[0]=*(const __attribute__((address_space(3))) bf16x8*)(kp);      kf[1]=*(const __attribute__((address_space(3))) bf16x8*)(kp+512);
  kf[2]=*(const __attribute__((address_space(3))) bf16x8*)(kp+2048); kf[3]=*(const __attribute__((address_space(3))) bf16x8*)(kp+2560);
  kf[4]=*(const __attribute__((address_space(3))) bf16x8*)(kp+4096); kf[5]=*(const __attribute__((address_space(3))) bf16x8*)(kp+4608);
  kf[6]=*(const __attribute__((address_space(3))) bf16x8*)(kp+6144); kf[7]=*(const __attribute__((address_space(3))) bf16x8*)(kp+6656);
}
__device__ __forceinline__ void kload2(bf16x8*kf,lds_cptr kp,int j){ kf[2*j]=*(const __attribute__((address_space(3))) bf16x8*)(kp+j*2048); kf[2*j+1]=*(const __attribute__((address_space(3))) bf16x8*)(kp+j*2048+512); }
__device__ __forceinline__ s16x4 vtr(lds_cptr p){ return __builtin_bit_cast(s16x4,__builtin_amdgcn_ds_read_tr16_b64_v4i16((__attribute__((address_space(3))) v4i16_t*)p)); }
__device__ __forceinline__ float rowmax(const f32x16&p0,const f32x16&p1){
  float a=max3f(p0[0],p0[1],p1[0]),b=max3f(p0[2],p0[3],p1[1]);a=max3f(a,p1[2],p1[3]);
  #pragma unroll
  for(int r=4;r<16;r+=4){a=max3f(a,p0[r],p0[r+1]);b=max3f(b,p0[r+2],p0[r+3]);a=max3f(a,p1[r],p1[r+1]);b=max3f(b,p1[r+2],p1[r+3]);}
  const float m=max2f(a,b);
  auto rr=__builtin_amdgcn_permlane32_swap(__float_as_uint(m),__float_as_uint(m),false,false);
  return max2f(__uint_as_float(rr[0]),__uint_as_float(rr[1]));
}
__device__ __forceinline__ void pv(f32x16*o,int vb,bf16x8 pa0,bf16x8 pa1,bf16x8 pa2,bf16x8 pa3){
  #pragma unroll
  for(int d0=0;d0<2;++d0){s16x4 lo[4],hi[4];
    #pragma unroll
    for(int ks=0;ks<4;++ks){
      asm volatile("ds_read_b64_tr_b16 %0,%1 offset:%c2":"=&v"(lo[ks]):"v"(vb),"i"(d0*4096+ks*1024):"memory");
      asm volatile("ds_read_b64_tr_b16 %0,%1 offset:%c2":"=&v"(hi[ks]):"v"(vb),"i"(d0*4096+ks*1024+512):"memory");}
    asm volatile("s_waitcnt lgkmcnt(0)":::"memory");SBAR();
    #define PK(k) (bf16x8){lo[k][0],lo[k][1],lo[k][2],lo[k][3],hi[k][0],hi[k][1],hi[k][2],hi[k][3]}
    o[d0]=MFH(pa0,PK(0),o[d0],0,0,0);
    o[d0]=MFH(pa1,PK(1),o[d0],0,0,0);
    o[d0]=MFH(pa2,PK(2),o[d0],0,0,0);
    o[d0]=MFH(pa3,PK(3),o[d0],0,0,0);
    #undef PK
  }
}

#ifndef ATTN_STORE16
#define ATTN_STORE16(p,v) (*(u32x4*)(p)=(v))
#endif
template<int THRL> __device__ __forceinline__ void attn_unit(int b,int h,int qb,const bf16*Q,const bf16*__restrict__ K,const bf16*__restrict__ V,bf16*O,const unsigned long long*__restrict__ Mk,char*shm){
  const int tid=threadIdx.x,lane=tid&63,r32=lane&31,hi=lane>>5; const int wid=__builtin_amdgcn_readfirstlane(tid>>6);
  const long rowbase=(long)b*SEQ, kvbase=(long)b*KVROWS; const int q0=qb*QB;
  const bf16*Qw=Q+(rowbase+q0+wid*QBLK)*DM+h*D;
  const bf16*Kh=K+kvbase*DM+h*D,*Vh=V+kvbase*DM+h*D;
  const unsigned long long*mrow=Mk+(long)b*NMI_*SEQ+(q0+wid*QBLK+r32);
  u32x2 mA,mB; mload(mA,mrow); mload(mB,mrow+SEQ);
  const unsigned lds0=(unsigned)(uintptr_t)shm;
  float*wsf=(float*)(shm+LDS_WS)+wid*64;
  const bf16*ksrc=Kh+(long)lane*DM+wid*8;
  const bf16*vsrc=Vh+(long)(16*(wid&3)+(lane>>2))*DM+(wid>>2)*32+(lane&3)*8;
  const unsigned kdst=lds0+LDS_K+wid*1024, vdst=lds0+LDS_V+wid*1024;
  #define DMA_K(t,slot) glds16(ksrc+(long)(t)*KVBLK*DM,(unsigned)__builtin_amdgcn_readfirstlane(kdst+(slot)))
  #define DMA_V(t,slot) glds16(vsrc+(long)(t)*KVBLK*DM,(unsigned)__builtin_amdgcn_readfirstlane(vdst+(slot)))
  const int vb0=(int)(lds0+LDS_V)+((lane>>4)&1)*32+(lane&3)*8+(4*hi+((lane&15)>>2))*64;
  const char*Kbase=shm+LDS_K; bf16x8 kf[8];
  const lds_cptr shm3=(lds_cptr)shm; const lds_cptr kp0=shm3+LDS_K+hi*1024+r32*16; const lds_cptr vp0=shm3+LDS_V+((lane>>4)&1)*32+(lane&3)*8+(4*hi+((lane&15)>>2))*64;
  const int NT=(q0+QB)/KVBLK+2;
  DMA_K(0,0);DMA_V(0,0);DMA_K(1,SLOTB);
  bf16x8 qr[4];
  #pragma unroll
  for(int d0=0;d0<4;++d0)qr[d0]=*reinterpret_cast<const bf16x8*>(&Qw[(long)r32*DM+d0*16+hi*8]);
  float mhat=0.f,l_reg=0.f;f32x16 o[2];o[0]=f32x16{};o[1]=f32x16{};
  const int qrel=wid*QBLK+r32;
  bool resc=false;
  #define START(P0,P1) do{ const float rm=rowmax(P0,P1); resc=false; \
    { const float dl=rm; mhat=fadd_s(mhat,dl); \
      _Pragma("unroll") for(int r=0;r<16;++r){P0[r]=fsub_s(P0[r],dl);P1[r]=fsub_s(P1[r],dl);} \
      } \
    _Pragma("unroll") for(int r=0;r<16;++r)P0[r]=__builtin_amdgcn_exp2f(P0[r]); }while(0)
  #define RESC() do{ if(resc){ asm volatile("s_waitcnt lgkmcnt(0)":::"memory"); \
      _Pragma("unroll") for(int d_=0;d_<2;++d_) _Pragma("unroll") for(int r=0;r<16;++r)o[d_][r]*=wsf[crow(r,hi)]; } }while(0)
  f32x16 pA0,pA1,pB0,pB1;
  int sl_prev=0,sl_cur=0,sl_next=SLOTB;
  #define ROT() do{sl_prev=sl_cur;sl_cur=sl_next;sl_next=(sl_next==(NSLOT-1)*SLOTB)?0:sl_next+SLOTB;}while(0)
  DMA_K(2,2*SLOTB);
  WAIT_BAR_M2(3,mA,mB);
  cinit(pA0,pA1,mA,hi,0.f);qkt(pA0,pA1,Kbase,qr,r32,hi);asm volatile("s_nop 15\n\ts_nop 7":"+v"(pA0),"+v"(pA1));
  START(pA0,pA1);
  _Pragma("unroll") for(int r=0;r<16;++r)pA1[r]=__builtin_amdgcn_exp2f(pA1[r]);
  WAIT_BAR(0);
  DMA_K(3,0);DMA_V(1,SLOTB);
  ROT();
  kload8(kf,kp0+sl_cur);
  WAIT_BAR(2);
  s16x4 vlo[8],vhi[8]; u32x4 pw0,pw1,pw2,pw3;
  #define PKW(P,B) cvtpk_s(P[B],P[B+1])
  #define PAF(k) __builtin_bit_cast(bf16x8,pw##k)
  #define VFR(i) (bf16x8){vlo[i][0],vlo[i][1],vlo[i][2],vlo[i][3],vhi[i][0],vhi[i][1],vhi[i][2],vhi[i][3]}
  #define PIN(x) asm volatile("":"+v"(x))
  #define MX3(a,b,c) __builtin_fmaxf(__builtin_fmaxf((a),(b)),(c))
  #define GAPA(MF,A0,A1,A2,A3,W0,W1,PW) do{ MF; sacc+=A0; sacc+=A1; sacc+=A2; sacc+=A3; PIN(sacc); W0; W1; PIN(PW); SBAR(); }while(0)
  #define EX(v) __builtin_amdgcn_exp2f(v)
  #define GAPB(MF,X,B) do{ MF; X[B]=EX(X[B]); X[B+1]=EX(X[B+1]); X[B+2]=EX(X[B+2]); X[B+3]=EX(X[B+3]); PIN(X); SBAR(); }while(0)
  #define VRD(i) do{ vlo[i]=vtr(vp_+(((i)>>2)*4096+((i)&3)*1024)); vhi[i]=vtr(vp_+(((i)>>2)*4096+((i)&3)*1024+512)); }while(0)
  #define KRD(G,j) do{ if(G){ kload2(kf,kp0+sl_next,j); SBAR(); } }while(0)
  #define STEP(C0,C1,P0,P1,t,GK,GV,GL,MC,MN,GM) do{ SBAR(); \
    if(GM){mload(MN,mrow+(long)((t)+1)*SEQ);} \
    cinit(C0,C1,MC,hi,-mhat); SBAR(); \
    const lds_cptr vp_=vp0+sl_prev; \
    VRD(0); SBAR(); float sacc=(P0[0]+P0[1]); \
    GAPA(C0=MFH(kf[0],qr[0],C0,0,0,0), P0[2],P0[3],P0[4],P0[5],     pw0[0]=PKW(P0,0), pw0[1]=PKW(P0,2), pw0); \
    VRD(4); SBAR(); GAPA(C1=MFH(kf[1],qr[0],C1,0,0,0), P0[6],P0[7],P0[8],P0[9],     pw0[2]=PKW(P0,4), pw0[3]=PKW(P0,6), pw0); \
    VRD(1); SBAR(); GAPA(C0=MFH(kf[2],qr[1],C0,0,0,0),   P0[10],P0[11],P0[12],P0[13], pw1[0]=PKW(P0,8), pw1[1]=PKW(P0,10), pw1); \
    VRD(5); SBAR(); GAPA(C1=MFH(kf[3],qr[1],C1,0,0,0),   P0[14],P0[15],P1[0],P1[1],   pw1[2]=PKW(P0,12),pw1[3]=PKW(P0,14), pw1); \
    VRD(2); SBAR(); GAPA(C0=MFH(kf[4],qr[2],C0,0,0,0),   P1[2],P1[3],P1[4],P1[5],     pw2[0]=PKW(P1,0), pw2[1]=PKW(P1,2), pw2); \
    VRD(6); SBAR(); GAPA(C1=MFH(kf[5],qr[2],C1,0,0,0),   P1[6],P1[7],P1[8],P1[9],     pw2[2]=PKW(P1,4), pw2[3]=PKW(P1,6), pw2); \
    VRD(3); SBAR(); GAPA(C0=MFH(kf[6],qr[3],C0,0,0,0),   P1[10],P1[11],P1[12],P1[13], pw3[0]=PKW(P1,8), pw3[1]=PKW(P1,10), pw3); \
    VRD(7); SBAR(); GAPA(C1=MFH(kf[7],qr[3],C1,0,0,0),   P1[14],P1[15],0.f,0.f,       pw3[2]=PKW(P1,12),pw3[3]=PKW(P1,14), pw3); \
    l_reg+=sacc; \
    if(GK){DMA_K((t)+3,sl_cur);} if(GV){DMA_V((t)+1,sl_next);} \
    { float a=MX3(C0[0],C0[1],C1[0]),b=MX3(C0[2],C0[3],C1[1]); a=MX3(a,C1[2],C1[3]); \
      _Pragma("unroll") for(int r=4;r<16;r+=4){a=MX3(a,C0[r],C0[r+1]);b=MX3(b,C0[r+2],C0[r+3]);a=MX3(a,C1[r],C1[r+1]);b=MX3(b,C1[r+2],C1[r+3]);} \
      float rm=__builtin_fmaxf(a,b); { auto rr=__builtin_amdgcn_permlane32_swap(__float_as_uint(rm),__float_as_uint(rm),false,false); rm=__builtin_fmaxf(__uint_as_float(rr[0]),__uint_as_float(rr[1])); } \
      resc=false; \
      if(__builtin_expect(__any(rm>(float)THRL),0)){ const float dl=__builtin_fmaxf(rm,0.f); mhat+=dl; \
        _Pragma("unroll") for(int r=0;r<16;++r){C0[r]-=dl;C1[r]-=dl;} \
        const float f=__builtin_amdgcn_exp2f(-dl); l_reg*=f; if(hi==0)wsf[r32]=f; resc=true; } } \
    SBAR(); \
    GAPB(o[0]=MFH(PAF(0),VFR(0),o[0],0,0,0), C0,0); \
    GAPB(o[1]=MFH(PAF(0),VFR(4),o[1],0,0,0), C0,4); \
    KRD(GL,0); GAPB(o[0]=MFH(PAF(1),VFR(1),o[0],0,0,0), C0,8); \
    KRD(GL,1); GAPB(o[1]=MFH(PAF(1),VFR(5),o[1],0,0,0), C0,12); \
    KRD(GL,2); GAPB(o[0]=MFH(PAF(2),VFR(2),o[0],0,0,0), C1,0); \
    KRD(GL,3); GAPB(o[1]=MFH(PAF(2),VFR(6),o[1],0,0,0), C1,4); \
    GAPB(o[0]=MFH(PAF(3),VFR(3),o[0],0,0,0), C1,8); \
    GAPB(o[1]=MFH(PAF(3),VFR(7),o[1],0,0,0), C1,12); \
    }while(0)
  int t=1;
  for(;t+5<NT;t+=2){
    STEP(pB0,pB1,pA0,pA1,t,true,true,true,mB,mA,true);     WAIT_BAR_M(2,mA); RESC(); ROT();
    STEP(pA0,pA1,pB0,pB1,t+1,true,true,true,mA,mB,true);   WAIT_BAR_M(2,mB); RESC(); ROT();
  }
  #define ENDW(tt,M) do{ if((tt)+3<NT){WAIT_BAR_M(2,M);} else if((tt)+2<NT){WAIT_BAR_M(1,M);} else {WAIT_BAR_M(0,M);} }while(0)
  for(;t+1<NT;t+=2){
    STEP(pB0,pB1,pA0,pA1,t,(t+3<NT),(t+1<NT),(t+1<NT),mB,mA,(t+1<NT));       ENDW(t,mA);   RESC(); ROT();
    STEP(pA0,pA1,pB0,pB1,t+1,(t+4<NT),(t+2<NT),(t+2<NT),mA,mB,(t+2<NT));     ENDW(t+1,mB); RESC(); ROT();
  }
  STEP(pB0,pB1,pA0,pA1,NT-1,false,false,false,mB,mA,false); RESC();
  { float sacc=pB0[0]+pB0[1]; _Pragma("unroll") for(int r=2;r<16;++r)sacc+=pB0[r]; _Pragma("unroll") for(int r=0;r<16;++r)sacc+=pB1[r]; l_reg+=sacc;
    pw0=(u32x4){PKW(pB0,0),PKW(pB0,2),PKW(pB0,4),PKW(pB0,6)};pw1=(u32x4){PKW(pB0,8),PKW(pB0,10),PKW(pB0,12),PKW(pB0,14)};pw2=(u32x4){PKW(pB1,0),PKW(pB1,2),PKW(pB1,4),PKW(pB1,6)};pw3=(u32x4){PKW(pB1,8),PKW(pB1,10),PKW(pB1,12),PKW(pB1,14)};
    SBAR(); pv(o,vb0+sl_cur,PAF(0),PAF(1),PAF(2),PAF(3)); }
  #undef PKW
  #undef PAF
  #undef VFR
  #undef PIN
  #undef MX3
  #undef GAPA
  #undef GAPB
  #undef EX
  #undef VRD
  #undef KRD
  #undef STEP
  #undef ENDW
  {auto rr=__builtin_amdgcn_permlane32_swap(__float_as_uint(l_reg),__float_as_uint(l_reg),false,false);l_reg=__uint_as_float(rr[0])+__uint_as_float(rr[1]);}
  if(hi==0)wsf[32+r32]=l_reg;asm volatile("s_waitcnt lgkmcnt(0)":::"memory");
  float rli[16];
  #pragma unroll
  for(int r=0;r<16;++r)rli[r]=__builtin_amdgcn_rcpf(wsf[32+crow(r,hi)]);
  bf16*Ow=O+(rowbase+q0+wid*QBLK)*DM+h*D;
  { bf16*stg=(bf16*)(shm+LDS_OST)+wid*2048;
    #pragma unroll
    for(int r=0;r<16;++r){const int orow=crow(r,hi);
      #pragma unroll
      for(int d0=0;d0<2;++d0)stg[orow*64+d0*32+r32]=(bf16)(o[d0][r]*rli[r]);}
    asm volatile("s_waitcnt lgkmcnt(0)":::"memory");
    #pragma unroll
    for(int i=0;i<4;++i){const int row=i*8+(lane>>3),ch=lane&7; const u32x4 v=*(const u32x4*)(stg+row*64+ch*8); ATTN_STORE16(Ow+(long)row*DM+ch*8,v);} }
  asm volatile("s_waitcnt lgkmcnt(0)\n\ts_barrier":::"memory");
  #undef DMA_K
  #undef DMA_V
  #undef START
  #undef RESC
  #undef ROT
}
constexpr int ATTN_LDS_BYTES=LDS_BYTES;
struct AttnTensors { const bf16* Q; const bf16* K; const bf16* V; bf16* O; const unsigned long long* Mk; };
struct AttnUnit { int bh; int qb; };
struct StaticOrder {
  int vcu,G;
  __device__ __forceinline__ explicit StaticOrder(int grid,int block):vcu((grid%8==0)?((block%8)*(grid/8)+block/8):block),G(grid){}
  __device__ __forceinline__ bool next(int i,AttnUnit&u)const{ const int v=vcu+G*(i>>1); if(v>=256)return false; const int s=v&15; u.bh=v>>4; u.qb=(i&1)?s:31-s; return true; }
};
template<class Sched,int THRL=8> __device__ __forceinline__ void attn_phase(char*lds,const AttnTensors&T,const Sched&S){
  AttnUnit u;
  for(int i=0;S.next(i,u);++i){ attn_unit<THRL>(u.bh/NHEAD,u.bh%NHEAD,u.qb,T.Q,T.K,T.V,T.O,T.Mk,lds); }
}
#undef SBAR
#undef WAIT_BAR
#undef WAIT_BAR_M
#undef WAIT_BAR_M2
#undef MFH
}

typedef __bf16 bf16;
typedef __bf16 bf16x8 __attribute__((ext_vector_type(8)));
typedef __bf16 bf16x4 __attribute__((ext_vector_type(4)));
typedef __bf16 bf16x2 __attribute__((ext_vector_type(2)));
typedef short s16x4_t __attribute__((ext_vector_type(4)));
typedef short s16x8_t __attribute__((ext_vector_type(8)));
typedef LAS const char* lcptr;
constexpr int HVP = 272;
constexpr int HAP = 144;
__device__ __forceinline__ float hgrn_lb(const Params& p, int idx) { const float l0 = p.lb_logits[idx], l1 = p.lb_logits[512 + idx]; return 1.f / (1.f + __expf(l1 - l0)); }
__device__ __forceinline__ bf16x8 tr_frag(lcptr plo, lcptr phi) {
    const s16x4_t lo = __builtin_amdgcn_ds_read_tr16_b64_v4i16((LAS s16x4_t*)plo), hi = __builtin_amdgcn_ds_read_tr16_b64_v4i16((LAS s16x4_t*)phi);
    return __builtin_bit_cast(bf16x8, (s16x8_t){lo[0], lo[1], lo[2], lo[3], hi[0], hi[1], hi[2], hi[3]});
}
__device__ __forceinline__ void hgrn_fb(const Params& p, const h16* P, size_t rowbase, int h, int d, int g, int L, float (&cs)[16], float (&kk)[16], float* gtot) {
    const float lb = hgrn_lb(p, h * 128 + d);
    float run = 0.f;
#pragma unroll
    for (int i = 0; i < 16; ++i) {
        const int t = 16 * g + i;
        if (t < L) { const float hf = (float)P[(rowbase + t) * NP2 + C_HF + h * 128 + d]; const float f = lb + (1.f - lb) * sigmoidf_(hf); run += __logf(f); kk[i] = 1.f - f; }
        else kk[i] = 0.f;
        cs[i] = run;
    }
    gtot[g * 128 + d] = run;
}
__device__ __forceinline__ void hgrn_load_v(const bf16* Pb, size_t rowbase, int h, int L, char* vs) {
    for (int idx = threadIdx.x; idx < 64 * 16; idx += NT) {
        const int t = idx >> 4, c16 = idx & 15;
        bf16x8 v = {};
        if (t < L) v = *(const bf16x8*)(Pb + (rowbase + t) * NP2 + C_HI + h * 128 + c16 * 8);
        *(bf16x8*)(vs + t * HVP + c16 * 16) = v;
    }
}

constexpr int HA_VS = 0, HA_KT = 17408, HA_GT = 35840;
__device__ __forceinline__ void hgrn_stepA(const Params& p, int item, char* lds) {
    const h16* P = (const h16*)(p.ws + WS_P); bf16* ST = (bf16*)(p.ws + WS_X); float* G = (float*)(p.ws + WS_G);
    float* gtot = (float*)(lds + HA_GT);
    const int tid = threadIdx.x, d = tid & 127, g = tid >> 7;
    const int c = item % NCH, bh = item / NCH, h = bh & 3, b = bh >> 2;
    const int L = c == 0 ? 16 : 64; const size_t rowbase = c == 0 ? (size_t)MREAL : (size_t)(b * S + (c - 1) * 64);
    hgrn_load_v((const bf16*)P, rowbase, h, L, lds + HA_VS);
    float cs[16], kk[16];
    hgrn_fb(p, P, rowbase, h, d, g, L, cs, kk, gtot);
    __syncthreads();
    {
        const float t0 = gtot[d], t1 = gtot[128 + d], t2 = gtot[256 + d], t3 = gtot[384 + d];
        const float bend = (t0 + t1) + (t2 + t3), off = g == 0 ? 0.f : (g == 1 ? t0 : (g == 2 ? t0 + t1 : t0 + t1 + t2));
        bf16x8 o0, o1;
#pragma unroll
        for (int i = 0; i < 8; ++i) { o0[i] = (bf16)(kk[i] * __expf(bend - (off + cs[i]))); o1[i] = (bf16)(kk[8 + i] * __expf(bend - (off + cs[8 + i]))); }
        *(bf16x8*)(lds + HA_KT + d * HAP + 32 * g) = o0; *(bf16x8*)(lds + HA_KT + d * HAP + 32 * g + 16) = o1;
        if (g == 0) G[(size_t)item * 128 + d] = __expf(bend);
    }
    __syncthreads();
    const int w = tid >> 6, lane = tid & 63, hl = lane >> 5, r32 = lane & 31;
    const int dt = w >> 1, vt0 = 2 * (w & 1);
    f32x16 acc0 = {0.f, 0.f, 0.f, 0.f, 0.f, 0.f, 0.f, 0.f, 0.f, 0.f, 0.f, 0.f, 0.f, 0.f, 0.f, 0.f}, acc1 = acc0;
    const lcptr vbase = (lcptr)(lds + HA_VS) + (8 * hl + ((lane & 15) >> 2)) * HVP + (16 * ((lane >> 4) & 1) + 4 * (lane & 3)) * 2;
#pragma unroll
    for (int ks = 0; ks < 4; ++ks) {
        const bf16x8 a = *(const bf16x8*)(lds + HA_KT + (32 * dt + r32) * HAP + (16 * ks + 8 * hl) * 2);
        const lcptr pv0 = vbase + (16 * ks) * HVP + (32 * vt0) * 2, pv1 = pv0 + 64;
        const bf16x8 b0 = tr_frag(pv0, pv0 + 4 * HVP), b1 = tr_frag(pv1, pv1 + 4 * HVP);
        acc0 = __builtin_amdgcn_mfma_f32_32x32x16_bf16(a, b0, acc0, 0, 0, 0);
        acc1 = __builtin_amdgcn_mfma_f32_32x32x16_bf16(a, b1, acc1, 0, 0, 0);
    }
    bf16* o = ST + ((size_t)item * 128 + 32 * vt0 + r32) * 128 + 32 * dt + 4 * hl;
#pragma unroll
    for (int r4 = 0; r4 < 4; ++r4) {
        const bf16x4 x0 = {(bf16)acc0[4 * r4], (bf16)acc0[4 * r4 + 1], (bf16)acc0[4 * r4 + 2], (bf16)acc0[4 * r4 + 3]};
        const bf16x4 x1 = {(bf16)acc1[4 * r4], (bf16)acc1[4 * r4 + 1], (bf16)acc1[4 * r4 + 2], (bf16)acc1[4 * r4 + 3]};
        *(bf16x4*)(o + 8 * r4) = x0; *(bf16x4*)(o + 32 * 128 + 8 * r4) = x1;
    }
    __syncthreads();
}

__device__ __forceinline__ void hgrn_scan(const Params& p) {
    bf16* ST = (bf16*)(p.ws + WS_X); const float* G = (const float*)(p.ws + WS_G);
    for (int e = blockIdx.x * NT + threadIdx.x; e < NB * 4 * 128 * 64; e += gridDim.x * NT) {
        const int bh = e >> 13, vd = e & 8191, dp = e & 63;
        float s0 = 0.f, s1 = 0.f;
#pragma unroll 8
        for (int c = 0; c < NCH; ++c) {
            bf16x2* ptr = (bf16x2*)(ST + (size_t)(bh * NCH + c) * 16384) + vd;
            const bf16x2 u = *ptr; const f32x2 g = *(const f32x2*)(G + (size_t)(bh * NCH + c) * 128 + 2 * dp);
            const bf16x2 sv = {(bf16)s0, (bf16)s1}; *ptr = sv;
            s0 = g.x * s0 + (float)u[0]; s1 = g.y * s1 + (float)u[1];
        }
    }
}

constexpr int HC_VS = 0, HC_QH = 17408, HC_Q0 = 34816, HC_Q1 = 47872, HC_Q2 = 56576, HC_KD = 60928, HC_KG = 73984, HC_AM = 91392, HC_GT = 100608, HC_OT = 34816, HC_OTP = 132;
__device__ __forceinline__ void hgrn_stepC(const Params& p, int item, char* lds) {
    const h16* P = (const h16*)(p.ws + WS_P); const bf16* ST = (const bf16*)(p.ws + WS_X); h16* MIX = (h16*)(p.ws + WS_MIX);
    float* gtot = (float*)(lds + HC_GT);
    const int tid = threadIdx.x, d = tid & 127, g = tid >> 7;
    const int w = tid >> 6, lane = tid & 63, hl = lane >> 5, r32 = lane & 31;
    const int c = 1 + item % 128, bh = item / 128, h = bh & 3, b = bh >> 2;
    const size_t rowbase = (size_t)(b * S + (c - 1) * 64);
    const int tt = w >> 2, vt = w & 3;
    bf16x8 sfr[8];
    { const bf16* sp = ST + ((size_t)(bh * NCH + c) * 128 + 32 * vt + r32) * 128 + 8 * hl;
#pragma unroll
      for (int ks = 0; ks < 8; ++ks) sfr[ks] = *(const bf16x8*)(sp + 16 * ks); }
    hgrn_load_v((const bf16*)P, rowbase, h, 64, lds + HC_VS);
    for (int i = tid; i < 64 * HAP / 16; i += NT) *(f32x4*)(lds + HC_AM + i * 16) = (f32x4){0.f, 0.f, 0.f, 0.f};
    float cs[16], kk[16], qv[16];
#pragma unroll
    for (int i = 0; i < 16; ++i) qv[i] = siluf_((float)P[(rowbase + 16 * g + i) * NP2 + C_HQ + h * 128 + d]);
    hgrn_fb(p, P, rowbase, h, d, g, 64, cs, kk, gtot);
    __syncthreads();
    {
        const float t0 = gtot[d], t1 = gtot[128 + d], t2 = gtot[256 + d];
        const float bg = g == 0 ? 0.f : (g == 1 ? t0 : (g == 2 ? t0 + t1 : t0 + t1 + t2));
        const float tg = g == 0 ? t0 : (g == 1 ? t1 : t2);
        const float e1 = g >= 2 ? (g == 2 ? t1 : t2) : 0.f;
        const float e2 = g == 3 ? t1 : 0.f;
#pragma unroll
        for (int i = 0; i < 16; ++i) {
            const int t = 16 * g + i; const float cc = cs[i], q = qv[i];
            *(bf16*)(lds + HC_QH + t * HVP + d * 2) = (bf16)(q * __expf(bg + cc));
            if (g >= 1) *(bf16*)(lds + (g == 1 ? HC_Q0 : (g == 2 ? HC_Q1 : HC_Q2)) + i * HVP + d * 2) = (bf16)(q * __expf(cc));
            if (g >= 2) *(bf16*)(lds + (g == 2 ? HC_Q0 : HC_Q1) + (16 + i) * HVP + d * 2) = (bf16)(q * __expf(e1 + cc));
            if (g == 3) *(bf16*)(lds + HC_Q0 + (32 + i) * HVP + d * 2) = (bf16)(q * __expf(e1 + e2 + cc));
            if (g <= 2) *(bf16*)(lds + HC_KD + t * HVP + d * 2) = (bf16)(kk[i] * __expf(tg - cc));
            *(bf16*)(lds + HC_KG + t * HVP + d * 2) = (bf16)(kk[i] * __expf(fminf(-cc, 80.f)));
        }
    }
    __syncthreads();
    for (int n = w; n < 10; n += 8) {
        const int I = n >= 6 ? 3 : (n >= 3 ? 2 : (n >= 1 ? 1 : 0)), J = n - I * (I + 1) / 2;
        const char* qp; const char* kp;
        if (J == I) { qp = I == 0 ? lds + HC_QH : lds + (I == 1 ? HC_Q0 : (I == 2 ? HC_Q1 : HC_Q2)); kp = lds + HC_KG + 16 * I * HVP; }
        else { qp = lds + (J == 0 ? HC_Q0 : (J == 1 ? HC_Q1 : HC_Q2)) + (16 * I - 16 * (J + 1)) * HVP; kp = lds + HC_KD + 16 * J * HVP; }
        f32x4 a4 = {0.f, 0.f, 0.f, 0.f};
        const int fo = (lane & 15) * HVP + 16 * (lane >> 4);
#pragma unroll
        for (int ks = 0; ks < 4; ++ks) {
            const bf16x8 af = *(const bf16x8*)(qp + fo + 64 * ks), bf_ = *(const bf16x8*)(kp + fo + 64 * ks);
            a4 = __builtin_amdgcn_mfma_f32_16x16x32_bf16(af, bf_, a4, 0, 0, 0);
        }
        const int sl = lane & 15, tl0 = 4 * (lane >> 4);
#pragma unroll
        for (int r = 0; r < 4; ++r) { const int tl = tl0 + r; const float val = (J == I && sl > tl) ? 0.f : a4[r]; *(bf16*)(lds + HC_AM + (16 * I + tl) * HAP + (16 * J + sl) * 2) = (bf16)val; }
    }
    __syncthreads();
    f32x16 acc = {0.f, 0.f, 0.f, 0.f, 0.f, 0.f, 0.f, 0.f, 0.f, 0.f, 0.f, 0.f, 0.f, 0.f, 0.f, 0.f};
    {
        const lcptr vbase = (lcptr)(lds + HC_VS) + (8 * hl + ((lane & 15) >> 2)) * HVP + (32 * vt + 16 * ((lane >> 4) & 1) + 4 * (lane & 3)) * 2;
#pragma unroll
        for (int ks = 0; ks < 4; ++ks) {
            const bf16x8 a = *(const bf16x8*)(lds + HC_AM + (32 * tt + r32) * HAP + (16 * ks + 8 * hl) * 2);
            const lcptr pv = vbase + (16 * ks) * HVP;
            acc = __builtin_amdgcn_mfma_f32_32x32x16_bf16(a, tr_frag(pv, pv + 4 * HVP), acc, 0, 0, 0);
        }
#pragma unroll
        for (int ks = 0; ks < 8; ++ks) {
            const bf16x8 a = *(const bf16x8*)(lds + HC_QH + (32 * tt + r32) * HVP + (16 * ks + 8 * hl) * 2);
            acc = __builtin_amdgcn_mfma_f32_32x32x16_bf16(a, sfr[ks], acc, 0, 0, 0);
        }
    }
    __syncthreads();
    float* OT = (float*)(lds + HC_OT);
#pragma unroll
    for (int i = 0; i < 16; ++i) OT[(32 * tt + (i & 3) + 8 * (i >> 2) + 4 * hl) * HC_OTP + 32 * vt + r32] = acc[i];
    __syncthreads();
    {
        const int t = tid >> 3, j = tid & 7;
        f32x4 x[4]; float ss = 0.f;
#pragma unroll
        for (int k = 0; k < 4; ++k) { x[k] = *(const f32x4*)(OT + t * HC_OTP + 16 * j + 4 * k); ss += x[k].x * x[k].x + x[k].y * x[k].y + x[k].z * x[k].z + x[k].w * x[k].w; }
        ss += __shfl_xor(ss, 1); ss += __shfl_xor(ss, 2); ss += __shfl_xor(ss, 4);
        const float rs = rsqrtf(ss * (1.f / 128.f) + 1e-6f);
        const h16* gp = P + (rowbase + t) * NP2 + C_HG + h * 128 + 16 * j;
        const h16x8 g0 = *(const h16x8*)gp, g1 = *(const h16x8*)(gp + 8);
        h16x8 o0, o1;
#pragma unroll
        for (int k = 0; k < 8; ++k) {
            o0[k] = (h16)(x[k >> 2][k & 3] * rs * p.hgrn_norm[16 * j + k] * siluf_((float)g0[k]));
            o1[k] = (h16)(x[2 + (k >> 2)][k & 3] * rs * p.hgrn_norm[16 * j + 8 + k] * siluf_((float)g1[k]));
        }
        h16* op = MIX + (rowbase + t) * D + 512 + h * 128 + 16 * j;
        *(h16x8*)op = o0; *(h16x8*)(op + 8) = o1;
    }
    __syncthreads();
}

__device__ __forceinline__ void phase_mix(const Params& p) {
    const h16* P = (const h16*)(p.ws + WS_P); h16* MIX = (h16*)(p.ws + WS_MIX);
    const int lane = threadIdx.x & 63, wave = threadIdx.x >> 6;
    for (int row = blockIdx.x * 8 + wave; row < MREAL; row += gridDim.x * 8) {
        const h16* pr = P + (size_t)row * NP2; h16* o = MIX + (size_t)row * D; const h16* qo = (const h16*)(p.ws + WS_QB) + (size_t)row * 512;
        const h16x8 a = *(const h16x8*)(qo + lane * 8); const h16x8 g = *(const h16x8*)(pr + C_AG + lane * 8);
        float ss = 0.f;
#pragma unroll
        for (int j = 0; j < 8; ++j) ss += (float)a[j] * (float)a[j];
        const float rs = rsqrtf(wave_sum(ss) * (1.f / 512.f) + 1e-6f);
        h16x8 ov;
#pragma unroll
        for (int j = 0; j < 8; ++j) ov[j] = (h16)((float)a[j] * rs * p.attn_norm[lane * 8 + j] * siluf_((float)g[j]));
        *(h16x8*)(o + lane * 8) = ov;
    }
}

__device__ __forceinline__ void phase_final(const Params& p) {
    const int lane = threadIdx.x & 63, wave = threadIdx.x >> 6;
    for (int row = blockIdx.x * 8 + wave; row < MREAL; row += gridDim.x * 8) {
        float* o = p.out + (size_t)row * D;
        f32x4 v[4]; float ss = 0.f;
        for (int j = 0; j < 4; ++j) { v[j] = *(const f32x4*)(o + (lane + 64 * j) * 4); ss += v[j].x * v[j].x + v[j].y * v[j].y + v[j].z * v[j].z + v[j].w * v[j].w; }
        const float rs = rsqrtf(wave_sum(ss) * (1.f / D) + 1e-6f);
        for (int j = 0; j < 4; ++j) { const f32x4 g = *(const f32x4*)(p.final_norm + (lane + 64 * j) * 4);
            *(f32x4*)(o + (lane + 64 * j) * 4) = (f32x4){v[j].x * rs * g.x, v[j].y * rs * g.y, v[j].z * rs * g.z, v[j].w * rs * g.w}; }
    }
}

#define XB_TMO      128
#define XB_XCNT(j)  (256  + 64 * (j))
#define XB_XSUB(j)  (1280 + 64 * (j))
#define XB_XGEN(j)  (2304 + 64 * (j))
#define XB_TOP      3328
#define XB_TOPGEN   3392
#define XCD_BAR_WORDS 3456
#define XB_SPIN_CAP (1u << 18)

__device__ __forceinline__ unsigned xb_ld(unsigned* p)              { return __hip_atomic_load(p, __ATOMIC_RELAXED, __HIP_MEMORY_SCOPE_AGENT); }
__device__ __forceinline__ unsigned xb_add(unsigned* p, unsigned v) { return __hip_atomic_fetch_add(p, v, __ATOMIC_RELAXED, __HIP_MEMORY_SCOPE_AGENT); }
__device__ __forceinline__ unsigned xb_xcc_id() { return (unsigned)__builtin_amdgcn_s_getreg((3 << 11) | 20) & 0xFu; }
#define XB_SPIN(cond, bar) do { unsigned _sp = 0; while (cond) { __builtin_amdgcn_s_sleep(1); \
    if ((++_sp & 255u) == 0u) { if (xb_ld(&(bar)[XB_TMO])) break; if (_sp > XB_SPIN_CAP) { atomicAdd(&(bar)[XB_TMO], 1u); break; } } } } while (0)

struct XcdBarrier {
    unsigned* bar; unsigned x;
    volatile LAS unsigned* st;
};

__device__ __forceinline__ XcdBarrier xcd_barrier_post(unsigned* bar, volatile LAS unsigned* st) {
    XcdBarrier b; b.bar = bar; b.x = xb_xcc_id(); b.st = st;
    if (threadIdx.x == 0) (void)xb_add(&bar[XB_XCNT(b.x)], 1u);
    return b;
}
__device__ __forceinline__ void xcd_barrier_complete(unsigned* bar, unsigned x, unsigned& nloc, unsigned& nx) {
    const unsigned G = gridDim.x * gridDim.y * gridDim.z;
    unsigned sum, cnt, mine, sp = 0u;
    for (;;) {
        sum = 0u; cnt = 0u; mine = 0u;
#pragma unroll
        for (unsigned j = 0; j < 16; ++j) { const unsigned c = xb_ld(&bar[XB_XCNT(j)]); sum += c; cnt += (c > 0u) ? 1u : 0u; mine = (j == x) ? c : mine; }
        if (sum == G) break;
        __builtin_amdgcn_s_sleep(1);
        if ((++sp & 255u) == 0u) { if (xb_ld(&bar[XB_TMO])) break; if (sp > XB_SPIN_CAP) { atomicAdd(&bar[XB_TMO], 1u); break; } }
    }
    nloc = mine > 0u ? mine : 1u; nx = cnt > 0u ? cnt : 1u;
}

__device__ __forceinline__ void xcd_barrier(const XcdBarrier& b) {
    asm volatile("s_waitcnt vmcnt(0)" ::: "memory");
    __syncthreads();
    if (threadIdx.x == 0) {
        unsigned* bar = b.bar;
        __builtin_amdgcn_s_waitcnt(0);
        unsigned nloc = b.st[0], nx = b.st[1];
        if (nloc == 0u) { xcd_barrier_complete(bar, b.x, nloc, nx); b.st[0] = nloc; b.st[1] = nx; }
        const unsigned old = xb_add(&bar[XB_XSUB(b.x)], 1u);
        const unsigned gen = old / nloc;
        if (old + 1u == (gen + 1u) * nloc) {
            __builtin_amdgcn_fence(__ATOMIC_RELEASE, "agent");
            asm volatile("s_waitcnt vmcnt(0)" ::: "memory");
            const unsigned og = xb_add(&bar[XB_TOP], 1u);
            const unsigned tg = og / nx;
            if (og + 1u == (tg + 1u) * nx) xb_add(&bar[XB_TOPGEN], 1u);
            else XB_SPIN(xb_ld(&bar[XB_TOPGEN]) == tg, bar);
            __builtin_amdgcn_fence(__ATOMIC_ACQUIRE, "agent");
            xb_add(&bar[XB_XGEN(b.x)], 1u);
            asm volatile("s_waitcnt vmcnt(0)" ::: "memory");
        } else {
            XB_SPIN(xb_ld(&bar[XB_XGEN(b.x)]) == gen, bar);
            __builtin_amdgcn_fence(__ATOMIC_ACQUIRE, "agent");
            asm volatile("s_waitcnt vmcnt(0)" ::: "memory");
        }
    }
    __syncthreads();
}


constexpr int NPHASE = 9;
__global__ void __launch_bounds__(NT, 2) mega(Params p, int ph_lo, int ph_hi) {
    extern __shared__ __attribute__((aligned(16))) char lds[];
    cg::grid_group grid = cg::this_grid();
    volatile LAS unsigned* xst = (volatile LAS unsigned*)(LAS char*)(lds + LDS_BYTES - 16);
    if (threadIdx.x < 4) xst[threadIdx.x] = 0u;
    __syncthreads();
    XcdBarrier xbar = xcd_barrier_post((unsigned*)p.ws, xst);
#define IN(k) (ph_lo <= (k) && (k) < ph_hi)
#define SYNC(k) do { if ((k) + 1 < ph_hi) { if ((k) == 0 && USE_CG_SYNC) grid.sync(); else xcd_barrier(xbar); } } while (0)
    if (IN(0)) { phase_prep(p, lds); if (PROBE == 4) phase_prep(p, lds); SYNC(0); }
    if (PROBE == 2) { for (int i = 0; i < 8; ++i) xcd_barrier(xbar); }
    if (IN(1)) { phase_gemm_in(p, lds); if (PROBE == 1) phase_gemm_in(p, lds); SYNC(1); }
    if (IN(3)) {
        constexpr int NA = NB * 4 * NCH;
        for (int rep = 0; rep < ((PROBE == 3 || PROBE == 12) ? 2 : 1); ++rep)
        for (int it = blockIdx.x; it < 512; it += gridDim.x) { const int uu = it < 256 ? 255 - (it >> 1) : (it - 256) >> 1; idx_unit(p, it & 1, uu, lds, (PROBE == 12 && rep == 1) ? 1 : 0); }
        for (int rep = 0; rep < (PROBE == 5 ? 2 : 1); ++rep)
        for (int it = blockIdx.x; it < NA; it += gridDim.x) hgrn_stepA(p, it, lds);
        SYNC(3);
    }
    if (IN(4)) { hgrn_scan(p); SYNC(4); }
    if (IN(5)) {
        constexpr int NC = NB * 4 * 128;
        for (int it = blockIdx.x; it < NC; it += gridDim.x) hgrn_stepC(p, it, lds);
        {
            const attn_body::AttnTensors AT{(const h16*)(p.ws + WS_QB), (const h16*)(p.ws + WS_KB), (const h16*)(p.ws + WS_VB), (h16*)(p.ws + WS_QB), (const unsigned long long*)p.out};
            const attn_body::StaticOrder SO((int)gridDim.x, (int)blockIdx.x);
            attn_body::attn_phase<attn_body::StaticOrder>(lds, AT, SO);
        }
        SYNC(5);
    }
    if (IN(6)) { phase_mix(p); if (PROBE == 6) phase_mix(p); SYNC(6); }
    if (IN(7)) { phase_gemm_out(p, lds); if (PROBE == 7) phase_gemm_out(p, lds); SYNC(7); }
    if (IN(8)) { phase_final(p); }
#undef IN
#undef SYNC
}

extern "C" void kernel_launch(void* const* d_in, const int* in_sizes, int n_in, void* d_out, int out_size, void* d_ws, size_t ws_size, hipStream_t stream) {
    static int grid = 0;
    if (grid == 0) {
        if (n_in != 11 || ws_size < WS_END || out_size != MREAL * D) { fprintf(stderr, "kernel_launch: unexpected shapes n_in %d ws %zu out %d\n", n_in, ws_size, out_size); grid = -1; return; }
        int dev = 0, cus = 0, per_cu = 0;
        hipGetDevice(&dev); hipDeviceGetAttribute(&cus, hipDeviceAttributeMultiprocessorCount, dev);
        hipFuncSetAttribute((const void*)mega, hipFuncAttributeMaxDynamicSharedMemorySize, LDS_BYTES);
        hipOccupancyMaxActiveBlocksPerMultiprocessor(&per_cu, (const void*)mega, NT, LDS_BYTES);
        if (per_cu < 1) { fprintf(stderr, "kernel_launch: occupancy query says %d\n", per_cu); per_cu = 1; }
        grid = cus * 1;
        (void)hipGetLastError();
    }
    if (grid < 0) return;
    Params p{};
    p.x = (const float*)d_in[0]; p.meta = (const float*)d_in[1]; p.mix_norm = (const float*)d_in[2]; p.w_in = (const float*)d_in[3];
    p.idx_g = (const float*)d_in[4]; p.idx_b = (const float*)d_in[5]; p.attn_norm = (const float*)d_in[6]; p.lb_logits = (const float*)d_in[7];
    p.hgrn_norm = (const float*)d_in[8]; p.w_out = (const float*)d_in[9]; p.final_norm = (const float*)d_in[10];
    p.out = (float*)d_out; p.ws = (unsigned char*)d_ws;
    hipMemsetAsync(d_ws, 0, 16384, stream);
#if N_LAUNCH_MODE == 1
    int lo = 0, hi = NPHASE; void* args[] = {&p, &lo, &hi};
    hipError_t e = hipLaunchCooperativeKernel((const void*)mega, dim3(grid), dim3(NT), args, LDS_BYTES, stream);
    if (e != hipSuccess) fprintf(stderr, "cooperative launch failed: %s (grid %d)\n", hipGetErrorString(e), grid);
#else
    for (int ph = 0; ph < NPHASE; ++ph) hipLaunchKernelGGL(mega, dim3(grid), dim3(NT), LDS_BYTES, stream, p, ph, ph + 1);
#endif
}
```

```cpp
#include <hip/hip_runtime.h>
#include <hip/hip_cooperative_groups.h>
#include <cstdint>
#include <cstdio>
namespace cg = cooperative_groups;

typedef _Float16 h16;
typedef _Float16 h16x8 __attribute__((ext_vector_type(8)));
typedef _Float16 h16x4 __attribute__((ext_vector_type(4)));
#define LAS __attribute__((address_space(3)))
typedef float f32x4 __attribute__((ext_vector_type(4)));
typedef float f32x2 __attribute__((ext_vector_type(2)));

#ifndef PROBE
#define PROBE 0
#endif
#ifndef USE_CG_SYNC
#define USE_CG_SYNC 0
#endif
#ifndef N_LAUNCH_MODE
#define N_LAUNCH_MODE 1
#endif

constexpr int NB = 2, S = 8192, NMETA = 16, D = 1024;
constexpr int MREAL = NB * S;
constexpr int MROWS = MREAL + NMETA;
constexpr int MPAD = 16640;
constexpr int NCOL = 4680, NPAD = 4864;
constexpr int G_IK = 4608;
constexpr int NP2 = 3328;
constexpr int C_AG = 0, C_IQ = 512, C_HQ = 1024, C_HF = 1536, C_HI = 2048, C_HG = 2560, C_IK = 3072, C_IW = 3136;
constexpr int KVROWS = 8320;
constexpr int NCH = 129;
constexpr int NT = 512;

constexpr size_t MiB = 1u << 20;
constexpr size_t WS_WTIN = 1 * MiB, WS_WTOUT = 11 * MiB, WS_ROPE = 13 * MiB, WS_W8 = 14 * MiB, WS_KI = 23 * MiB, WS_G = 26 * MiB, WS_P = 27 * MiB, WS_QB = 133 * MiB, WS_KB = 149 * MiB, WS_VB = 166 * MiB, WS_X = 190 * MiB, WS_MIX = 223 * MiB, WS_END = 256 * MiB;
static_assert(WS_P + (size_t)MPAD * NP2 * 2 <= WS_QB && WS_QB + (size_t)MREAL * 512 * 2 <= WS_KB && WS_KB + (size_t)NB * KVROWS * 512 * 2 <= WS_VB && WS_VB + (size_t)NB * KVROWS * 512 * 2 <= WS_X, "ws map");
static_assert(WS_X + (size_t)NB * 4 * NCH * 16384 * 2 <= WS_MIX && WS_X + (size_t)MPAD * D * 2 <= WS_MIX + 0 * MiB + 33 * MiB && WS_MIX + (size_t)MREAL * D * 2 <= WS_END, "ST / HN / MIX");

constexpr int LDS_BYTES = 140 * 1024;

struct Params {
    const float *x, *meta, *mix_norm, *w_in, *idx_g, *idx_b, *attn_norm, *lb_logits, *hgrn_norm, *w_out, *final_norm;
    float* out; unsigned char* ws;
};

__device__ __forceinline__ float wave_sum(float v) {
#pragma unroll
    for (int o = 1; o < 64; o <<= 1) v += __shfl_xor(v, o);
    return v;
}
__device__ __forceinline__ float wave_max(float v) {
#pragma unroll
    for (int o = 1; o < 64; o <<= 1) v = fmaxf(v, __shfl_xor(v, o));
    return v;
}
__device__ __forceinline__ float sigmoidf_(float x) { return 1.f / (1.f + __expf(-x)); }
__device__ __forceinline__ float siluf_(float x) { return x * sigmoidf_(x); }
__device__ __forceinline__ int oldcol(int n) { if (n < 2560) return n; if (n < 4608) return n + 72; const int j = n - 4608; return j < 32 ? 2560 + j : (j < 40 ? 2624 + (j - 32) : ((j >= 128 && j < 160) ? 2592 + (j - 128) : -1)); }
__device__ __forceinline__ unsigned skey(float x) { if (x == 0.f) x = 0.f; unsigned u = __float_as_uint(x); return (u & 0x80000000u) ? ~u : (u | 0x80000000u); }

__device__ __forceinline__ void transpose_item(const float* __restrict__ W, int ldw, int nvalid, bool remap, h16* __restrict__ WT, int K, int item, float* tile) {
    constexpr float C2 = 0.125f * 1.4426950408889634f;
    const int nkt = K / 64, nb = item / nkt, kb = item % nkt, n0 = nb * 64, k0 = kb * 64, tid = threadIdx.x;
    {
        const int nl = tid & 63, kl = tid >> 6, n = n0 + nl;
        int src = -1; if (remap) src = oldcol(n); else if (n < nvalid) src = n;
        const float scl = (remap && n < 512) ? C2 : 1.f;
        for (int kk = kl; kk < 64; kk += 8) tile[kk * 65 + nl] = (src >= 0) ? W[(size_t)(k0 + kk) * ldw + src] * scl : 0.f;
    }
    __syncthreads();
    {
        const int kl = tid & 63, nl = tid >> 6;
        for (int nn = nl; nn < 64; nn += 8) WT[(size_t)(n0 + nn) * K + k0 + kl] = (h16)tile[kl * 65 + nn];
    }
    __syncthreads();
}

__device__ __forceinline__ void phase_prep(const Params& p, char* lds) {
    float* tile = (float*)lds;
    h16* WTin = (h16*)(p.ws + WS_WTIN); h16* WTout = (h16*)(p.ws + WS_WTOUT);
    constexpr int I_IN = (NPAD / 64) * (D / 64), I_OUT = (D / 64) * (D / 64);
    for (int it = blockIdx.x; it < I_IN + I_OUT; it += gridDim.x) {
        if (it < I_IN) transpose_item(p.w_in, NCOL, NCOL, true, WTin, D, it, tile);
        else transpose_item(p.w_out, D, D, false, WTout, D, it - I_IN, tile);
    }
    h16* HN = (h16*)(p.ws + WS_X);
    const int lane = threadIdx.x & 63, wave = threadIdx.x >> 6;
    for (int row = blockIdx.x * 8 + wave; row < MPAD; row += gridDim.x * 8) {
        h16* o = HN + (size_t)row * D;
        if (row >= MROWS) {
            for (int j = 0; j < 4; ++j) { h16x4 z = {(h16)0.f, (h16)0.f, (h16)0.f, (h16)0.f}; *(h16x4*)(o + (lane + 64 * j) * 4) = z; }
            continue;
        }
        const float* src = row < MREAL ? p.x + (size_t)row * D : p.meta + (size_t)(row - MREAL) * D;
        f32x4 v[4]; float ss = 0.f;
        for (int j = 0; j < 4; ++j) { v[j] = *(const f32x4*)(src + (lane + 64 * j) * 4); ss += v[j].x * v[j].x + v[j].y * v[j].y + v[j].z * v[j].z + v[j].w * v[j].w; }
        const float rs = rsqrtf(wave_sum(ss) * (1.f / D) + 1e-6f);
        for (int j = 0; j < 4; ++j) {
            const f32x4 g = *(const f32x4*)(p.mix_norm + (lane + 64 * j) * 4);
            h16x4 hv = {(h16)(v[j].x * rs * g.x), (h16)(v[j].y * rs * g.y), (h16)(v[j].z * rs * g.z), (h16)(v[j].w * rs * g.w)};
            *(h16x4*)(o + (lane + 64 * j) * 4) = hv;
        }
    }
    {
        h16* KB = (h16*)(p.ws + WS_KB); h16* VB = (h16*)(p.ws + WS_VB);
        for (int idx = blockIdx.x * NT + threadIdx.x; idx < NB * 112 * 64; idx += gridDim.x * NT) {
            const int c = idx & 63, rr = (idx >> 6) % 112, b = idx / (112 * 64);
            const int row = b * KVROWS + (rr < 48 ? 16 + rr : 8256 + (rr - 48));
            const h16x8 z = {(h16)0.f, (h16)0.f, (h16)0.f, (h16)0.f, (h16)0.f, (h16)0.f, (h16)0.f, (h16)0.f};
            *(h16x8*)(KB + (size_t)row * 512 + c * 8) = z; *(h16x8*)(VB + (size_t)row * 512 + c * 8) = z;
        }
    }
    float* ROPE = (float*)(p.ws + WS_ROPE);
    const double inv[8] = {1.0, 0.1939227432012558, 0.03760603070259094, 0.007292664609849453, 0.0014142135623842478, 0.00027424818836152554, 5.3182957344688475e-05, 1.0313385246263351e-05};
    for (int idx = blockIdx.x * NT + threadIdx.x; idx < (S + NMETA) * 8; idx += gridDim.x * NT) {
        const int t = idx >> 3, i = idx & 7;
        double iv = inv[0];
        if (i == 1) iv = inv[1]; else if (i == 2) iv = inv[2]; else if (i == 3) iv = inv[3]; else if (i == 4) iv = inv[4]; else if (i == 5) iv = inv[5]; else if (i == 6) iv = inv[6]; else if (i == 7) iv = inv[7];
        const double rev = (double)t * iv * 0.15915494309189535;
        const float fr = (float)(rev - __builtin_rint(rev));
        ROPE[idx * 2] = __builtin_amdgcn_cosf(fr); ROPE[idx * 2 + 1] = __builtin_amdgcn_sinf(fr);
    }
}

namespace pg8 {
#define PG8_LAS __attribute__((address_space(3)))
typedef unsigned short bf16_t;
typedef short bf16x8 __attribute__((ext_vector_type(8)));
typedef unsigned u32x4 __attribute__((ext_vector_type(4)));
constexpr int BM = 256, BK = 64, HALF = 128, HTB = HALF * BK * 2  , STAGE_BYTES = 8 * HTB, NXCD = 8, WGM = 8;

__host__ __device__ __forceinline__ int lds_byte(int r, int c) { const int st = (r >> 4) * 2 + (c >> 5), rr = r & 15, cc = c & 31, ob = rr * 64 + cc * 2; return st * 1024 + (ob ^ (((ob >> 9) & 1) << 5)); }
__host__ __device__ __forceinline__ void stage_rc(int b, int& R, int& C) { const int st = b / 1024, sb = b % 1024, swz = sb ^ (((sb >> 9) & 1) << 5); R = (st >> 1) * 16 + swz / 64; C = (st & 1) * 32 + (swz % 64) / 2; }
__host__ __device__ __forceinline__ int perm32(int rho) { const int n = rho >> 4, i = rho & 15; return 8 * (i >> 2) + 4 * n + (i & 3); }

struct Unit { int pm, pn; };
struct Gemm { const bf16_t* A; const bf16_t* Bt; int M, N, K; };

struct StaticOrder {
    int nM, nN, nwg, G, c;
    __host__ __device__ void init(int M, int N, int G_, int c_) { nM = M / BM; nN = N / BM; nwg = nM * nN; G = G_; c = c_; }
    __host__ __device__ bool next(int i, Unit& u) const {
        const long L = (long)i * G + c; if (L >= nwg) return false;
        int wgid = (int)L; { const int q = nwg / NXCD, r = nwg % NXCD, xcd = wgid % NXCD, off = wgid / NXCD; wgid = (xcd < r ? xcd * (q + 1) : r * (q + 1) + (xcd - r) * q) + off; }
        const int nig = WGM * nN, gid = wgid / nig, fm = gid * WGM, gsz = (nM - fm) < WGM ? (nM - fm) : WGM;
        u.pm = fm + ((wgid % nig) % gsz); u.pn = (wgid % nig) / gsz; return true;
    }
    __device__ __forceinline__ void a_ready(const Unit&) const {}
    __device__ __forceinline__ void done(const Unit&) const {}
};


struct EpiProj {
    static constexpr bool PERM = true, AFTER_DRAIN = false;
    unsigned char* ws; const float* idx_g; const float* idx_b;
    __device__ __forceinline__ void operator()(const f32x4 (&acc)[2][2][4][2], const Unit& u, int wr, int wc, int fr, int fq) const {
        const int pn = u.pn;
        const int row0 = u.pm * BM + wr * 64 + fr, colt = pn * BM + wc * 32 + 8 * fq;
        const bool rope_wave = (pn < 4 || pn == 8 || pn == 9) && !(wc & 1);
        const float* ROPE = (const float*)(ws + WS_ROPE);
#pragma unroll
        for (int ai = 0; ai < 2; ++ai)
#pragma unroll
            for (int m = 0; m < 4; ++m) {
                const int grow = row0 + ai * HALF + m * 16;
                const bool valid = grow < MROWS;
                const int t = grow < MREAL ? NMETA + (grow & (S - 1)) : grow - MREAL;
                if (pn == 18) {
                    if (wc == 0) {
                        float x[16];
#pragma unroll
                        for (int k = 0; k < 4; ++k) { x[k] = acc[ai][0][m][0][k]; x[4 + k] = acc[ai][0][m][1][k]; x[8 + k] = acc[ai][1][m][0][k]; x[12 + k] = acc[ai][1][m][1][k]; }
                        float s = 0.f;
#pragma unroll
                        for (int k = 0; k < 16; ++k) s += x[k];
                        s += __shfl_xor(s, 16); s += __shfl_xor(s, 32);
                        const float mean = s * (1.f / 64.f); float q = 0.f;
#pragma unroll
                        for (int k = 0; k < 16; ++k) { x[k] -= mean; q += x[k] * x[k]; }
                        q += __shfl_xor(q, 16); q += __shfl_xor(q, 32);
                        const float rstd = rsqrtf(q * (1.f / 64.f) + 1e-6f);
#pragma unroll
                        for (int k = 0; k < 16; ++k) { const int c = (k < 8 ? 0 : 32) + 8 * fq + (k & 7); x[k] = x[k] * rstd * idx_g[c] + idx_b[c]; }
                        float px[8];
#pragma unroll
                        for (int k = 0; k < 8; ++k) px[k] = __shfl_xor(x[k], 16);
                        if (fq < 2 && valid) {
                            const f32x4* rp = (const f32x4*)(ROPE + (size_t)t * 16);
#pragma unroll
                            for (int k4 = 0; k4 < 4; ++k4) { const f32x4 cs = rp[k4];
                                x[2 * k4] = fq == 0 ? x[2 * k4] * cs.x - px[2 * k4] * cs.y : x[2 * k4] * cs.x + px[2 * k4] * cs.y;
                                x[2 * k4 + 1] = fq == 0 ? x[2 * k4 + 1] * cs.z - px[2 * k4 + 1] * cs.w : x[2 * k4 + 1] * cs.z + px[2 * k4 + 1] * cs.w; }
                        }
                        if (valid) {
                            h16* kp = (h16*)(ws + WS_KI) + (size_t)grow * 64 + 8 * fq;
                            *(h16x8*)kp = (h16x8){(h16)x[0], (h16)x[1], (h16)x[2], (h16)x[3], (h16)x[4], (h16)x[5], (h16)x[6], (h16)x[7]};
                            *(h16x8*)(kp + 32) = (h16x8){(h16)x[8], (h16)x[9], (h16)x[10], (h16)x[11], (h16)x[12], (h16)x[13], (h16)x[14], (h16)x[15]};
                        }
                    } else if (wc == 1 && fq == 0 && valid) {
                        float* wp = (float*)(ws + WS_W8) + (size_t)grow * 8;
                        *(f32x4*)wp = acc[ai][0][m][0]; *(f32x4*)(wp + 4) = acc[ai][0][m][1];
                    }
                    continue;
                }
                f32x4 cs4[4];
                if (rope_wave && fq < 2 && valid) { const f32x4* rp = (const f32x4*)(ROPE + (size_t)t * 16);
#pragma unroll
                    for (int k4 = 0; k4 < 4; ++k4) cs4[k4] = rp[k4]; }
#pragma unroll
                for (int bj = 0; bj < 2; ++bj) {
                    const int gcol = colt + bj * HALF;
                    f32x4 v0 = acc[ai][bj][m][0], v1 = acc[ai][bj][m][1];
                    if (rope_wave) {
                        float x[8] = {v0[0], v0[1], v0[2], v0[3], v1[0], v1[1], v1[2], v1[3]}, px[8];
#pragma unroll
                        for (int k = 0; k < 8; ++k) px[k] = __shfl_xor(x[k], 16);
                        if (fq < 2 && valid) {
#pragma unroll
                            for (int k4 = 0; k4 < 4; ++k4) { const f32x4 cs = cs4[k4];
                                x[2 * k4] = fq == 0 ? x[2 * k4] * cs.x - px[2 * k4] * cs.y : x[2 * k4] * cs.x + px[2 * k4] * cs.y;
                                x[2 * k4 + 1] = fq == 0 ? x[2 * k4 + 1] * cs.z - px[2 * k4 + 1] * cs.w : x[2 * k4 + 1] * cs.z + px[2 * k4 + 1] * cs.w; }
                            v0 = (f32x4){x[0], x[1], x[2], x[3]}; v1 = (f32x4){x[4], x[5], x[6], x[7]};
                        }
                    }
                    h16x8 hv = {(h16)v0[0], (h16)v0[1], (h16)v0[2], (h16)v0[3], (h16)v1[0], (h16)v1[1], (h16)v1[2], (h16)v1[3]};
                    if (pn == 14 || pn == 15) {
                        typedef __bf16 b16x8 __attribute__((ext_vector_type(8)));
                        const b16x8 bv = {(__bf16)v0[0], (__bf16)v0[1], (__bf16)v0[2], (__bf16)v0[3], (__bf16)v1[0], (__bf16)v1[1], (__bf16)v1[2], (__bf16)v1[3]};
                        hv = __builtin_bit_cast(h16x8, bv);
                    }
                    if (gcol < 512) { if (grow < MREAL) *(h16x8*)((h16*)(ws + WS_QB) + (size_t)grow * 512 + gcol) = hv; }
                    else if (gcol < 1536) {
                        h16* dst = (h16*)(ws + (gcol < 1024 ? WS_KB : WS_VB)); const int cc = (gcol - 512) & 511;
                        if (grow < MREAL) *(h16x8*)(dst + ((size_t)(grow >> 13) * KVROWS + 64 + (grow & (S - 1))) * 512 + cc) = hv;
                        else if (grow < MROWS) { *(h16x8*)(dst + (size_t)(grow - MREAL) * 512 + cc) = hv; *(h16x8*)(dst + ((size_t)KVROWS + (grow - MREAL)) * 512 + cc) = hv; }
                    } else {
                        *(h16x8*)((h16*)(ws + WS_P) + (size_t)grow * NP2 + (gcol - 1536)) = hv;
                    }
                }
            }
    }
};
struct EpiOut {
    static constexpr bool PERM = false, AFTER_DRAIN = false;
    const float* x; float* out;
    __device__ __forceinline__ void operator()(const f32x4 (&acc)[2][2][4][2], const Unit& u, int wr, int wc, int fr, int fq) const {
        const int row0 = u.pm * BM + wr * 64 + fr, col0 = u.pn * BM + wc * 32 + 4 * fq;
#pragma unroll
        for (int ai = 0; ai < 2; ++ai)
#pragma unroll
            for (int m = 0; m < 4; ++m) {
                const size_t off = (size_t)(row0 + ai * HALF + m * 16) * D + col0;
#pragma unroll
                for (int bj = 0; bj < 2; ++bj)
#pragma unroll
                    for (int n = 0; n < 2; ++n) { const f32x4 xv = *(const f32x4*)(x + off + bj * HALF + n * 16); *(f32x4*)(out + off + bj * HALF + n * 16) = xv + acc[ai][bj][m][n]; }
            }
    }
};
template <class Epi, class Sched, bool ALIGN_EPI = false, bool SP2 = false>
__device__ __forceinline__ void gemm_phase(PG8_LAS unsigned char* lds, const Gemm g, const Sched& S, const Epi& E) {
    const int tid = threadIdx.x, wid = __builtin_amdgcn_readfirstlane(tid >> 6), lane = tid & 63, wr = wid >> 2, wc = wid & 3, fr = lane & 15, fq = lane >> 4;
    const int K = g.K, nt = K / BK;
    unsigned voffA[2], voffB[2];
#pragma unroll
    for (int i = 0; i < 2; ++i) { int R, C; stage_rc(tid * 16 + i * 8192, R, C); const int Rb = Epi::PERM ? ((R & ~31) + perm32(R & 31)) : R;
        voffA[i] = (unsigned)(R * K + C) * 2u; voffB[i] = (unsigned)(Rb * K + C) * 2u; }
    const size_t kstep = (size_t)(BK * 2);
    const size_t hstep = (size_t)HALF * K * 2;
    const size_t tstep = 2 * hstep;
    const unsigned ldsw = (unsigned)wid * 1024u;
    const int aoff = lds_byte(wr * 64 + fr, fq * 8), boff = lds_byte(wc * 32 + fr, fq * 8);
#define PG8_SA(b, h) (((b) * 2 + (h)) * HTB)
#define PG8_SB(b, h) ((4 + (b) * 2 + (h)) * HTB)
#define PG8_STAGE(bufoff, gbase, voff) do { _Pragma("unroll") for (int _i = 0; _i < 2; ++_i) \
        __builtin_amdgcn_global_load_lds((const unsigned*)((const char*)(gbase) + (voff)[_i]), (PG8_LAS unsigned*)(lds + (bufoff) + ldsw + _i * 8192), 16, 0, 0); } while (0)
#define PG8_LDA(dst, b, h) do { _Pragma("unroll") for (int m = 0; m < 4; ++m) _Pragma("unroll") for (int k = 0; k < 2; ++k) dst[m][k] = *(const PG8_LAS bf16x8*)(lds + PG8_SA(b, h) + aoff + m * 2048 + k * 1024); } while (0)
#define PG8_LDB(dst, b, h) do { _Pragma("unroll") for (int n = 0; n < 2; ++n) _Pragma("unroll") for (int k = 0; k < 2; ++k) dst[n][k] = *(const PG8_LAS bf16x8*)(lds + PG8_SB(b, h) + boff + n * 2048 + k * 1024); } while (0)
#define PG8_MMA(ai, bj, At, Bt) do { __builtin_amdgcn_s_setprio(1); _Pragma("unroll") for (int m = 0; m < 4; ++m) _Pragma("unroll") for (int n = 0; n < 2; ++n) _Pragma("unroll") for (int k = 0; k < 2; ++k) \
        acc[ai][bj][m][n] = __builtin_amdgcn_mfma_f32_16x16x32_f16(__builtin_bit_cast(h16x8, Bt[n][k]), __builtin_bit_cast(h16x8, At[m][k]), acc[ai][bj][m][n], 0, 0, 0); __builtin_amdgcn_s_setprio(0); } while (0)
#define PG8_WAIT_V(n) asm volatile("s_waitcnt vmcnt(" #n ")" ::: "memory")
#define PG8_WAIT_L(n) asm volatile("s_waitcnt lgkmcnt(" #n ")" ::: "memory")
#define PG8_BAR __builtin_amdgcn_s_barrier()
#define PG8_SCHED __builtin_amdgcn_sched_barrier(0)
    Unit cur, nxt; int ui = 0;
    if (!S.next(0, cur)) return;
    f32x4 acc[2][2][4][2];
#pragma unroll
    for (int a = 0; a < 2; ++a)
#pragma unroll
        for (int b = 0; b < 2; ++b)
#pragma unroll
            for (int m = 0; m < 4; ++m)
#pragma unroll
                for (int n = 0; n < 2; ++n) acc[a][b][m][n] = (f32x4){0.f, 0.f, 0.f, 0.f};
    bf16x8 At[4][2], B0[2][2], B1[2][2];
    const char* cA = (const char*)g.A + (size_t)cur.pm * tstep; const char* cB = (const char*)g.Bt + (size_t)cur.pn * tstep;
    S.a_ready(cur);
    if constexpr (SP2) {
        PG8_STAGE(PG8_SB(0, 0), cB, voffB); PG8_STAGE(PG8_SB(0, 1), cB + hstep, voffB); PG8_STAGE(PG8_SA(0, 0), cA, voffA); PG8_STAGE(PG8_SA(0, 1), cA + hstep, voffA);
        if (wr == 1) PG8_BAR;
        PG8_WAIT_V(2); PG8_BAR;
        PG8_STAGE(PG8_SB(1, 0), cB + kstep, voffB); PG8_STAGE(PG8_SA(1, 0), cA + kstep, voffA); PG8_STAGE(PG8_SB(1, 1), cB + hstep + kstep, voffB);
        PG8_WAIT_V(6); PG8_BAR;
    } else {
        PG8_STAGE(PG8_SB(0, 0), cB, voffB); PG8_STAGE(PG8_SA(0, 0), cA, voffA); PG8_STAGE(PG8_SB(0, 1), cB + hstep, voffB); PG8_STAGE(PG8_SA(0, 1), cA + hstep, voffA);
        if (wr == 1) PG8_BAR;
        PG8_WAIT_V(4); PG8_BAR;
        PG8_STAGE(PG8_SB(1, 0), cB + kstep, voffB); PG8_STAGE(PG8_SA(1, 0), cA + kstep, voffA); PG8_STAGE(PG8_SB(1, 1), cB + hstep + kstep, voffB);
        PG8_WAIT_V(6); PG8_BAR;
    }
    for (;;) {
        const bool has_next = S.next(ui + 1, nxt);
        const char* nA = has_next ? (const char*)g.A + (size_t)nxt.pm * tstep : cA; const char* nB = has_next ? (const char*)g.Bt + (size_t)nxt.pn * tstep : cB;
        for (int t = 0; t < nt; t += 2) {
            const bool last = (t == nt - 2);
            const char* a1 = cA + (size_t)(t + 1) * kstep;
            const char* a2 = last ? nA : cA + (size_t)(t + 2) * kstep; const char* b2 = last ? nB : cB + (size_t)(t + 2) * kstep;
            const char* a3 = a2 + kstep; const char* b3 = b2 + kstep;
            if (last && has_next) S.a_ready(nxt);
            if constexpr (SP2) {
            PG8_LDB(B0, 0, 0); PG8_LDB(B1, 0, 1); PG8_SCHED; PG8_LDA(At, 0, 0); PG8_STAGE(PG8_SA(1, 1), a1 + hstep, voffA);
            PG8_WAIT_V(8); PG8_WAIT_L(0); PG8_BAR; PG8_MMA(0, 0, At, B0); PG8_MMA(0, 1, At, B1); PG8_BAR; PG8_SCHED;
            PG8_LDA(At, 0, 1); PG8_STAGE(PG8_SB(0, 0), b2, voffB); PG8_STAGE(PG8_SB(0, 1), b2 + hstep, voffB); PG8_STAGE(PG8_SA(0, 0), a2, voffA);
            PG8_WAIT_V(8); PG8_WAIT_L(0); PG8_BAR; PG8_MMA(1, 0, At, B0); PG8_MMA(1, 1, At, B1); PG8_BAR; PG8_SCHED;
            PG8_LDB(B0, 1, 0); PG8_LDB(B1, 1, 1); PG8_SCHED; PG8_LDA(At, 1, 0); PG8_STAGE(PG8_SA(0, 1), a2 + hstep, voffA);
            PG8_WAIT_V(8); PG8_WAIT_L(0); PG8_BAR; PG8_MMA(0, 0, At, B0); PG8_MMA(0, 1, At, B1); PG8_BAR; PG8_SCHED;
            PG8_LDA(At, 1, 1); PG8_STAGE(PG8_SB(1, 0), b3, voffB); PG8_STAGE(PG8_SB(1, 1), b3 + hstep, voffB); PG8_STAGE(PG8_SA(1, 0), a3, voffA);
            PG8_WAIT_V(8); PG8_WAIT_L(0); PG8_BAR; PG8_MMA(1, 0, At, B0); PG8_MMA(1, 1, At, B1); PG8_BAR; PG8_SCHED;
            } else {
            PG8_LDB(B0, 0, 0); PG8_SCHED; PG8_LDA(At, 0, 0); PG8_STAGE(PG8_SA(1, 1), a1 + hstep, voffA);
            PG8_WAIT_L(8); PG8_BAR; PG8_WAIT_L(0); PG8_MMA(0, 0, At, B0); PG8_BAR; PG8_SCHED;
            PG8_LDB(B1, 0, 1); PG8_STAGE(PG8_SB(0, 0), b2, voffB);
            PG8_BAR; PG8_WAIT_L(0); PG8_MMA(0, 1, At, B1); PG8_BAR;
            PG8_LDA(At, 0, 1); PG8_STAGE(PG8_SA(0, 0), a2, voffA);
            PG8_BAR; PG8_WAIT_L(0); PG8_MMA(1, 0, At, B0); PG8_BAR; PG8_SCHED;
            PG8_STAGE(PG8_SB(0, 1), b2 + hstep, voffB);
            PG8_WAIT_V(6); PG8_BAR; PG8_MMA(1, 1, At, B1); PG8_BAR;
            PG8_LDB(B0, 1, 0); PG8_SCHED; PG8_LDA(At, 1, 0); PG8_STAGE(PG8_SA(0, 1), a2 + hstep, voffA);
            PG8_WAIT_L(8); PG8_BAR; PG8_WAIT_L(0); PG8_MMA(0, 0, At, B0); PG8_BAR; PG8_SCHED;
            PG8_LDB(B1, 1, 1); PG8_STAGE(PG8_SB(1, 0), b3, voffB);
            PG8_BAR; PG8_WAIT_L(0); PG8_MMA(0, 1, At, B1); PG8_BAR;
            PG8_LDA(At, 1, 1); PG8_STAGE(PG8_SA(1, 0), a3, voffA);
            PG8_BAR; PG8_WAIT_L(0); PG8_MMA(1, 0, At, B0); PG8_BAR; PG8_SCHED;
            PG8_STAGE(PG8_SB(1, 1), b3 + hstep, voffB);
            PG8_WAIT_V(6); PG8_BAR; PG8_MMA(1, 1, At, B1); PG8_BAR;
            }
        }
        if constexpr (ALIGN_EPI) { if (wr == 0) PG8_BAR; }
        if constexpr (!Epi::AFTER_DRAIN) { E(acc, cur, wr, wc, fr, fq); S.done(cur); }
        if (!has_next) break;
#pragma unroll
        for (int a = 0; a < 2; ++a)
#pragma unroll
            for (int b = 0; b < 2; ++b)
#pragma unroll
                for (int m = 0; m < 4; ++m)
#pragma unroll
                    for (int n = 0; n < 2; ++n) acc[a][b][m][n] = (f32x4){0.f, 0.f, 0.f, 0.f};
        cur = nxt; cA = nA; cB = nB; ++ui;
        if constexpr (ALIGN_EPI) { if (wr == 1) PG8_BAR; }
    }
    PG8_WAIT_V(0);
    if constexpr (!ALIGN_EPI) { if (wr == 0) PG8_BAR; }
    PG8_BAR;
    if constexpr (Epi::AFTER_DRAIN) { E.fused(acc, cur, wr, wc, fr, fq, lds, wid, lane); S.done(cur); }
#undef PG8_SA
#undef PG8_SB
#undef PG8_STAGE
#undef PG8_LDA
#undef PG8_LDB
#undef PG8_MMA
#undef PG8_WAIT_V
#undef PG8_WAIT_L
#undef PG8_BAR
#undef PG8_SCHED
}
}

__device__ __forceinline__ void phase_gemm_in(const Params& p, char* lds) {
    pg8::Gemm g{(const pg8::bf16_t*)(p.ws + WS_X), (const pg8::bf16_t*)(p.ws + WS_WTIN), MPAD, NPAD, D};
    pg8::StaticOrder So; So.init(MPAD, NPAD, (int)gridDim.x, (int)blockIdx.x);
    pg8::EpiProj E{p.ws, p.idx_g, p.idx_b};
    pg8::gemm_phase<pg8::EpiProj, pg8::StaticOrder, true, true>((PG8_LAS unsigned char*)lds, g, So, E);
}
__device__ __forceinline__ void phase_gemm_out(const Params& p, char* lds) {
    pg8::Gemm g{(const pg8::bf16_t*)(p.ws + WS_MIX), (const pg8::bf16_t*)(p.ws + WS_WTOUT), MREAL, D, D};
    pg8::StaticOrder So; So.init(MREAL, D, (int)gridDim.x, (int)blockIdx.x);
    pg8::EpiOut E{p.x, p.out};
    pg8::gemm_phase<pg8::EpiOut, pg8::StaticOrder, true, true>((PG8_LAS unsigned char*)lds, g, So, E);
}

constexpr int NMI = 130;
constexpr int QB = 32, CAP = 128;
constexpr int IX_KB = 0, IX_HIST = 32768, IX_MASK = 32768  , IX_CAND = 98304, IX_CANDI = 114688, IX_ST = 131072, IX_FLAG = 132096;
constexpr int HROW = 512;
typedef float f32x16 __attribute__((ext_vector_type(16)));
#define ST_LO 0
#define ST_HI 1
#define ST_NEED 2
#define ST_CNT 3
#define ST_FLAGS 4
#define ST_NCAND 5
#define ST_SH 6
#define ST_RUN 7
#define FL_ACTIVE 1u
#define FL_TIE 2u

__device__ __forceinline__ float relu_(float x) { return __builtin_amdgcn_fmed3f(x, 0.f, __builtin_inff()); }
__device__ __forceinline__ unsigned skey_c(float x) { const unsigned u = __float_as_uint(x); return u ^ (((unsigned)((int)u >> 31)) | 0x80000000u); }
__device__ __forceinline__ int custom_bin(unsigned key) {
    const int k14 = (int)(key >> 18); const int a = k14 - 11488, bb = k14 - 3873;
    const int lowpart = min(max(bb, 0), 511);
    return max(min(a, 1023), lowpart);
}

__device__ __forceinline__ void glds16(const void* gsrc, unsigned lds_dst) { unsigned keep;
    asm volatile("s_mov_b32 %0, m0\n\ts_mov_b32 m0, %2\n\ts_nop 0\n\tglobal_load_lds_dwordx4 %1, off\n\ts_mov_b32 m0, %0" : "=&s"(keep) : "v"(gsrc), "s"(lds_dst) : "memory"); }

struct IdxLane { unsigned loA, hiA, loB, hiB, flA, flB, shA, shB, needA, needB, runA, runB; int qA, qB, rA, rB; bool anyTie; };

template <int MODE, bool DIAG>
__device__ __forceinline__ void idx_tile(char* lds, const char* kb, int t, const h16x8 (&afrag)[4], const float (&wreg)[16], IdxLane& L) {
    unsigned* HIST = (unsigned*)(lds + IX_HIST); unsigned* MASK = (unsigned*)(lds + IX_MASK); unsigned* CAND = (unsigned*)(lds + IX_CAND); unsigned* CANDI = (unsigned*)(lds + IX_CANDI); unsigned* ST = (unsigned*)(lds + IX_ST);
    const int lane = threadIdx.x & 63, w = threadIdx.x >> 6, hl = lane >> 5, cc = lane & 31;
    h16x8 bf[2][4];
#pragma unroll
    for (int kh = 0; kh < 2; ++kh)
#pragma unroll
        for (int ks = 0; ks < 4; ++ks) { const int ki = 32 * kh + cc; bf[kh][ks] = *(const h16x8*)(kb + ki * 128 + (((2 * ks + hl) ^ ((ki >> 1) & 7)) << 4)); }
    f32x16 accs[2];
    accs[0] = (f32x16){0.f, 0.f, 0.f, 0.f, 0.f, 0.f, 0.f, 0.f, 0.f, 0.f, 0.f, 0.f, 0.f, 0.f, 0.f, 0.f}; accs[1] = accs[0];
#pragma unroll
    for (int ks = 0; ks < 4; ++ks) { accs[0] = __builtin_amdgcn_mfma_f32_32x32x16_f16(afrag[ks], bf[0][ks], accs[0], 0, 0, 0); accs[1] = __builtin_amdgcn_mfma_f32_32x32x16_f16(afrag[ks], bf[1][ks], accs[1], 0, 0, 0); }
#pragma unroll
    for (int kh = 0; kh < 2; ++kh) {
        const f32x16 acc = accs[kh];
        float pq[4];
#pragma unroll
        for (int q4 = 0; q4 < 4; ++q4)
            pq[q4] = __builtin_fmaf(wreg[4 * q4 + 3], relu_(acc[4 * q4 + 3]), __builtin_fmaf(wreg[4 * q4 + 2], relu_(acc[4 * q4 + 2]), __builtin_fmaf(wreg[4 * q4 + 1], relu_(acc[4 * q4 + 1]), __builtin_fmaf(wreg[4 * q4], relu_(acc[4 * q4]), 0.f))));
        const auto r01 = __builtin_amdgcn_permlane32_swap(__float_as_uint(pq[0]), __float_as_uint(pq[1]), false, false);
        const auto r23 = __builtin_amdgcn_permlane32_swap(__float_as_uint(pq[2]), __float_as_uint(pq[3]), false, false);
        const float sA = __uint_as_float(r01[0]) + __uint_as_float(r01[1]);
        const float sB = __uint_as_float(r23[0]) + __uint_as_float(r23[1]);
        const int sidx = 64 * t + 32 * kh + cc;
        const bool vA = DIAG ? (sidx <= L.rA) : true, vB = DIAG ? (sidx <= L.rB) : true;
        const unsigned kA = skey_c(sA), kB = skey_c(sB);
        if (MODE == 0) {
            const int bA = custom_bin(kA), bB = custom_bin(kB);
            if (vA) atomicAdd(&HIST[L.qA * HROW + (bA >> 1)], 1u << (16 * (bA & 1)));
            if (vB) atomicAdd(&HIST[L.qB * HROW + (bB >> 1)], 1u << (16 * (bB & 1)));
        } else if (MODE == 1) {
            if (vA && (L.flA & FL_ACTIVE) && (kA - L.loA) <= (L.hiA - L.loA)) { const unsigned sb = (kA - L.loA) >> L.shA; atomicAdd(&HIST[L.qA * HROW + (sb >> 1)], 1u << (16 * (sb & 1))); }
            if (vB && (L.flB & FL_ACTIVE) && (kB - L.loB) <= (L.hiB - L.loB)) { const unsigned sb = (kB - L.loB) >> L.shB; atomicAdd(&HIST[L.qB * HROW + (sb >> 1)], 1u << (16 * (sb & 1))); }
        } else {
            bool selA = vA && kA > L.hiA, selB = vB && kB > L.hiB;
            const bool inA = vA && (kA - L.loA) <= (L.hiA - L.loA), inB = vB && (kB - L.loB) <= (L.hiB - L.loB);
            if (L.anyTie) {
                const unsigned long long eA = __ballot(inA && (L.flA & FL_TIE)), eB = __ballot(inB && (L.flB & FL_TIE));
                const unsigned pA = hl ? (unsigned)(eA >> 32) : (unsigned)eA, pB = hl ? (unsigned)(eB >> 32) : (unsigned)eB;
                const unsigned below = (1u << cc) - 1u;
                if (inA && (L.flA & FL_TIE) && L.runA + __popc(pA & below) < L.needA) selA = true;
                if (inB && (L.flB & FL_TIE) && L.runB + __popc(pB & below) < L.needB) selB = true;
                L.runA += __popc(pA); L.runB += __popc(pB);
            }
            if (inA && !(L.flA & FL_TIE)) { const unsigned pos = atomicAdd(&ST[L.qA * 8 + ST_NCAND], 1u); if (pos < CAP) { CAND[L.qA * CAP + pos] = kA; CANDI[L.qA * CAP + pos] = (unsigned)sidx; } }
            if (inB && !(L.flB & FL_TIE)) { const unsigned pos = atomicAdd(&ST[L.qB * 8 + ST_NCAND], 1u); if (pos < CAP) { CAND[L.qB * CAP + pos] = kB; CANDI[L.qB * CAP + pos] = (unsigned)sidx; } }
            const unsigned long long mA = __ballot(selA), mB = __ballot(selB);
            const unsigned val = lane == 0 ? (unsigned)mA : (lane == 1 ? (unsigned)(mA >> 32) : (lane == 2 ? (unsigned)mB : (unsigned)(mB >> 32)));
            if (lane < 4) MASK[(4 * w + lane) * 260 + (t + 1) * 2 + kh] = val;
        }
    }
}

template <int MODE>
__device__ __forceinline__ void idx_pass(const Params& p, int b, int u, char* lds, const h16x8 (&afrag)[4], const float (&wreg)[16]) {
    const h16* KI = (const h16*)(p.ws + WS_KI) + (size_t)b * S * 64;
    unsigned* ST = (unsigned*)(lds + IX_ST);
    const int tid = threadIdx.x, lane = tid & 63, hl = lane >> 5; const int w = __builtin_amdgcn_readfirstlane(tid >> 6);
    const int tq = u >> 1;
    IdxLane L{};
    L.qA = 4 * w + hl; L.qB = 4 * w + 2 + hl; L.rA = 32 * u + L.qA; L.rB = 32 * u + L.qB;
    if (MODE != 0) { L.loA = ST[L.qA * 8 + ST_LO]; L.hiA = ST[L.qA * 8 + ST_HI]; L.flA = ST[L.qA * 8 + ST_FLAGS]; L.shA = ST[L.qA * 8 + ST_SH]; L.needA = ST[L.qA * 8 + ST_NEED];
                     L.loB = ST[L.qB * 8 + ST_LO]; L.hiB = ST[L.qB * 8 + ST_HI]; L.flB = ST[L.qB * 8 + ST_FLAGS]; L.shB = ST[L.qB * 8 + ST_SH]; L.needB = ST[L.qB * 8 + ST_NEED]; }
    L.anyTie = (MODE == 2) && (__ballot((L.flA | L.flB) & FL_TIE) != 0ull);
    const int si = 8 * w + (lane >> 3);
    const h16* ksrc = KI + (size_t)si * 64 + (((lane & 7) ^ ((si >> 1) & 7)) << 3);
    const unsigned lds0 = (unsigned)(uintptr_t)lds + IX_KB + (unsigned)w * 1024u;
#define IDX_DMA(tt) glds16(ksrc + (size_t)(tt) * 64 * 64, (unsigned)__builtin_amdgcn_readfirstlane(lds0 + (unsigned)((tt) & 3) * 8192u))
#define IDX_WAIT(N) asm volatile("s_waitcnt vmcnt(" #N ") lgkmcnt(0)\n\ts_barrier" ::: "memory")
    IDX_DMA(0); if (tq >= 1) IDX_DMA(1);
    IDX_WAIT(0);
    for (int t = 0; t + 1 < tq; t += 2) {
        IDX_DMA(t + 2); if (t + 3 <= tq) IDX_DMA(t + 3);
        idx_tile<MODE, false>(lds, lds + IX_KB + (t & 3) * 8192, t, afrag, wreg, L);
        idx_tile<MODE, false>(lds, lds + IX_KB + ((t + 1) & 3) * 8192, t + 1, afrag, wreg, L);
        IDX_WAIT(0);
    }
    if (tq & 1) {
        idx_tile<MODE, false>(lds, lds + IX_KB + ((tq - 1) & 3) * 8192, tq - 1, afrag, wreg, L);
        idx_tile<MODE, true>(lds, lds + IX_KB + (tq & 3) * 8192, tq, afrag, wreg, L);
    } else {
        idx_tile<MODE, true>(lds, lds + IX_KB + (tq & 3) * 8192, tq, afrag, wreg, L);
    }
    IDX_WAIT(0);
#undef IDX_DMA
#undef IDX_WAIT
}

template <int MODE>
__device__ __forceinline__ void idx_scan(char* lds) {
    unsigned* HIST = (unsigned*)(lds + IX_HIST); unsigned* ST = (unsigned*)(lds + IX_ST); unsigned* FLAG = (unsigned*)(lds + IX_FLAG);
    const int lane = threadIdx.x & 63, w = threadIdx.x >> 6;
    for (int q4 = 0; q4 < 4; ++q4) {
        const int q = 4 * w + q4;
        const unsigned fl = ST[q * 8 + ST_FLAGS];
        if (MODE == 1 && !(fl & FL_ACTIVE)) continue;
        const unsigned need = ST[q * 8 + ST_NEED], lo = ST[q * 8 + ST_LO], hi = ST[q * 8 + ST_HI], sh = ST[q * 8 + ST_SH];
        unsigned c[16];
#pragma unroll
        for (int j = 0; j < 8; ++j) { const unsigned d = HIST[q * HROW + 8 * lane + j]; c[2 * j] = d & 0xFFFFu; c[2 * j + 1] = d >> 16; HIST[q * HROW + 8 * lane + j] = 0u; }
        unsigned tl = 0;
#pragma unroll
        for (int k = 0; k < 16; ++k) tl += c[k];
        unsigned Ssum = tl;
#pragma unroll
        for (int o = 1; o < 64; o <<= 1) { const unsigned v = __shfl_down(Ssum, o); if (lane + o < 64) Ssum += v; }
        const unsigned above = Ssum - tl;
        if (above < need && need <= Ssum) {
            unsigned cum = above; int bstar = 16 * lane; unsigned cnt = 0; bool found = false;
#pragma unroll
            for (int k = 15; k >= 0; --k) { if (!found) { if (cum + c[k] >= need) { bstar = 16 * lane + k; cnt = c[k]; found = true; } else cum += c[k]; } }
            const unsigned nneed = need - cum;
            unsigned nlo, nhi;
            if (MODE == 0) {
                if (bstar >= 512) { nlo = (unsigned)(bstar + 11488) << 18; nhi = bstar == 1023 ? 0xFFFFFFFFu : (nlo | 0x3FFFFu); }
                else if (bstar == 511) { nlo = 4384u << 18; nhi = (11999u << 18) | 0x3FFFFu; }
                else { nhi = ((unsigned)(bstar + 3873) << 18) | 0x3FFFFu; nlo = bstar == 0 ? 0u : ((unsigned)(bstar + 3873) << 18); }
            } else {
                nlo = lo + ((unsigned)bstar << sh); const unsigned top = nlo + ((1u << sh) - 1u); nhi = top < hi ? top : hi; if (top < nlo) nhi = hi;
            }
            const unsigned range = nhi - nlo;
            unsigned nfl = 0, nsh = 0;
            if (nlo < nhi && cnt > CAP) { nfl = FL_ACTIVE; const int bits = 32 - __clz(range); nsh = bits > 10 ? (unsigned)(bits - 10) : 0u; *FLAG = 1u; }
            else if (cnt > CAP) nfl = FL_TIE;
            ST[q * 8 + ST_LO] = nlo; ST[q * 8 + ST_HI] = nhi; ST[q * 8 + ST_NEED] = nneed; ST[q * 8 + ST_CNT] = cnt; ST[q * 8 + ST_FLAGS] = nfl; ST[q * 8 + ST_SH] = nsh;
        }
    }
}

__device__ __forceinline__ void idx_unit(const Params& p, int b, int u, char* lds, int dry = 0) {
    const h16* P = (const h16*)(p.ws + WS_P); const float* W8 = (const float*)(p.ws + WS_W8);
    unsigned long long* Mk = (unsigned long long*)p.out + (dry ? (size_t)(36u << 20) / 8 : 0);
    unsigned* HIST = (unsigned*)(lds + IX_HIST); unsigned* MASK = (unsigned*)(lds + IX_MASK); unsigned* CAND = (unsigned*)(lds + IX_CAND); unsigned* ST = (unsigned*)(lds + IX_ST); unsigned* FLAG = (unsigned*)(lds + IX_FLAG);
    const int tid = threadIdx.x, lane = tid & 63, w = tid >> 6, hl = lane >> 5, cc = lane & 31;
    const int qb = u >> 3, nwords = 4 * qb + 6;
    if (32 * u + 31 < 256) {
        for (int idx = tid; idx < 32 * nwords; idx += NT) {
            const int q = idx & 31, i = idx >> 5, r = 32 * u + q;
            unsigned long long wv;
            if (i == 0) wv = 0xFFFFull; else { const int nv = r - 64 * (i - 1) + 1; wv = nv <= 0 ? 0ull : (nv >= 64 ? ~0ull : ((1ull << nv) - 1ull)); }
            Mk[((size_t)b * NMI + i) * S + r] = wv;
        }
        return;
    }
    for (int i = tid; i < 32 * HROW; i += NT) HIST[i] = 0u;
    if (tid < 32) { ST[tid * 8 + ST_LO] = 0u; ST[tid * 8 + ST_HI] = 0xFFFFFFFFu; ST[tid * 8 + ST_NEED] = 256u; ST[tid * 8 + ST_CNT] = 0u; ST[tid * 8 + ST_FLAGS] = 0u; ST[tid * 8 + ST_NCAND] = 0u; ST[tid * 8 + ST_SH] = 0u; ST[tid * 8 + ST_RUN] = 0u; }
    if (tid == 0) *FLAG = 0u;
    h16x8 afrag[4]; float wreg[16];
    {
        const int qq = cc >> 3, head = cc & 7;
        const size_t row = (size_t)b * S + 32 * u + 4 * w + qq;
#pragma unroll
        for (int ks = 0; ks < 4; ++ks) afrag[ks] = *(const h16x8*)(P + row * NP2 + C_IQ + head * 64 + 16 * ks + 8 * hl);
#pragma unroll
        for (int q4 = 0; q4 < 4; ++q4) { const f32x4 wv = *(const f32x4*)(W8 + ((size_t)b * S + 32 * u + 4 * w + q4) * 8 + 4 * hl); wreg[4 * q4] = wv.x; wreg[4 * q4 + 1] = wv.y; wreg[4 * q4 + 2] = wv.z; wreg[4 * q4 + 3] = wv.w; }
    }
#pragma unroll
    for (int ks = 0; ks < 4; ++ks) asm volatile("" : "+v"(afrag[ks]));
#pragma unroll
    for (int i = 0; i < 16; ++i) asm volatile("" : "+v"(wreg[i]));
    __syncthreads();
#if PROBE == 9
    idx_pass<0>(p, b, u, lds, afrag, wreg);
    for (int i = tid; i < 32 * HROW; i += NT) HIST[i] = 0u;
    __syncthreads();
#endif
    if (!dry) idx_pass<0>(p, b, u, lds, afrag, wreg);
    idx_scan<0>(lds);
    __syncthreads();
    for (int iter = 0; iter < 8; ++iter) {
        if (*FLAG == 0u || PROBE == 14) break;
        __syncthreads();
        if (tid == 0) *FLAG = 0u;
        __syncthreads();
        if (!dry) idx_pass<1>(p, b, u, lds, afrag, wreg);
        idx_scan<1>(lds);
        __syncthreads();
    }
    for (int i = tid; i < 32 * 260; i += NT) MASK[i] = 0u;
    __syncthreads();
    if (!dry) idx_pass<2>(p, b, u, lds, afrag, wreg);
#if PROBE == 8
    if (tid < 32) ST[tid * 8 + ST_NCAND] = 0u;
    __syncthreads();
    idx_pass<2>(p, b, u, lds, afrag, wreg);
#endif
    for (int rrep = 0; rrep < (PROBE == 13 ? 2 : 1); ++rrep)
    for (int q4 = 0; q4 < 4; ++q4) {
        const int q = 4 * w + q4;
        const unsigned fl = ST[q * 8 + ST_FLAGS]; if (fl & FL_TIE) continue;
        unsigned nc = ST[q * 8 + ST_NCAND]; if (nc > CAP) nc = CAP;
        const unsigned need = ST[q * 8 + ST_NEED], lo = ST[q * 8 + ST_LO];
        (void)lo;
        const unsigned* CANDI = (const unsigned*)(lds + IX_CANDI);
        const unsigned k0 = lane < nc ? CAND[q * CAP + lane] : 0u, k1 = lane + 64 < nc ? CAND[q * CAP + lane + 64] : 0u;
        const unsigned i0 = lane < nc ? CANDI[q * CAP + lane] : 0u, i1 = lane + 64 < nc ? CANDI[q * CAP + lane + 64] : 0u;
        unsigned r0 = 0, r1 = 0;
        for (unsigned j = 0; j < nc; ++j) { const unsigned kj = CAND[q * CAP + j], ij = CANDI[q * CAP + j];
            r0 += (kj > k0 || (kj == k0 && ij < i0)) ? 1u : 0u; r1 += (kj > k1 || (kj == k1 && ij < i1)) ? 1u : 0u; }
        if (lane < nc && r0 < need) { const int s = (int)i0; atomicOr(&MASK[q * 260 + ((s >> 6) + 1) * 2 + ((s >> 5) & 1)], 1u << (s & 31)); }
        if (lane + 64 < nc && r1 < need) { const int s = (int)i1; atomicOr(&MASK[q * 260 + ((s >> 6) + 1) * 2 + ((s >> 5) & 1)], 1u << (s & 31)); }
    }
    __syncthreads();
    for (int idx = tid; idx < 32 * nwords; idx += NT) {
        const int q = idx & 31, i = idx >> 5, r = 32 * u + q;
        const unsigned long long wv = i == 0 ? 0xFFFFull : ((unsigned long long)MASK[q * 260 + 2 * i] | ((unsigned long long)MASK[q * 260 + 2 * i + 1] << 32));
        Mk[((size_t)b * NMI + i) * S + r] = wv;
    }
    __syncthreads();
}

namespace attn_body {
using bf16=_Float16;
typedef _Float16 fh16x8 __attribute__((ext_vector_type(8)));
typedef unsigned u32x2 __attribute__((ext_vector_type(2)));
#define MFH(a,b,c,x,y,z) __builtin_amdgcn_mfma_f32_32x32x16_f16(__builtin_bit_cast(fh16x8,(a)),__builtin_bit_cast(fh16x8,(b)),(c),0,0,0)
using bf16x8=__attribute__((ext_vector_type(8)))short;
using s16x4=__attribute__((ext_vector_type(4)))short;
using f32x16=__attribute__((ext_vector_type(16)))float;
using u32x4=__attribute__((ext_vector_type(4)))unsigned;
constexpr int BATCH=2,NHEAD=8,SEQ=8192,D=64,DM=NHEAD*D,KVROWS=8320,NMI_=130;
constexpr int NW=8,QBLK=32,QB=QBLK*NW,KVBLK=64,NQB=SEQ/QB;
constexpr int ATTN_PITCH=DM, ATTN_UNIT_ROWS=QB;
__device__ __forceinline__ int crow(int r,int hi){return (r&3)+8*(r>>2)+4*hi;}
#define SBAR() __builtin_amdgcn_sched_barrier(0)
__device__ __forceinline__ float msel(int m,int pos,float keepv){ const int t=__builtin_amdgcn_sbfe(m,pos,1); float d; asm("v_bfi_b32 %0, %1, %2, %3":"=v"(d):"v"(t),"v"(keepv),"s"(0xFF800000u)); return d; }
__device__ __forceinline__ void cinit(f32x16&p0,f32x16&p1,const u32x2&m,int hi,float nmh){
  const int m0=(int)(m[0]>>(4*hi)), m1=(int)(m[1]>>(4*hi));
  #pragma unroll
  for(int r=0;r<16;++r){ const int pos=(r&3)+8*(r>>2); p0[r]=msel(m0,pos,nmh); p1[r]=msel(m1,pos,nmh); }
  asm volatile("s_nop 1":"+v"(p0),"+v"(p1));
}
__device__ __forceinline__ void mload(u32x2&m,const unsigned long long*p){ asm volatile("global_load_dwordx2 %0, %1, off":"=v"(m):"v"(p):"memory"); }
constexpr int NSLOT=3, SLOTB=8192;
constexpr int LDS_K=0, LDS_V=NSLOT*SLOTB, LDS_WS=2*NSLOT*SLOTB, LDS_OST=LDS_WS+NW*64*4, LDS_BYTES=LDS_OST+NW*4096;
constexpr float C2=0.125f*1.4426950408889634f;
__device__ __forceinline__ void glds16(const void*gsrc,unsigned lds_dst){unsigned keep;
  asm volatile("s_mov_b32 %0, m0\n\ts_mov_b32 m0, %2\n\ts_nop 0\n\tglobal_load_lds_dwordx4 %1, off\n\ts_mov_b32 m0, %0":"=&s"(keep):"v"(gsrc),"s"(lds_dst):"memory");}
__device__ __forceinline__ float max3f(float a,float b,float c){float r;asm("v_max3_f32 %0, %1, %2, %3":"=v"(r):"v"(a),"v"(b),"v"(c));return r;}
__device__ __forceinline__ float max2f(float a,float b){float r;asm("v_max_f32_e32 %0, %1, %2":"=v"(r):"v"(a),"v"(b));return r;}
__device__ __forceinline__ float fadd_s(float a,float b){float r;asm("v_add_f32_e32 %0, %1, %2":"=v"(r):"v"(a),"v"(b));return r;}
__device__ __forceinline__ float fsub_s(float a,float b){float r;asm("v_sub_f32_e32 %0, %1, %2":"=v"(r):"v"(a),"v"(b));return r;}
typedef float f32x2_t __attribute__((ext_vector_type(2))); typedef _Float16 bf16x2_t __attribute__((ext_vector_type(2)));
__device__ __forceinline__ unsigned cvtpk_s(float lo,float hi){f32x2_t v={lo,hi};bf16x2_t b=__builtin_convertvector(v,bf16x2_t);return __builtin_bit_cast(unsigned,b);}
#define WAIT_BAR(N) asm volatile("s_waitcnt vmcnt(" #N ") lgkmcnt(0)\n\ts_barrier":::"memory")
#define WAIT_BAR_M(N,M) do{ asm volatile("s_waitcnt vmcnt(" #N ") lgkmcnt(0)\n\ts_barrier":::"memory"); __builtin_amdgcn_sched_barrier(0); asm volatile("":"+v"(M)); }while(0)
#define WAIT_BAR_M2(N,M,M2) do{ asm volatile("s_waitcnt vmcnt(" #N ") lgkmcnt(0)\n\ts_barrier":::"memory"); __builtin_amdgcn_sched_barrier(0); asm volatile("":"+v"(M),"+v"(M2)); }while(0)

__device__ __forceinline__ void qkt(f32x16&p0,f32x16&p1,const char*Kslot,const bf16x8*qr,int r32,int hi){
  const char*kb=Kslot+hi*1024+r32*16;
  #pragma unroll
  for(int d0=0;d0<4;++d0){
    const bf16x8 b0=*reinterpret_cast<const bf16x8*>(kb+d0*2048);
    const bf16x8 b1=*reinterpret_cast<const bf16x8*>(kb+d0*2048+512);
    p0=MFH(b0,qr[d0],p0,0,0,0);p1=MFH(b1,qr[d0],p1,0,0,0);}
}
typedef __attribute__((address_space(3))) const char* lds_cptr;
typedef short v4i16_t __attribute__((ext_vector_type(4)));
__device__ __forceinline__ void kload8(bf16x8*kf,lds_cptr kp){
  kf[0]=*(const __attribute__((address_space(3))) bf16x8*)(kp);      kf[1]=*(const __attribute__((address_space(3))) bf16x8*)(kp+512);
  kf[2]=*(const __attribute__((address_space(3))) bf16x8*)(kp+2048); kf[3]=*(const __attribute__((address_space(3))) bf16x8*)(kp+2560);
  kf[4]=*(const __attribute__((address_space(3))) bf16x8*)(kp+4096); kf[5]=*(const __attribute__((address_space(3))) bf16x8*)(kp+4608);
  kf[6]=*(const __attribute__((address_space(3))) bf16x8*)(kp+6144); kf[7]=*(const __attribute__((address_space(3))) bf16x8*)(kp+6656);
}
__device__ __forceinline__ void kload2(bf16x8*kf,lds_cptr kp,int j){ kf[2*j]=*(const __attribute__((address_space(3))) bf16x8*)(kp+j*2048); kf[2*j+1]=*(const __attribute__((address_space(3))) bf16x8*)(kp+j*2048+512); }
__device__ __forceinline__ s16x4 vtr(lds_cptr p){ return __builtin_bit_cast(s16x4,__builtin_amdgcn_ds_read_tr16_b64_v4i16((__attribute__((address_space(3))) v4i16_t*)p)); }
__device__ __forceinline__ float rowmax(const f32x16&p0,const f32x16&p1){
  float a=max3f(p0[0],p0[1],p1[0]),b=max3f(p0[2],p0[3],p1[1]);a=max3f(a,p1[2],p1[3]);
  #pragma unroll
  for(int r=4;r<16;r+=4){a=max3f(a,p0[r],p0[r+1]);b=max3f(b,p0[r+2],p0[r+3]);a=max3f(a,p1[r],p1[r+1]);b=max3f(b,p1[r+2],p1[r+3]);}
  const float m=max2f(a,b);
  auto rr=__builtin_amdgcn_permlane32_swap(__float_as_uint(m),__float_as_uint(m),false,false);
  return max2f(__uint_as_float(rr[0]),__uint_as_float(rr[1]));
}
__device__ __forceinline__ void pv(f32x16*o,int vb,bf16x8 pa0,bf16x8 pa1,bf16x8 pa2,bf16x8 pa3){
  #pragma unroll
  for(int d0=0;d0<2;++d0){s16x4 lo[4],hi[4];
    #pragma unroll
    for(int ks=0;ks<4;++ks){
      asm volatile("ds_read_b64_tr_b16 %0,%1 offset:%c2":"=&v"(lo[ks]):"v"(vb),"i"(d0*4096+ks*1024):"memory");
      asm volatile("ds_read_b64_tr_b16 %0,%1 offset:%c2":"=&v"(hi[ks]):"v"(vb),"i"(d0*4096+ks*1024+512):"memory");}
    asm volatile("s_waitcnt lgkmcnt(0)":::"memory");SBAR();
    #define PK(k) (bf16x8){lo[k][0],lo[k][1],lo[k][2],lo[k][3],hi[k][0],hi[k][1],hi[k][2],hi[k][3]}
    o[d0]=MFH(pa0,PK(0),o[d0],0,0,0);
    o[d0]=MFH(pa1,PK(1),o[d0],0,0,0);
    o[d0]=MFH(pa2,PK(2),o[d0],0,0,0);
    o[d0]=MFH(pa3,PK(3),o[d0],0,0,0);
    #undef PK
  }
}

#ifndef ATTN_STORE16
#define ATTN_STORE16(p,v) (*(u32x4*)(p)=(v))
#endif
template<int THRL> __device__ __forceinline__ void attn_unit(int b,int h,int qb,const bf16*Q,const bf16*__restrict__ K,const bf16*__restrict__ V,bf16*O,const unsigned long long*__restrict__ Mk,char*shm){
  const int tid=threadIdx.x,lane=tid&63,r32=lane&31,hi=lane>>5; const int wid=__builtin_amdgcn_readfirstlane(tid>>6);
  const long rowbase=(long)b*SEQ, kvbase=(long)b*KVROWS; const int q0=qb*QB;
  const bf16*Qw=Q+(rowbase+q0+wid*QBLK)*DM+h*D;
  const bf16*Kh=K+kvbase*DM+h*D,*Vh=V+kvbase*DM+h*D;
  const unsigned long long*mrow=Mk+(long)b*NMI_*SEQ+(q0+wid*QBLK+r32);
  u32x2 mA,mB; mload(mA,mrow); mload(mB,mrow+SEQ);
  const unsigned lds0=(unsigned)(uintptr_t)shm;
  float*wsf=(float*)(shm+LDS_WS)+wid*64;
  const bf16*ksrc=Kh+(long)lane*DM+wid*8;
  const bf16*vsrc=Vh+(long)(16*(wid&3)+(lane>>2))*DM+(wid>>2)*32+(lane&3)*8;
  const unsigned kdst=lds0+LDS_K+wid*1024, vdst=lds0+LDS_V+wid*1024;
  #define DMA_K(t,slot) glds16(ksrc+(long)(t)*KVBLK*DM,(unsigned)__builtin_amdgcn_readfirstlane(kdst+(slot)))
  #define DMA_V(t,slot) glds16(vsrc+(long)(t)*KVBLK*DM,(unsigned)__builtin_amdgcn_readfirstlane(vdst+(slot)))
  const int vb0=(int)(lds0+LDS_V)+((lane>>4)&1)*32+(lane&3)*8+(4*hi+((lane&15)>>2))*64;
  const char*Kbase=shm+LDS_K; bf16x8 kf[8];
  const lds_cptr shm3=(lds_cptr)shm; const lds_cptr kp0=shm3+LDS_K+hi*1024+r32*16; const lds_cptr vp0=shm3+LDS_V+((lane>>4)&1)*32+(lane&3)*8+(4*hi+((lane&15)>>2))*64;
  const int NT=(q0+QB)/KVBLK+2;
  DMA_K(0,0);DMA_V(0,0);DMA_K(1,SLOTB);
  bf16x8 qr[4];
  #pragma unroll
  for(int d0=0;d0<4;++d0)qr[d0]=*reinterpret_cast<const bf16x8*>(&Qw[(long)r32*DM+d0*16+hi*8]);
  float mhat=0.f,l_reg=0.f;f32x16 o[2];o[0]=f32x16{};o[1]=f32x16{};
  const int qrel=wid*QBLK+r32;
  bool resc=false;
  #define START(P0,P1) do{ const float rm=rowmax(P0,P1); resc=false; \
    { const float dl=rm; mhat=fadd_s(mhat,dl); \
      _Pragma("unroll") for(int r=0;r<16;++r){P0[r]=fsub_s(P0[r],dl);P1[r]=fsub_s(P1[r],dl);} \
      } \
    _Pragma("unroll") for(int r=0;r<16;++r)P0[r]=__builtin_amdgcn_exp2f(P0[r]); }while(0)
  #define RESC() do{ if(resc){ asm volatile("s_waitcnt lgkmcnt(0)":::"memory"); \
      _Pragma("unroll") for(int d_=0;d_<2;++d_) _Pragma("unroll") for(int r=0;r<16;++r)o[d_][r]*=wsf[crow(r,hi)]; } }while(0)
  f32x16 pA0,pA1,pB0,pB1;
  int sl_prev=0,sl_cur=0,sl_next=SLOTB;
  #define ROT() do{sl_prev=sl_cur;sl_cur=sl_next;sl_next=(sl_next==(NSLOT-1)*SLOTB)?0:sl_next+SLOTB;}while(0)
  DMA_K(2,2*SLOTB);
  WAIT_BAR_M2(3,mA,mB);
  cinit(pA0,pA1,mA,hi,0.f);qkt(pA0,pA1,Kbase,qr,r32,hi);asm volatile("s_nop 15\n\ts_nop 7":"+v"(pA0),"+v"(pA1));
  START(pA0,pA1);
  _Pragma("unroll") for(int r=0;r<16;++r)pA1[r]=__builtin_amdgcn_exp2f(pA1[r]);
  WAIT_BAR(0);
  DMA_K(3,0);DMA_V(1,SLOTB);
  ROT();
  kload8(kf,kp0+sl_cur);
  WAIT_BAR(2);
  s16x4 vlo[8],vhi[8]; u32x4 pw0,pw1,pw2,pw3;
  #define PKW(P,B) cvtpk_s(P[B],P[B+1])
  #define PAF(k) __builtin_bit_cast(bf16x8,pw##k)
  #define VFR(i) (bf16x8){vlo[i][0],vlo[i][1],vlo[i][2],vlo[i][3],vhi[i][0],vhi[i][1],vhi[i][2],vhi[i][3]}
  #define PIN(x) asm volatile("":"+v"(x))
  #define MX3(a,b,c) __builtin_fmaxf(__builtin_fmaxf((a),(b)),(c))
  #define GAPA(MF,A0,A1,A2,A3,W0,W1,PW) do{ MF; sacc+=A0; sacc+=A1; sacc+=A2; sacc+=A3; PIN(sacc); W0; W1; PIN(PW); SBAR(); }while(0)
  #define EX(v) __builtin_amdgcn_exp2f(v)
  #define GAPB(MF,X,B) do{ MF; X[B]=EX(X[B]); X[B+1]=EX(X[B+1]); X[B+2]=EX(X[B+2]); X[B+3]=EX(X[B+3]); PIN(X); SBAR(); }while(0)
  #define VRD(i) do{ vlo[i]=vtr(vp_+(((i)>>2)*4096+((i)&3)*1024)); vhi[i]=vtr(vp_+(((i)>>2)*4096+((i)&3)*1024+512)); }while(0)
  #define KRD(G,j) do{ if(G){ kload2(kf,kp0+sl_next,j); SBAR(); } }while(0)
  #define STEP(C0,C1,P0,P1,t,GK,GV,GL,MC,MN,GM) do{ SBAR(); \
    if(GM){mload(MN,mrow+(long)((t)+1)*SEQ);} \
    cinit(C0,C1,MC,hi,-mhat); SBAR(); \
    const lds_cptr vp_=vp0+sl_prev; \
    VRD(0); SBAR(); float sacc=(P0[0]+P0[1]); \
    GAPA(C0=MFH(kf[0],qr[0],C0,0,0,0), P0[2],P0[3],P0[4],P0[5],     pw0[0]=PKW(P0,0), pw0[1]=PKW(P0,2), pw0); \
    VRD(4); SBAR(); GAPA(C1=MFH(kf[1],qr[0],C1,0,0,0), P0[6],P0[7],P0[8],P0[9],     pw0[2]=PKW(P0,4), pw0[3]=PKW(P0,6), pw0); \
    VRD(1); SBAR(); GAPA(C0=MFH(kf[2],qr[1],C0,0,0,0),   P0[10],P0[11],P0[12],P0[13], pw1[0]=PKW(P0,8), pw1[1]=PKW(P0,10), pw1); \
    VRD(5); SBAR(); GAPA(C1=MFH(kf[3],qr[1],C1,0,0,0),   P0[14],P0[15],P1[0],P1[1],   pw1[2]=PKW(P0,12),pw1[3]=PKW(P0,14), pw1); \
    VRD(2); SBAR(); GAPA(C0=MFH(kf[4],qr[2],C0,0,0,0),   P1[2],P1[3],P1[4],P1[5],     pw2[0]=PKW(P1,0), pw2[1]=PKW(P1,2), pw2); \
    VRD(6); SBAR(); GAPA(C1=MFH(kf[5],qr[2],C1,0,0,0),   P1[6],P1[7],P1[8],P1[9],     pw2[2]=PKW(P1,4), pw2[3]=PKW(P1,6), pw2); \
    VRD(3); SBAR(); GAPA(C0=MFH(kf[6],qr[3],C0,0,0,0),   P1[10],P1[11],P1[12],P1[13], pw3[0]=PKW(P1,8), pw3[1]=PKW(P1,10), pw3); \
    VRD(7); SBAR(); GAPA(C1=MFH(kf[7],qr[3],C1,0,0,0),   P1[14],P1[15],0.f,0.f,       pw3[2]=PKW(P1,12),pw3[3]=PKW(P1,14), pw3); \
    l_reg+=sacc; \
    if(GK){DMA_K((t)+3,sl_cur);} if(GV){DMA_V((t)+1,sl_next);} \
    { float a=MX3(C0[0],C0[1],C1[0]),b=MX3(C0[2],C0[3],C1[1]); a=MX3(a,C1[2],C1[3]); \
      _Pragma("unroll") for(int r=4;r<16;r+=4){a=MX3(a,C0[r],C0[r+1]);b=MX3(b,C0[r+2],C0[r+3]);a=MX3(a,C1[r],C1[r+1]);b=MX3(b,C1[r+2],C1[r+3]);} \
      float rm=__builtin_fmaxf(a,b); { auto rr=__builtin_amdgcn_permlane32_swap(__float_as_uint(rm),__float_as_uint(rm),false,false); rm=__builtin_fmaxf(__uint_as_float(rr[0]),__uint_as_float(rr[1])); } \
      resc=false; \
      if(__builtin_expect(__any(rm>(float)THRL),0)){ const float dl=__builtin_fmaxf(rm,0.f); mhat+=dl; \
        _Pragma("unroll") for(int r=0;r<16;++r){C0[r]-=dl;C1[r]-=dl;} \
        const float f=__builtin_amdgcn_exp2f(-dl); l_reg*=f; if(hi==0)wsf[r32]=f; resc=true; } } \
    SBAR(); \
    GAPB(o[0]=MFH(PAF(0),VFR(0),o[0],0,0,0), C0,0); \
    GAPB(o[1]=MFH(PAF(0),VFR(4),o[1],0,0,0), C0,4); \
    KRD(GL,0); GAPB(o[0]=MFH(PAF(1),VFR(1),o[0],0,0,0), C0,8); \
    KRD(GL,1); GAPB(o[1]=MFH(PAF(1),VFR(5),o[1],0,0,0), C0,12); \
    KRD(GL,2); GAPB(o[0]=MFH(PAF(2),VFR(2),o[0],0,0,0), C1,0); \
    KRD(GL,3); GAPB(o[1]=MFH(PAF(2),VFR(6),o[1],0,0,0), C1,4); \
    GAPB(o[0]=MFH(PAF(3),VFR(3),o[0],0,0,0), C1,8); \
    GAPB(o[1]=MFH(PAF(3),VFR(7),o[1],0,0,0), C1,12); \
    }while(0)
  int t=1;
  for(;t+5<NT;t+=2){
    STEP(pB0,pB1,pA0,pA1,t,true,true,true,mB,mA,true);     WAIT_BAR_M(2,mA); RESC(); ROT();
    STEP(pA0,pA1,pB0,pB1,t+1,true,true,true,mA,mB,true);   WAIT_BAR_M(2,mB); RESC(); ROT();
  }
  #define ENDW(tt,M) do{ if((tt)+3<NT){WAIT_BAR_M(2,M);} else if((tt)+2<NT){WAIT_BAR_M(1,M);} else {WAIT_BAR_M(0,M);} }while(0)
  for(;t+1<NT;t+=2){
    STEP(pB0,pB1,pA0,pA1,t,(t+3<NT),(t+1<NT),(t+1<NT),mB,mA,(t+1<NT));       ENDW(t,mA);   RESC(); ROT();
    STEP(pA0,pA1,pB0,pB1,t+1,(t+4<NT),(t+2<NT),(t+2<NT),mA,mB,(t+2<NT));     ENDW(t+1,mB); RESC(); ROT();
  }
  STEP(pB0,pB1,pA0,pA1,NT-1,false,false,false,mB,mA,false); RESC();
  { float sacc=pB0[0]+pB0[1]; _Pragma("unroll") for(int r=2;r<16;++r)sacc+=pB0[r]; _Pragma("unroll") for(int r=0;r<16;++r)sacc+=pB1[r]; l_reg+=sacc;
    pw0=(u32x4){PKW(pB0,0),PKW(pB0,2),PKW(pB0,4),PKW(pB0,6)};pw1=(u32x4){PKW(pB0,8),PKW(pB0,10),PKW(pB0,12),PKW(pB0,14)};pw2=(u32x4){PKW(pB1,0),PKW(pB1,2),PKW(pB1,4),PKW(pB1,6)};pw3=(u32x4){PKW(pB1,8),PKW(pB1,10),PKW(pB1,12),PKW(pB1,14)};
    SBAR(); pv(o,vb0+sl_cur,PAF(0),PAF(1),PAF(2),PAF(3)); }
  #undef PKW
  #undef PAF
  #undef VFR
  #undef PIN
  #undef MX3
  #undef GAPA
  #undef GAPB
  #undef EX
  #undef VRD
  #undef KRD
  #undef STEP
  #undef ENDW
  {auto rr=__builtin_amdgcn_permlane32_swap(__float_as_uint(l_reg),__float_as_uint(l_reg),false,false);l_reg=__uint_as_float(rr[0])+__uint_as_float(rr[1]);}
  if(hi==0)wsf[32+r32]=l_reg;asm volatile("s_waitcnt lgkmcnt(0)":::"memory");
  float rli[16];
  #pragma unroll
  for(int r=0;r<16;++r)rli[r]=__builtin_amdgcn_rcpf(wsf[32+crow(r,hi)]);
  bf16*Ow=O+(rowbase+q0+wid*QBLK)*DM+h*D;
  { bf16*stg=(bf16*)(shm+LDS_OST)+wid*2048;
    #pragma unroll
    for(int r=0;r<16;++r){const int orow=crow(r,hi);
      #pragma unroll
      for(int d0=0;d0<2;++d0)stg[orow*64+d0*32+r32]=(bf16)(o[d0][r]*rli[r]);}
    asm volatile("s_waitcnt lgkmcnt(0)":::"memory");
    #pragma unroll
    for(int i=0;i<4;++i){const int row=i*8+(lane>>3),ch=lane&7; const u32x4 v=*(const u32x4*)(stg+row*64+ch*8); ATTN_STORE16(Ow+(long)row*DM+ch*8,v);} }
  asm volatile("s_waitcnt lgkmcnt(0)\n\ts_barrier":::"memory");
  #undef DMA_K
  #undef DMA_V
  #undef START
  #undef RESC
  #undef ROT
}
constexpr int ATTN_LDS_BYTES=LDS_BYTES;
struct AttnTensors { const bf16* Q; const bf16* K; const bf16* V; bf16* O; const unsigned long long* Mk; };
struct AttnUnit { int bh; int qb; };
struct StaticOrder {
  int vcu,G;
  __device__ __forceinline__ explicit StaticOrder(int grid,int block):vcu((grid%8==0)?((block%8)*(grid/8)+block/8):block),G(grid){}
  __device__ __forceinline__ bool next(int i,AttnUnit&u)const{ const int v=vcu+G*(i>>1); if(v>=256)return false; const int s=v&15; u.bh=v>>4; u.qb=(i&1)?s:31-s; return true; }
};
template<class Sched,int THRL=8> __device__ __forceinline__ void attn_phase(char*lds,const AttnTensors&T,const Sched&S){
  AttnUnit u;
  for(int i=0;S.next(i,u);++i){ attn_unit<THRL>(u.bh/NHEAD,u.bh%NHEAD,u.qb,T.Q,T.K,T.V,T.O,T.Mk,lds); }
}
#undef SBAR
#undef WAIT_BAR
#undef WAIT_BAR_M
#undef WAIT_BAR_M2
#undef MFH
}

typedef __bf16 bf16;
typedef __bf16 bf16x8 __attribute__((ext_vector_type(8)));
typedef __bf16 bf16x4 __attribute__((ext_vector_type(4)));
typedef __bf16 bf16x2 __attribute__((ext_vector_type(2)));
typedef short s16x4_t __attribute__((ext_vector_type(4)));
typedef short s16x8_t __attribute__((ext_vector_type(8)));
typedef LAS const char* lcptr;
constexpr int HVP = 272;
constexpr int HAP = 144;
__device__ __forceinline__ float hgrn_lb(const Params& p, int idx) { const float l0 = p.lb_logits[idx], l1 = p.lb_logits[512 + idx]; return 1.f / (1.f + __expf(l1 - l0)); }
__device__ __forceinline__ bf16x8 tr_frag(lcptr plo, lcptr phi) {
    const s16x4_t lo = __builtin_amdgcn_ds_read_tr16_b64_v4i16((LAS s16x4_t*)plo), hi = __builtin_amdgcn_ds_read_tr16_b64_v4i16((LAS s16x4_t*)phi);
    return __builtin_bit_cast(bf16x8, (s16x8_t){lo[0], lo[1], lo[2], lo[3], hi[0], hi[1], hi[2], hi[3]});
}
__device__ __forceinline__ void hgrn_fb(const Params& p, const h16* P, size_t rowbase, int h, int d, int g, int L, float (&cs)[16], float (&kk)[16], float* gtot) {
    const float lb = hgrn_lb(p, h * 128 + d);
    float run = 0.f;
#pragma unroll
    for (int i = 0; i < 16; ++i) {
        const int t = 16 * g + i;
        if (t < L) { const float hf = (float)P[(rowbase + t) * NP2 + C_HF + h * 128 + d]; const float f = lb + (1.f - lb) * sigmoidf_(hf); run += __logf(f); kk[i] = 1.f - f; }
        else kk[i] = 0.f;
        cs[i] = run;
    }
    gtot[g * 128 + d] = run;
}
__device__ __forceinline__ void hgrn_load_v(const bf16* Pb, size_t rowbase, int h, int L, char* vs) {
    for (int idx = threadIdx.x; idx < 64 * 16; idx += NT) {
        const int t = idx >> 4, c16 = idx & 15;
        bf16x8 v = {};
        if (t < L) v = *(const bf16x8*)(Pb + (rowbase + t) * NP2 + C_HI + h * 128 + c16 * 8);
        *(bf16x8*)(vs + t * HVP + c16 * 16) = v;
    }
}

constexpr int HA_VS = 0, HA_KT = 17408, HA_GT = 35840;
__device__ __forceinline__ void hgrn_stepA(const Params& p, int item, char* lds) {
    const h16* P = (const h16*)(p.ws + WS_P); bf16* ST = (bf16*)(p.ws + WS_X); float* G = (float*)(p.ws + WS_G);
    float* gtot = (float*)(lds + HA_GT);
    const int tid = threadIdx.x, d = tid & 127, g = tid >> 7;
    const int c = item % NCH, bh = item / NCH, h = bh & 3, b = bh >> 2;
    const int L = c == 0 ? 16 : 64; const size_t rowbase = c == 0 ? (size_t)MREAL : (size_t)(b * S + (c - 1) * 64);
    hgrn_load_v((const bf16*)P, rowbase, h, L, lds + HA_VS);
    float cs[16], kk[16];
    hgrn_fb(p, P, rowbase, h, d, g, L, cs, kk, gtot);
    __syncthreads();
    {
        const float t0 = gtot[d], t1 = gtot[128 + d], t2 = gtot[256 + d], t3 = gtot[384 + d];
        const float bend = (t0 + t1) + (t2 + t3), off = g == 0 ? 0.f : (g == 1 ? t0 : (g == 2 ? t0 + t1 : t0 + t1 + t2));
        bf16x8 o0, o1;
#pragma unroll
        for (int i = 0; i < 8; ++i) { o0[i] = (bf16)(kk[i] * __expf(bend - (off + cs[i]))); o1[i] = (bf16)(kk[8 + i] * __expf(bend - (off + cs[8 + i]))); }
        *(bf16x8*)(lds + HA_KT + d * HAP + 32 * g) = o0; *(bf16x8*)(lds + HA_KT + d * HAP + 32 * g + 16) = o1;
        if (g == 0) G[(size_t)item * 128 + d] = __expf(bend);
    }
    __syncthreads();
    const int w = tid >> 6, lane = tid & 63, hl = lane >> 5, r32 = lane & 31;
    const int dt = w >> 1, vt0 = 2 * (w & 1);
    f32x16 acc0 = {0.f, 0.f, 0.f, 0.f, 0.f, 0.f, 0.f, 0.f, 0.f, 0.f, 0.f, 0.f, 0.f, 0.f, 0.f, 0.f}, acc1 = acc0;
    const lcptr vbase = (lcptr)(lds + HA_VS) + (8 * hl + ((lane & 15) >> 2)) * HVP + (16 * ((lane >> 4) & 1) + 4 * (lane & 3)) * 2;
#pragma unroll
    for (int ks = 0; ks < 4; ++ks) {
        const bf16x8 a = *(const bf16x8*)(lds + HA_KT + (32 * dt + r32) * HAP + (16 * ks + 8 * hl) * 2);
        const lcptr pv0 = vbase + (16 * ks) * HVP + (32 * vt0) * 2, pv1 = pv0 + 64;
        const bf16x8 b0 = tr_frag(pv0, pv0 + 4 * HVP), b1 = tr_frag(pv1, pv1 + 4 * HVP);
        acc0 = __builtin_amdgcn_mfma_f32_32x32x16_bf16(a, b0, acc0, 0, 0, 0);
        acc1 = __builtin_amdgcn_mfma_f32_32x32x16_bf16(a, b1, acc1, 0, 0, 0);
    }
    bf16* o = ST + ((size_t)item * 128 + 32 * vt0 + r32) * 128 + 32 * dt + 4 * hl;
#pragma unroll
    for (int r4 = 0; r4 < 4; ++r4) {
        const bf16x4 x0 = {(bf16)acc0[4 * r4], (bf16)acc0[4 * r4 + 1], (bf16)acc0[4 * r4 + 2], (bf16)acc0[4 * r4 + 3]};
        const bf16x4 x1 = {(bf16)acc1[4 * r4], (bf16)acc1[4 * r4 + 1], (bf16)acc1[4 * r4 + 2], (bf16)acc1[4 * r4 + 3]};
        *(bf16x4*)(o + 8 * r4) = x0; *(bf16x4*)(o + 32 * 128 + 8 * r4) = x1;
    }
    __syncthreads();
}

__device__ __forceinline__ void hgrn_scan(const Params& p) {
    bf16* ST = (bf16*)(p.ws + WS_X); const float* G = (const float*)(p.ws + WS_G);
    for (int e = blockIdx.x * NT + threadIdx.x; e < NB * 4 * 128 * 64; e += gridDim.x * NT) {
        const int bh = e >> 13, vd = e & 8191, dp = e & 63;
        float s0 = 0.f, s1 = 0.f;
#pragma unroll 8
        for (int c = 0; c < NCH; ++c) {
            bf16x2* ptr = (bf16x2*)(ST + (size_t)(bh * NCH + c) * 16384) + vd;
            const bf16x2 u = *ptr; const f32x2 g = *(const f32x2*)(G + (size_t)(bh * NCH + c) * 128 + 2 * dp);
            const bf16x2 sv = {(bf16)s0, (bf16)s1}; *ptr = sv;
            s0 = g.x * s0 + (float)u[0]; s1 = g.y * s1 + (float)u[1];
        }
    }
}

constexpr int HC_VS = 0, HC_QH = 17408, HC_Q0 = 34816, HC_Q1 = 47872, HC_Q2 = 56576, HC_KD = 60928, HC_KG = 73984, HC_AM = 91392, HC_GT = 100608, HC_OT = 34816, HC_OTP = 132;
__device__ __forceinline__ void hgrn_stepC(const Params& p, int item, char* lds) {
    const h16* P = (const h16*)(p.ws + WS_P); const bf16* ST = (const bf16*)(p.ws + WS_X); h16* MIX = (h16*)(p.ws + WS_MIX);
    float* gtot = (float*)(lds + HC_GT);
    const int tid = threadIdx.x, d = tid & 127, g = tid >> 7;
    const int w = tid >> 6, lane = tid & 63, hl = lane >> 5, r32 = lane & 31;
    const int c = 1 + item % 128, bh = item / 128, h = bh & 3, b = bh >> 2;
    const size_t rowbase = (size_t)(b * S + (c - 1) * 64);
    const int tt = w >> 2, vt = w & 3;
    bf16x8 sfr[8];
    { const bf16* sp = ST + ((size_t)(bh * NCH + c) * 128 + 32 * vt + r32) * 128 + 8 * hl;
#pragma unroll
      for (int ks = 0; ks < 8; ++ks) sfr[ks] = *(const bf16x8*)(sp + 16 * ks); }
    hgrn_load_v((const bf16*)P, rowbase, h, 64, lds + HC_VS);
    for (int i = tid; i < 64 * HAP / 16; i += NT) *(f32x4*)(lds + HC_AM + i * 16) = (f32x4){0.f, 0.f, 0.f, 0.f};
    float cs[16], kk[16], qv[16];
#pragma unroll
    for (int i = 0; i < 16; ++i) qv[i] = siluf_((float)P[(rowbase + 16 * g + i) * NP2 + C_HQ + h * 128 + d]);
    hgrn_fb(p, P, rowbase, h, d, g, 64, cs, kk, gtot);
    __syncthreads();
    {
        const float t0 = gtot[d], t1 = gtot[128 + d], t2 = gtot[256 + d];
        const float bg = g == 0 ? 0.f : (g == 1 ? t0 : (g == 2 ? t0 + t1 : t0 + t1 + t2));
        const float tg = g == 0 ? t0 : (g == 1 ? t1 : t2);
        const float e1 = g >= 2 ? (g == 2 ? t1 : t2) : 0.f;
        const float e2 = g == 3 ? t1 : 0.f;
#pragma unroll
        for (int i = 0; i < 16; ++i) {
            const int t = 16 * g + i; const float cc = cs[i], q = qv[i];
            *(bf16*)(lds + HC_QH + t * HVP + d * 2) = (bf16)(q * __expf(bg + cc));
            if (g >= 1) *(bf16*)(lds + (g == 1 ? HC_Q0 : (g == 2 ? HC_Q1 : HC_Q2)) + i * HVP + d * 2) = (bf16)(q * __expf(cc));
            if (g >= 2) *(bf16*)(lds + (g == 2 ? HC_Q0 : HC_Q1) + (16 + i) * HVP + d * 2) = (bf16)(q * __expf(e1 + cc));
            if (g == 3) *(bf16*)(lds + HC_Q0 + (32 + i) * HVP + d * 2) = (bf16)(q * __expf(e1 + e2 + cc));
            if (g <= 2) *(bf16*)(lds + HC_KD + t * HVP + d * 2) = (bf16)(kk[i] * __expf(tg - cc));
            *(bf16*)(lds + HC_KG + t * HVP + d * 2) = (bf16)(kk[i] * __expf(fminf(-cc, 80.f)));
        }
    }
    __syncthreads();
    for (int n = w; n < 10; n += 8) {
        const int I = n >= 6 ? 3 : (n >= 3 ? 2 : (n >= 1 ? 1 : 0)), J = n - I * (I + 1) / 2;
        const char* qp; const char* kp;
        if (J == I) { qp = I == 0 ? lds + HC_QH : lds + (I == 1 ? HC_Q0 : (I == 2 ? HC_Q1 : HC_Q2)); kp = lds + HC_KG + 16 * I * HVP; }
        else { qp = lds + (J == 0 ? HC_Q0 : (J == 1 ? HC_Q1 : HC_Q2)) + (16 * I - 16 * (J + 1)) * HVP; kp = lds + HC_KD + 16 * J * HVP; }
        f32x4 a4 = {0.f, 0.f, 0.f, 0.f};
        const int fo = (lane & 15) * HVP + 16 * (lane >> 4);
#pragma unroll
        for (int ks = 0; ks < 4; ++ks) {
            const bf16x8 af = *(const bf16x8*)(qp + fo + 64 * ks), bf_ = *(const bf16x8*)(kp + fo + 64 * ks);
            a4 = __builtin_amdgcn_mfma_f32_16x16x32_bf16(af, bf_, a4, 0, 0, 0);
        }
        const int sl = lane & 15, tl0 = 4 * (lane >> 4);
#pragma unroll
        for (int r = 0; r < 4; ++r) { const int tl = tl0 + r; const float val = (J == I && sl > tl) ? 0.f : a4[r]; *(bf16*)(lds + HC_AM + (16 * I + tl) * HAP + (16 * J + sl) * 2) = (bf16)val; }
    }
    __syncthreads();
    f32x16 acc = {0.f, 0.f, 0.f, 0.f, 0.f, 0.f, 0.f, 0.f, 0.f, 0.f, 0.f, 0.f, 0.f, 0.f, 0.f, 0.f};
    {
        const lcptr vbase = (lcptr)(lds + HC_VS) + (8 * hl + ((lane & 15) >> 2)) * HVP + (32 * vt + 16 * ((lane >> 4) & 1) + 4 * (lane & 3)) * 2;
#pragma unroll
        for (int ks = 0; ks < 4; ++ks) {
            const bf16x8 a = *(const bf16x8*)(lds + HC_AM + (32 * tt + r32) * HAP + (16 * ks + 8 * hl) * 2);
            const lcptr pv = vbase + (16 * ks) * HVP;
            acc = __builtin_amdgcn_mfma_f32_32x32x16_bf16(a, tr_frag(pv, pv + 4 * HVP), acc, 0, 0, 0);
        }
#pragma unroll
        for (int ks = 0; ks < 8; ++ks) {
            const bf16x8 a = *(const bf16x8*)(lds + HC_QH + (32 * tt + r32) * HVP + (16 * ks + 8 * hl) * 2);
            acc = __builtin_amdgcn_mfma_f32_32x32x16_bf16(a, sfr[ks], acc, 0, 0, 0);
        }
    }
    __syncthreads();
    float* OT = (float*)(lds + HC_OT);
#pragma unroll
    for (int i = 0; i < 16; ++i) OT[(32 * tt + (i & 3) + 8 * (i >> 2) + 4 * hl) * HC_OTP + 32 * vt + r32] = acc[i];
    __syncthreads();
    {
        const int t = tid >> 3, j = tid & 7;
        f32x4 x[4]; float ss = 0.f;
#pragma unroll
        for (int k = 0; k < 4; ++k) { x[k] = *(const f32x4*)(OT + t * HC_OTP + 16 * j + 4 * k); ss += x[k].x * x[k].x + x[k].y * x[k].y + x[k].z * x[k].z + x[k].w * x[k].w; }
        ss += __shfl_xor(ss, 1); ss += __shfl_xor(ss, 2); ss += __shfl_xor(ss, 4);
        const float rs = rsqrtf(ss * (1.f / 128.f) + 1e-6f);
        const h16* gp = P + (rowbase + t) * NP2 + C_HG + h * 128 + 16 * j;
        const h16x8 g0 = *(const h16x8*)gp, g1 = *(const h16x8*)(gp + 8);
        h16x8 o0, o1;
#pragma unroll
        for (int k = 0; k < 8; ++k) {
            o0[k] = (h16)(x[k >> 2][k & 3] * rs * p.hgrn_norm[16 * j + k] * siluf_((float)g0[k]));
            o1[k] = (h16)(x[2 + (k >> 2)][k & 3] * rs * p.hgrn_norm[16 * j + 8 + k] * siluf_((float)g1[k]));
        }
        h16* op = MIX + (rowbase + t) * D + 512 + h * 128 + 16 * j;
        *(h16x8*)op = o0; *(h16x8*)(op + 8) = o1;
    }
    __syncthreads();
}

__device__ __forceinline__ void phase_mix(const Params& p) {
    const h16* P = (const h16*)(p.ws + WS_P); h16* MIX = (h16*)(p.ws + WS_MIX);
    const int lane = threadIdx.x & 63, wave = threadIdx.x >> 6;
    for (int row = blockIdx.x * 8 + wave; row < MREAL; row += gridDim.x * 8) {
        const h16* pr = P + (size_t)row * NP2; h16* o = MIX + (size_t)row * D; const h16* qo = (const h16*)(p.ws + WS_QB) + (size_t)row * 512;
        const h16x8 a = *(const h16x8*)(qo + lane * 8); const h16x8 g = *(const h16x8*)(pr + C_AG + lane * 8);
        float ss = 0.f;
#pragma unroll
        for (int j = 0; j < 8; ++j) ss += (float)a[j] * (float)a[j];
        const float rs = rsqrtf(wave_sum(ss) * (1.f / 512.f) + 1e-6f);
        h16x8 ov;
#pragma unroll
        for (int j = 0; j < 8; ++j) ov[j] = (h16)((float)a[j] * rs * p.attn_norm[lane * 8 + j] * siluf_((float)g[j]));
        *(h16x8*)(o + lane * 8) = ov;
    }
}

__device__ __forceinline__ void phase_final(const Params& p) {
    const int lane = threadIdx.x & 63, wave = threadIdx.x >> 6;
    for (int row = blockIdx.x * 8 + wave; row < MREAL; row += gridDim.x * 8) {
        float* o = p.out + (size_t)row * D;
        f32x4 v[4]; float ss = 0.f;
        for (int j = 0; j < 4; ++j) { v[j] = *(const f32x4*)(o + (lane + 64 * j) * 4); ss += v[j].x * v[j].x + v[j].y * v[j].y + v[j].z * v[j].z + v[j].w * v[j].w; }
        const float rs = rsqrtf(wave_sum(ss) * (1.f / D) + 1e-6f);
        for (int j = 0; j < 4; ++j) { const f32x4 g = *(const f32x4*)(p.final_norm + (lane + 64 * j) * 4);
            *(f32x4*)(o + (lane + 64 * j) * 4) = (f32x4){v[j].x * rs * g.x, v[j].y * rs * g.y, v[j].z * rs * g.z, v[j].w * rs * g.w}; }
    }
}

#define XB_TMO      128
#define XB_XCNT(j)  (256  + 64 * (j))
#define XB_XSUB(j)  (1280 + 64 * (j))
#define XB_XGEN(j)  (2304 + 64 * (j))
#define XB_TOP      3328
#define XB_TOPGEN   3392
#define XCD_BAR_WORDS 3456
#define XB_SPIN_CAP (1u << 18)

__device__ __forceinline__ unsigned xb_ld(unsigned* p)              { return __hip_atomic_load(p, __ATOMIC_RELAXED, __HIP_MEMORY_SCOPE_AGENT); }
__device__ __forceinline__ unsigned xb_add(unsigned* p, unsigned v) { return __hip_atomic_fetch_add(p, v, __ATOMIC_RELAXED, __HIP_MEMORY_SCOPE_AGENT); }
__device__ __forceinline__ unsigned xb_xcc_id() { return (unsigned)__builtin_amdgcn_s_getreg((3 << 11) | 20) & 0xFu; }
#define XB_SPIN(cond, bar) do { unsigned _sp = 0; while (cond) { __builtin_amdgcn_s_sleep(1); \
    if ((++_sp & 255u) == 0u) { if (xb_ld(&(bar)[XB_TMO])) break; if (_sp > XB_SPIN_CAP) { atomicAdd(&(bar)[XB_TMO], 1u); break; } } } } while (0)

struct XcdBarrier {
    unsigned* bar; unsigned x;
    volatile LAS unsigned* st;
};

__device__ __forceinline__ XcdBarrier xcd_barrier_post(unsigned* bar, volatile LAS unsigned* st) {
    XcdBarrier b; b.bar = bar; b.x = xb_xcc_id(); b.st = st;
    if (threadIdx.x == 0) (void)xb_add(&bar[XB_XCNT(b.x)], 1u);
    return b;
}
__device__ __forceinline__ void xcd_barrier_complete(unsigned* bar, unsigned x, unsigned& nloc, unsigned& nx) {
    const unsigned G = gridDim.x * gridDim.y * gridDim.z;
    unsigned sum, cnt, mine, sp = 0u;
    for (;;) {
        sum = 0u; cnt = 0u; mine = 0u;
#pragma unroll
        for (unsigned j = 0; j < 16; ++j) { const unsigned c = xb_ld(&bar[XB_XCNT(j)]); sum += c; cnt += (c > 0u) ? 1u : 0u; mine = (j == x) ? c : mine; }
        if (sum == G) break;
        __builtin_amdgcn_s_sleep(1);
        if ((++sp & 255u) == 0u) { if (xb_ld(&bar[XB_TMO])) break; if (sp > XB_SPIN_CAP) { atomicAdd(&bar[XB_TMO], 1u); break; } }
    }
    nloc = mine > 0u ? mine : 1u; nx = cnt > 0u ? cnt : 1u;
}

__device__ __forceinline__ void xcd_barrier(const XcdBarrier& b) {
    asm volatile("s_waitcnt vmcnt(0)" ::: "memory");
    __syncthreads();
    if (threadIdx.x == 0) {
        unsigned* bar = b.bar;
        __builtin_amdgcn_s_waitcnt(0);
        unsigned nloc = b.st[0], nx = b.st[1];
        if (nloc == 0u) { xcd_barrier_complete(bar, b.x, nloc, nx); b.st[0] = nloc; b.st[1] = nx; }
        const unsigned old = xb_add(&bar[XB_XSUB(b.x)], 1u);
        const unsigned gen = old / nloc;
        if (old + 1u == (gen + 1u) * nloc) {
            __builtin_amdgcn_fence(__ATOMIC_RELEASE, "agent");
            asm volatile("s_waitcnt vmcnt(0)" ::: "memory");
            const unsigned og = xb_add(&bar[XB_TOP], 1u);
            const unsigned tg = og / nx;
            if (og + 1u == (tg + 1u) * nx) xb_add(&bar[XB_TOPGEN], 1u);
            else XB_SPIN(xb_ld(&bar[XB_TOPGEN]) == tg, bar);
            __builtin_amdgcn_fence(__ATOMIC_ACQUIRE, "agent");
            xb_add(&bar[XB_XGEN(b.x)], 1u);
            asm volatile("s_waitcnt vmcnt(0)" ::: "memory");
        } else {
            XB_SPIN(xb_ld(&bar[XB_XGEN(b.x)]) == gen, bar);
            __builtin_amdgcn_fence(__ATOMIC_ACQUIRE, "agent");
            asm volatile("s_waitcnt vmcnt(0)" ::: "memory");
        }
    }
    __syncthreads();
}


constexpr int NPHASE = 9;
__global__ void __launch_bounds__(NT, 2) mega(Params p, int ph_lo, int ph_hi) {
    extern __shared__ __attribute__((aligned(16))) char lds[];
    cg::grid_group grid = cg::this_grid();
    volatile LAS unsigned* xst = (volatile LAS unsigned*)(LAS char*)(lds + LDS_BYTES - 16);
    if (threadIdx.x < 4) xst[threadIdx.x] = 0u;
    __syncthreads();
    XcdBarrier xbar = xcd_barrier_post((unsigned*)p.ws, xst);
#define IN(k) (ph_lo <= (k) && (k) < ph_hi)
#define SYNC(k) do { if ((k) + 1 < ph_hi) { if ((k) == 0 && USE_CG_SYNC) grid.sync(); else xcd_barrier(xbar); } } while (0)
    if (IN(0)) { phase_prep(p, lds); if (PROBE == 4) phase_prep(p, lds); SYNC(0); }
    if (PROBE == 2) { for (int i = 0; i < 8; ++i) xcd_barrier(xbar); }
    if (IN(1)) { phase_gemm_in(p, lds); if (PROBE == 1) phase_gemm_in(p, lds); SYNC(1); }
    if (IN(3)) {
        constexpr int NA = NB * 4 * NCH;
        for (int rep = 0; rep < ((PROBE == 3 || PROBE == 12) ? 2 : 1); ++rep)
        for (int it = blockIdx.x; it < 512; it += gridDim.x) { const int uu = it < 256 ? 255 - (it >> 1) : (it - 256) >> 1; idx_unit(p, it & 1, uu, lds, (PROBE == 12 && rep == 1) ? 1 : 0); }
        for (int rep = 0; rep < (PROBE == 5 ? 2 : 1); ++rep)
        for (int it = blockIdx.x; it < NA; it += gridDim.x) hgrn_stepA(p, it, lds);
        SYNC(3);
    }
    if (IN(4)) { hgrn_scan(p); SYNC(4); }
    if (IN(5)) {
        constexpr int NC = NB * 4 * 128;
        for (int it = blockIdx.x; it < NC; it += gridDim.x) hgrn_stepC(p, it, lds);
        {
            const attn_body::AttnTensors AT{(const h16*)(p.ws + WS_QB), (const h16*)(p.ws + WS_KB), (const h16*)(p.ws + WS_VB), (h16*)(p.ws + WS_QB), (const unsigned long long*)p.out};
            const attn_body::StaticOrder SO((int)gridDim.x, (int)blockIdx.x);
            attn_body::attn_phase<attn_body::StaticOrder>(lds, AT, SO);
        }
        SYNC(5);
    }
    if (IN(6)) { phase_mix(p); if (PROBE == 6) phase_mix(p); SYNC(6); }
    if (IN(7)) { phase_gemm_out(p, lds); if (PROBE == 7) phase_gemm_out(p, lds); SYNC(7); }
    if (IN(8)) { phase_final(p); }
#undef IN
#undef SYNC
}

extern "C" void kernel_launch(void* const* d_in, const int* in_sizes, int n_in, void* d_out, int out_size, void* d_ws, size_t ws_size, hipStream_t stream) {
    static int grid = 0;
    if (grid == 0) {
        if (n_in != 11 || ws_size < WS_END || out_size != MREAL * D) { fprintf(stderr, "kernel_launch: unexpected shapes n_in %d ws %zu out %d\n", n_in, ws_size, out_size); grid = -1; return; }
        int dev = 0, cus = 0, per_cu = 0;
        hipGetDevice(&dev); hipDeviceGetAttribute(&cus, hipDeviceAttributeMultiprocessorCount, dev);
        hipFuncSetAttribute((const void*)mega, hipFuncAttributeMaxDynamicSharedMemorySize, LDS_BYTES);
        hipOccupancyMaxActiveBlocksPerMultiprocessor(&per_cu, (const void*)mega, NT, LDS_BYTES);
        if (per_cu < 1) { fprintf(stderr, "kernel_launch: occupancy query says %d\n", per_cu); per_cu = 1; }
        grid = cus * 1;
        (void)hipGetLastError();
    }
    if (grid < 0) return;
    Params p{};
    p.x = (const float*)d_in[0]; p.meta = (const float*)d_in[1]; p.mix_norm = (const float*)d_in[2]; p.w_in = (const float*)d_in[3];
    p.idx_g = (const float*)d_in[4]; p.idx_b = (const float*)d_in[5]; p.attn_norm = (const float*)d_in[6]; p.lb_logits = (const float*)d_in[7];
    p.hgrn_norm = (const float*)d_in[8]; p.w_out = (const float*)d_in[9]; p.final_norm = (const float*)d_in[10];
    p.out = (float*)d_out; p.ws = (unsigned char*)d_ws;
    hipMemsetAsync(d_ws, 0, 16384, stream);
#if N_LAUNCH_MODE == 1
    int lo = 0, hi = NPHASE; void* args[] = {&p, &lo, &hi};
    hipError_t e = hipLaunchCooperativeKernel((const void*)mega, dim3(grid), dim3(NT), args, LDS_BYTES, stream);
    if (e != hipSuccess) fprintf(stderr, "cooperative launch failed: %s (grid %d)\n", hipGetErrorString(e), grid);
#else
    for (int ph = 0; ph < NPHASE; ++ph) hipLaunchKernelGGL(mega, dim3(grid), dim3(NT), LDS_BYTES, stream, p, ph, ph + 1);
#endif
}
```
